# Optimizing an MI355X kernel written in HIP

```python
import jax, jax.numpy as jnp
from jax import lax
import numpy as np

D_MODEL = 1024
BATCH = 32
SEQ = 2048
DEPTH = 1
DEC_BATCH = 128
DEC_SEQ = 8
PAST_LEN = 16384
PAGE_SIZE = 128

GDN_HEADS = 8
GDN_DK = 64
GDN_DV = 64
GDN_CONV = 4
GDN_CHUNK = 64
GDN_CONV_DIM = GDN_HEADS * (2 * GDN_DK + GDN_DV)
MLA_HEADS = 8
MLA_Q_LORA = 256
MLA_KV_LORA = 128
MLA_NOPE = 64
MLA_ROPE = 32
MLA_V = 64
MLA_SCALE = (MLA_NOPE + MLA_ROPE) ** -0.5
ROPE_THETA = 10000.0
Q_BLOCK = 128
GROUP_COLS = (GDN_CONV_DIM, GDN_HEADS * GDN_DV, GDN_HEADS, GDN_HEADS,
              MLA_Q_LORA, MLA_KV_LORA, MLA_ROPE)
IN_COLS = sum(GROUP_COLS)
MIX_WIDTH = GDN_HEADS * GDN_DV + MLA_HEADS * MLA_V
D_FF = 2816
FFN_CONV = 3
ALPHA = (2.0 * DEPTH) ** 0.25
BETA_INIT = (8.0 * DEPTH) ** -0.25
RMS_EPS = 1e-6
LN_EPS = 1e-5

kernel_name = "hymba_gdn_mla_convffn_deepnorm_step"


def split_cols(x, widths):
    idx, off = [], 0
    for w in widths[:-1]:
        off += w
        idx.append(off)
    return jnp.split(x, idx, axis=-1)


def rmsnorm(x, w):
    xf = x.astype(jnp.float32)
    y = xf * lax.rsqrt(jnp.mean(xf * xf, axis=-1, keepdims=True) + RMS_EPS)
    return (y * w.astype(jnp.float32)).astype(x.dtype)


def layernorm(x, g, b):
    xf = x.astype(jnp.float32)
    mu = jnp.mean(xf, axis=-1, keepdims=True)
    var = jnp.mean(jnp.square(xf - mu), axis=-1, keepdims=True)
    y = (xf - mu) * lax.rsqrt(var + LN_EPS) * g.astype(jnp.float32) + b.astype(jnp.float32)
    return y.astype(x.dtype)


def l2norm(x):
    return x * lax.rsqrt(jnp.sum(x * x, axis=-1, keepdims=True) + 1e-6)


def causal_dwconv(x_hist, w):
    width = w.shape[0]
    T = x_hist.shape[1] - width + 1
    y = x_hist[:, 0:T] * w[0]
    for j in range(1, width):
        y = y + x_hist[:, j:j + T] * w[j]
    return y


def rope(x, pos):
    half = MLA_ROPE // 2
    inv = ROPE_THETA ** (-jnp.arange(half, dtype=jnp.float32) / half)
    ang = pos.astype(jnp.float32)[:, None] * inv
    ang = ang.reshape((ang.shape[0],) + (1,) * (x.ndim - 3) + (half,))
    cos, sin = jnp.cos(ang), jnp.sin(ang)
    xf = x.astype(jnp.float32)
    x1, x2 = xf[..., :half], xf[..., half:]
    return jnp.concatenate([x1 * cos - x2 * sin, x1 * sin + x2 * cos], axis=-1).astype(x.dtype)


def gated_delta_chunked(q, k, v, g, beta, S0):
    f32 = jnp.float32
    B, T, H, DK = q.shape
    DV = v.shape[-1]
    C = GDN_CHUNK
    N = -(-T // C)
    pad = N * C - T
    q = l2norm(q.astype(f32)) * (DK ** -0.5)
    k = l2norm(k.astype(f32))

    def chunks(x):
        x = jnp.pad(x.astype(f32), [(0, 0), (0, pad)] + [(0, 0)] * (x.ndim - 2))
        x = x.reshape((B, N, C) + x.shape[2:])
        return jnp.transpose(x, (1, 0, 3, 2) + tuple(range(4, x.ndim)))

    qc, kc, vc, gc, bc = chunks(q), chunks(k), chunks(v), chunks(g), chunks(beta)
    gc = jnp.cumsum(gc, axis=-1)
    idx = jnp.arange(C)
    incl = idx[:, None] >= idx[None, :]
    strict = idx[:, None] > idx[None, :]
    decay = jnp.exp(jnp.where(incl, gc[..., :, None] - gc[..., None, :], -jnp.inf))
    kb = kc * bc[..., None]
    L = jnp.where(strict, jnp.einsum('nbhcd,nbhsd->nbhcs', kb, kc) * decay, 0.0)
    eye = jnp.eye(C, dtype=f32)
    Tm = lax.linalg.triangular_solve(eye + L, jnp.broadcast_to(eye, L.shape),
                                     left_side=True, lower=True)
    u = jnp.einsum('nbhcs,nbhsv->nbhcv', Tm, vc * bc[..., None])
    w = jnp.einsum('nbhcs,nbhsd->nbhcd', Tm, kb * jnp.exp(gc)[..., None])
    A = jnp.einsum('nbhcd,nbhsd->nbhcs', qc, kc) * decay
    qg = qc * jnp.exp(gc)[..., None]
    kg = kc * jnp.exp(gc[..., -1:] - gc)[..., None]
    g_last = jnp.exp(gc[..., -1])

    def step(S, xs):
        u_n, w_n, A_n, qg_n, kg_n, gl_n = xs
        v_new = u_n - jnp.einsum('bhcd,bhdv->bhcv', w_n, S)
        o = jnp.einsum('bhcd,bhdv->bhcv', qg_n, S) + jnp.einsum('bhcs,bhsv->bhcv', A_n, v_new)
        S = S * gl_n[..., None, None] + jnp.einsum('bhcd,bhcv->bhdv', kg_n, v_new)
        return S, o

    S, o = lax.scan(step, S0.astype(f32), (u, w, A, qg, kg, g_last))
    o = jnp.transpose(o, (1, 0, 3, 2, 4)).reshape(B, N * C, H, DV)[:, :T]
    return o, S


def mla_attention(q_lat, q_pe, q_pos, c_all, kpe_all, k_pos):
    B, H, T, R = q_lat.shape
    QB = Q_BLOCK if T % Q_BLOCK == 0 else T
    NB = T // QB

    def blocks(a):
        return jnp.moveaxis(a.reshape(B, H, NB, QB, a.shape[-1]), 2, 0)

    def one_block(args):
        ql, qp, qpos = args
        s = (jnp.einsum('bhqr,bkr->bhqk', ql, c_all)
             + jnp.einsum('bhqp,bkp->bhqk', qp, kpe_all)).astype(jnp.float32) * MLA_SCALE
        s = jnp.where(k_pos[None, :] <= qpos[:, None], s, -jnp.inf)
        p = jax.nn.softmax(s, axis=-1).astype(c_all.dtype)
        return jnp.einsum('bhqk,bkr->bhqr', p, c_all)

    o = lax.map(one_block, (blocks(q_lat), blocks(q_pe), q_pos.reshape(NB, QB)))
    return jnp.moveaxis(o, 0, 2).reshape(B, H, T, R)


def hybrid_layer(x, past_ckv, past_kpe, S0, conv_hist, ffn_hist,
                 w_in, gdn_conv_w, gdn_A_log, gdn_dt_bias, gdn_norm_w,
                 mla_q_norm_w, mla_w_uq, mla_kv_norm_w, mla_w_uk, mla_w_uv,
                 w_out, ln1_g, ln1_b, ffn_w_up, ffn_conv_w, ffn_w_down, ln2_g, ln2_b):
    B, T, _ = x.shape
    f32 = jnp.float32
    pos = past_ckv.shape[1] + jnp.arange(T, dtype=jnp.int32)
    proj = x @ w_in
    qkv_raw, z, b_raw, a_raw, cq, ckv_raw, kpe_raw = split_cols(proj, GROUP_COLS)

    xh = jnp.concatenate([conv_hist, qkv_raw], axis=1)
    qkv = jax.nn.silu(causal_dwconv(xh, gdn_conv_w))
    new_conv = xh[:, -(GDN_CONV - 1):]
    q, k, v = split_cols(qkv, (GDN_HEADS * GDN_DK, GDN_HEADS * GDN_DK, GDN_HEADS * GDN_DV))
    q = q.reshape(B, T, GDN_HEADS, GDN_DK)
    k = k.reshape(B, T, GDN_HEADS, GDN_DK)
    v = v.reshape(B, T, GDN_HEADS, GDN_DV)
    beta = jax.nn.sigmoid(b_raw.astype(f32))
    g = -jnp.exp(gdn_A_log.astype(f32)) * jax.nn.softplus(a_raw.astype(f32) + gdn_dt_bias.astype(f32))
    o_gdn, S_new = gated_delta_chunked(q, k, v, g, beta, S0)
    o_gdn = rmsnorm(o_gdn.astype(x.dtype), gdn_norm_w) * jax.nn.silu(z.reshape(B, T, GDN_HEADS, GDN_DV))
    o_gdn = o_gdn.reshape(B, T, GDN_HEADS * GDN_DV)

    qh = (rmsnorm(cq, mla_q_norm_w) @ mla_w_uq).reshape(B, T, MLA_HEADS, MLA_NOPE + MLA_ROPE)
    q_nope = qh[..., :MLA_NOPE]
    q_pe = rope(qh[..., MLA_NOPE:], pos)
    c_new = rmsnorm(ckv_raw, mla_kv_norm_w)
    kpe_new = rope(kpe_raw, pos)
    c_all = jnp.concatenate([past_ckv, c_new], axis=1)
    kpe_all = jnp.concatenate([past_kpe, kpe_new], axis=1)
    k_pos = jnp.arange(c_all.shape[1], dtype=jnp.int32)
    q_lat = jnp.einsum('bthn,rhn->bhtr', q_nope, mla_w_uk)
    o_lat = mla_attention(q_lat, jnp.transpose(q_pe, (0, 2, 1, 3)), pos, c_all, kpe_all, k_pos)
    o_mla = jnp.einsum('bhtr,rhv->bthv', o_lat, mla_w_uv).reshape(B, T, MLA_HEADS * MLA_V)

    mix = jnp.concatenate([o_gdn, o_mla], axis=-1) @ w_out
    x1 = layernorm(ALPHA * x + mix, ln1_g, ln1_b)

    up = x1 @ ffn_w_up
    uh = jnp.concatenate([ffn_hist, up], axis=1)
    hc = causal_dwconv(uh, ffn_conv_w)
    new_ffn = uh[:, -(FFN_CONV - 1):]
    u_half, g_half = jnp.split(hc, 2, axis=-1)
    y = layernorm(ALPHA * x1 + (jax.nn.silu(g_half) * u_half) @ ffn_w_down, ln2_g, ln2_b)
    return y, c_new, kpe_new, S_new.astype(S0.dtype), new_conv, new_ffn


def setup_inputs(seed: int = 0) -> dict:
    key = jax.random.key(seed)
    ks = jax.random.split(key, 32)
    f32 = jnp.float32
    n_pages = PAST_LEN // PAGE_SIZE
    n_pool = (5 * DEC_BATCH * n_pages) // 4

    def nrm(k, shape, scale):
        return jax.random.normal(k, shape, f32) * scale

    def gain(k, n):
        return 1.0 + nrm(k, (DEPTH, n), 0.01)

    page_table = jax.random.permutation(ks[4], n_pool)[:DEC_BATCH * n_pages]
    page_table = page_table.reshape(DEC_BATCH, n_pages).astype(jnp.int32)
    return {
        "x_prompt": nrm(ks[0], (BATCH, SEQ, D_MODEL), 1.0),
        "x_sample": nrm(ks[1], (DEC_BATCH, DEC_SEQ, D_MODEL), 1.0),
        "cache_ckv": nrm(ks[2], (DEPTH, n_pool, PAGE_SIZE, MLA_KV_LORA), 1.0),
        "cache_kpe": nrm(ks[3], (DEPTH, n_pool, PAGE_SIZE, MLA_ROPE), 1.0),
        "page_table": page_table,
        "state_gdn": nrm(ks[5], (DEPTH, DEC_BATCH, GDN_HEADS, GDN_DK, GDN_DV), 0.1),
        "state_gdn_conv": nrm(ks[6], (DEPTH, DEC_BATCH, GDN_CONV - 1, GDN_CONV_DIM), 1.0),
        "state_ffn_conv": nrm(ks[7], (DEPTH, DEC_BATCH, FFN_CONV - 1, 2 * D_FF), 1.0),
        "w_in": nrm(ks[8], (DEPTH, D_MODEL, IN_COLS), D_MODEL ** -0.5),
        "gdn_conv_w": nrm(ks[9], (DEPTH, GDN_CONV, GDN_CONV_DIM), GDN_CONV ** -0.5),
        "gdn_A_log": jnp.log(jax.random.uniform(ks[10], (DEPTH, GDN_HEADS), f32, 1.0, 16.0)),
        "gdn_dt_bias": jax.random.uniform(ks[11], (DEPTH, GDN_HEADS), f32, -3.0, -1.0),
        "gdn_norm_w": gain(ks[12], GDN_DV),
        "mla_q_norm_w": gain(ks[13], MLA_Q_LORA),
        "mla_w_uq": nrm(ks[14], (DEPTH, MLA_Q_LORA, MLA_HEADS * (MLA_NOPE + MLA_ROPE)), MLA_Q_LORA ** -0.5),
        "mla_kv_norm_w": gain(ks[15], MLA_KV_LORA),
        "mla_w_uk": nrm(ks[16], (DEPTH, MLA_KV_LORA, MLA_HEADS, MLA_NOPE), MLA_KV_LORA ** -0.5),
        "mla_w_uv": nrm(ks[17], (DEPTH, MLA_KV_LORA, MLA_HEADS, MLA_V), MLA_KV_LORA ** -0.5),
        "w_out": nrm(ks[18], (DEPTH, MIX_WIDTH, D_MODEL), BETA_INIT * MIX_WIDTH ** -0.5),
        "ln1_g": gain(ks[19], D_MODEL),
        "ln1_b": nrm(ks[20], (DEPTH, D_MODEL), 0.01),
        "ffn_w_up": nrm(ks[21], (DEPTH, D_MODEL, 2 * D_FF), D_MODEL ** -0.5),
        "ffn_conv_w": nrm(ks[22], (DEPTH, FFN_CONV, 2 * D_FF), FFN_CONV ** -0.5),
        "ffn_w_down": nrm(ks[23], (DEPTH, D_FF, D_MODEL), BETA_INIT * D_FF ** -0.5),
        "ln2_g": gain(ks[24], D_MODEL),
        "ln2_b": nrm(ks[25], (DEPTH, D_MODEL), 0.01),
    }


def reference(x_prompt, x_sample, cache_ckv, cache_kpe, page_table, state_gdn, state_gdn_conv,
              state_ffn_conv, w_in, gdn_conv_w, gdn_A_log, gdn_dt_bias, gdn_norm_w,
              mla_q_norm_w, mla_w_uq, mla_kv_norm_w, mla_w_uk, mla_w_uv, w_out, ln1_g, ln1_b,
              ffn_w_up, ffn_conv_w, ffn_w_down, ln2_g, ln2_b):
    B = x_prompt.shape[0]
    DB = x_sample.shape[0]
    n_pages = page_table.shape[1]
    dt = x_prompt.dtype
    xp, xs = x_prompt, x_sample
    new_p = ([], [], [], [], [])
    new_s = ([], [], [], [], [])
    for l in range(DEPTH):
        params = (w_in[l], gdn_conv_w[l], gdn_A_log[l], gdn_dt_bias[l], gdn_norm_w[l],
                  mla_q_norm_w[l], mla_w_uq[l], mla_kv_norm_w[l], mla_w_uk[l], mla_w_uv[l],
                  w_out[l], ln1_g[l], ln1_b[l], ffn_w_up[l], ffn_conv_w[l], ffn_w_down[l],
                  ln2_g[l], ln2_b[l])
        xp, *st_p = hybrid_layer(
            xp, jnp.zeros((B, 0, MLA_KV_LORA), dt), jnp.zeros((B, 0, MLA_ROPE), dt),
            jnp.zeros((B, GDN_HEADS, GDN_DK, GDN_DV), dt),
            jnp.zeros((B, GDN_CONV - 1, GDN_CONV_DIM), dt),
            jnp.zeros((B, FFN_CONV - 1, 2 * D_FF), dt), *params)
        past_ckv = cache_ckv[l][page_table].reshape(DB, n_pages * PAGE_SIZE, MLA_KV_LORA)
        past_kpe = cache_kpe[l][page_table].reshape(DB, n_pages * PAGE_SIZE, MLA_ROPE)
        xs, *st_s = hybrid_layer(xs, past_ckv, past_kpe, state_gdn[l], state_gdn_conv[l],
                                 state_ffn_conv[l], *params)
        for lst, val in zip(new_p, st_p):
            lst.append(val)
        for lst, val in zip(new_s, st_s):
            lst.append(val)
    p_ckv, p_kpe, p_gdn, p_gdn_conv, p_ffn_conv = [jnp.stack(v) for v in new_p]
    s_ckv, s_kpe, s_gdn, s_gdn_conv, s_ffn_conv = [jnp.stack(v) for v in new_s]
    return (xp, xs, p_ckv, p_kpe, p_gdn, p_gdn_conv, p_ffn_conv,
            s_ckv, s_kpe, s_gdn, s_gdn_conv, s_ffn_conv)
```

```cpp
#include <hip/hip_runtime.h>
#include <cstdio>
#include <cstdint>
#include <cmath>
constexpr int D = 1024, BATCH = 32, SEQ = 2048, DB = 128, DT = 8, PAST = 16384, PAGE = 128, NPAGES = 128;
constexpr int MP = BATCH * SEQ, MS = DB * DT, M = MP + MS;
constexpr int H = 8, DK = 64, DV = 64, CONVD = 1536, GCONV = 4;
constexpr int QL = 256, KVL = 128, NOPE = 64, ROPE = 32, VD = 64;
constexpr int INC = 2480, N1 = 2560, FF = 2816, FF2 = 5632, NQ = 768;
constexpr float ALPHA = 1.189207115002721f;
constexpr float RMS_EPS = 1e-6f, LN_EPS = 1e-5f;
constexpr float MLA_SCALE = 0.10206207261596577f;
constexpr float LOG2E = 1.4426950408889634f;
constexpr float QSCALE = MLA_SCALE * LOG2E;
constexpr size_t O_Y = 0;
constexpr size_t O_PCKV = (size_t)M * D;
constexpr size_t O_PKPE = O_PCKV + (size_t)MP * KVL;
constexpr size_t O_PGDN = O_PKPE + (size_t)MP * ROPE;
constexpr size_t O_PGC = O_PGDN + (size_t)BATCH * H * DK * DV;
constexpr size_t O_PFC = O_PGC + (size_t)BATCH * 3 * CONVD;
constexpr size_t O_SCKV = O_PFC + (size_t)BATCH * 2 * FF2;
constexpr size_t O_SKPE = O_SCKV + (size_t)MS * KVL;
constexpr size_t O_SGDN = O_SKPE + (size_t)MS * ROPE;
constexpr size_t O_SGC = O_SGDN + (size_t)DB * H * DK * DV;
constexpr size_t O_SFC = O_SGC + (size_t)DB * 3 * CONVD;
constexpr size_t O_END = O_SFC + (size_t)DB * 2 * FF2;
static_assert(O_END == 86589440, "out size");
enum { I_XP = 0, I_XS, I_CCKV, I_CKPE, I_PT, I_SGDN, I_SGC, I_SFC, I_WIN, I_GCW, I_ALOG, I_DTB, I_GNW, I_QNW, I_WUQ, I_KVNW, I_WUK, I_WUV, I_WOUT, I_LN1G, I_LN1B, I_WUP, I_FCW, I_WDN, I_LN2G, I_LN2B, N_IN };
constexpr size_t MiB = 1u << 20;
constexpr size_t WS_CTL = 0;
constexpr size_t WS_ROPE = 1 * MiB;
constexpr size_t WS_W1T = 2 * MiB;
constexpr size_t WS_WUQT = 8 * MiB;
constexpr size_t WS_WUKVT = 9 * MiB;
constexpr size_t WS_WOUTT = 10 * MiB;
constexpr size_t WS_WUPT = 12 * MiB;
constexpr size_t WS_WDNT = 24 * MiB;
constexpr size_t WS_XB = 32 * MiB;
constexpr size_t WS_QKVR = 164 * MiB;
constexpr size_t WS_Z = 360 * MiB;
constexpr size_t WS_SM = 426 * MiB;
constexpr size_t WS_CQN = 558 * MiB;
constexpr size_t WS_CN = 592 * MiB;
constexpr size_t WS_KPE = 626 * MiB;
constexpr size_t WS_BG = 632 * MiB;
constexpr size_t WS_QP = 638 * MiB;
constexpr size_t WS_KNV = 736 * MiB;
constexpr size_t WS_MIX = 866 * MiB;
constexpr size_t WS_PRE1 = 998 * MiB;
constexpr size_t WS_X1B = 1260 * MiB;
constexpr size_t WS_U = 1392 * MiB;
constexpr size_t WS_HB = 2108 * MiB;
constexpr size_t WS_SPART = 2468 * MiB;
constexpr size_t WS_SLOW = 2560 * MiB;
constexpr size_t WS_NEED = 4600 * MiB;
typedef unsigned short bf16_t;
__device__ __host__ __forceinline__ float bf2f(bf16_t b) { unsigned u = (unsigned)b << 16; return __builtin_bit_cast(float, u); }
__device__ __host__ __forceinline__ bf16_t f2bf(float f) { unsigned u = __builtin_bit_cast(unsigned, f); return (bf16_t)((u + 0x7fffu + ((u >> 16) & 1u)) >> 16); }
__host__ __device__ __forceinline__ int map1(int n) { if (n < 2048) return n; if (n < 2304) return 2064 + (n - 2048); if (n < 2432) return 2320 + (n - 2304); if (n < 2464) return 2448 + (n - 2432); if (n < 2472) return 2048 + (n - 2464); if (n < 2480) return 2056 + (n - 2472); return -1; }
__host__ __device__ __forceinline__ int mapq(int n) { if (n < 512) return (n >> 6) * 96 + (n & 63); const int m = n - 512, h = m >> 5, j = m & 31; return h * 96 + 64 + (j >> 1) + 16 * (j & 1); }
__device__ __forceinline__ float silu_f(float x) { return x / (1.f + __expf(-x)); }
__device__ __forceinline__ float softplus_f(float x) { return x > 20.f ? x : log1pf(__expf(x)); }
__constant__ double c_invfreq[16] = {1.0, 0.5623413251903491, 0.31622776601683794, 0.1778279410038923, 0.1, 0.05623413251903491, 0.03162277660168379, 0.01778279410038923, 0.01, 0.005623413251903491, 0.0031622776601683794, 0.0017782794100389228, 0.001, 0.0005623413251903491, 0.00031622776601683794, 0.00017782794100389227};
__device__ __forceinline__ void rope_entry(int p, int i, float& c, float& s) {
    const double pos = (double)(p < SEQ ? p : PAST + (p - SEQ));
    const double rev = pos * c_invfreq[i] * 0.15915494309189535;
    const float fr = (float)(rev - __builtin_rint(rev));
    c = __builtin_amdgcn_cosf(fr); s = __builtin_amdgcn_sinf(fr);
}
#define GSTRIDE(i, n) for (size_t i = (size_t)blockIdx.x * blockDim.x + threadIdx.x; i < (size_t)(n); i += (size_t)gridDim.x * blockDim.x)

__global__ void ks_xb(const float* xp, const float* xs, bf16_t* XB) { GSTRIDE(i, (size_t)M * D) XB[i] = f2bf(i < (size_t)MP * D ? xp[i] : xs[i - (size_t)MP * D]); }
__global__ void ks_w1t(const float* w_in, bf16_t* W1T) { GSTRIDE(i, (size_t)N1 * D) { const int n = (int)(i / D), k = (int)(i % D), o = map1(n); W1T[i] = o < 0 ? (bf16_t)0 : f2bf(w_in[(size_t)k * INC + o]); } }
__global__ void ks_wuqt(const float* w_uq, const float* qnw, bf16_t* W) { GSTRIDE(i, (size_t)NQ * QL) { const int n = (int)(i / QL), k = (int)(i % QL); W[i] = f2bf(qnw[k] * w_uq[(size_t)k * NQ + mapq(n)]); } }
__global__ void ks_wukvt(const float* w_uk, const float* w_uv, bf16_t* W) { GSTRIDE(i, (size_t)1024 * 256) { const int n = (int)(i / 256), k = (int)(i % 256); float v = 0.f; if (k < KVL) v = n < 512 ? w_uk[(size_t)k * 512 + n] : w_uv[(size_t)k * 512 + (n - 512)]; W[i] = f2bf(v); } }
__global__ void ks_wt(const float* w, bf16_t* WT, int K, int N) { GSTRIDE(i, (size_t)N * K) { const int n = (int)(i / K), k = (int)(i % K); WT[i] = f2bf(w[(size_t)k * N + n]); } }
__global__ void ks_rope(float2* RT) { GSTRIDE(i, (size_t)(SEQ + DT) * 16) { float c, s; rope_entry((int)(i / 16), (int)(i % 16), c, s); RT[i] = make_float2(c, s); } }

template <class Epi> __global__ void __launch_bounds__(256) ks_gemm(const bf16_t* A, const bf16_t* Bt, long K, Epi epi) {
    __shared__ float As[32][65], Bs[32][65];
    const int tx = threadIdx.x & 15, ty = threadIdx.x >> 4, m0 = blockIdx.y * 64, n0 = blockIdx.x * 64;
    float acc[4][4];
#pragma unroll
    for (int i = 0; i < 4; ++i)
#pragma unroll
        for (int j = 0; j < 4; ++j) acc[i][j] = 0.f;
    for (int k0 = 0; k0 < K; k0 += 32) {
        for (int i = threadIdx.x; i < 2048; i += 256) { const int r = i >> 5, c = i & 31; As[c][r] = bf2f(A[(size_t)(m0 + r) * K + k0 + c]); Bs[c][r] = bf2f(Bt[(size_t)(n0 + r) * K + k0 + c]); }
        __syncthreads();
#pragma unroll 8
        for (int kk = 0; kk < 32; ++kk) {
            float a[4], b[4];
#pragma unroll
            for (int i = 0; i < 4; ++i) { a[i] = As[kk][ty * 4 + i]; b[i] = Bs[kk][tx * 4 + i]; }
#pragma unroll
            for (int i = 0; i < 4; ++i)
#pragma unroll
                for (int j = 0; j < 4; ++j) acc[i][j] += a[i] * b[j];
        }
        __syncthreads();
    }
#pragma unroll
    for (int i = 0; i < 4; ++i)
#pragma unroll
        for (int j = 0; j < 4; ++j) epi(m0 + ty * 4 + i, n0 + tx * 4 + j, acc[i][j]);
}
struct SE1 { bf16_t* QKVR; bf16_t* Z; float* SM; float* out;
    __device__ void operator()(int row, int col, float v) const {
        if (col < 1536) { QKVR[(size_t)row * 1536 + col] = f2bf(v);
            if (row < MP) { const int b = row / SEQ, t = row % SEQ; if (t >= SEQ - 3) out[O_PGC + ((size_t)b * 3 + (t - (SEQ - 3))) * CONVD + col] = v; }
            else { const int r = row - MP, sb = r / DT, t = r % DT; if (t >= DT - 3) out[O_SGC + ((size_t)sb * 3 + (t - (DT - 3))) * CONVD + col] = v; } }
        else if (col < 2048) Z[(size_t)row * 512 + col - 1536] = f2bf(v);
        else SM[(size_t)row * 512 + col - 2048] = v; } };
struct SEF32 { float* O; int ld; int pad; __device__ void operator()(int row, int col, float v) const { O[(size_t)row * ld + col] = v; } };
struct SEB16 { bf16_t* O; int ld; int pad; __device__ void operator()(int row, int col, float v) const { O[(size_t)row * ld + col] = f2bf(v); } };
struct SE5 { float* O; const float* xp; const float* xs; __device__ void operator()(int row, int col, float v) const { const float x = row < MP ? xp[(size_t)row * D + col] : xs[(size_t)(row - MP) * D + col]; O[(size_t)row * D + col] = v + ALPHA * x; } };
struct SE7 { bf16_t* U; float* out;
    __device__ void operator()(int row, int col, float v) const { U[(size_t)row * FF2 + col] = f2bf(v);
        if (row < MP) { const int b = row / SEQ, t = row % SEQ; if (t >= SEQ - 2) out[O_PFC + ((size_t)b * 2 + (t - (SEQ - 2))) * FF2 + col] = v; }
        else { const int r = row - MP, sb = r / DT, t = r % DT; if (t >= DT - 2) out[O_SFC + ((size_t)sb * 2 + (t - (DT - 2))) * FF2 + col] = v; } } };
struct SE9 { float* O; const float* X1; __device__ void operator()(int row, int col, float v) const { O[(size_t)row * D + col] = v + ALPHA * X1[(size_t)row * D + col]; } };

__global__ void ks_tok(const float* SM, const float* kvnw, const float* alog, const float* dtb, const float2* RT, bf16_t* CQN, bf16_t* CN, bf16_t* KPE, float* BG, float* out) {
    GSTRIDE(row, M) { const float* s = SM + row * 512; float ss = 0.f;
        for (int j = 0; j < 256; ++j) ss += s[j] * s[j];
        float r = rsqrtf(ss * (1.f / 256.f) + RMS_EPS);
        for (int j = 0; j < 256; ++j) CQN[row * 256 + j] = f2bf(s[j] * r);
        ss = 0.f; for (int j = 0; j < 128; ++j) ss += s[256 + j] * s[256 + j];
        r = rsqrtf(ss * (1.f / 128.f) + RMS_EPS);
        float* ockv = row < MP ? out + O_PCKV + row * KVL : out + O_SCKV + (row - MP) * KVL;
        float* okpe = row < MP ? out + O_PKPE + row * ROPE : out + O_SKPE + (row - MP) * ROPE;
        for (int j = 0; j < 128; ++j) { const float c = s[256 + j] * r * kvnw[j]; ockv[j] = c; CN[row * 256 + j] = f2bf(c); CN[row * 256 + 128 + j] = 0; }
        const int p = row < MP ? (int)(row % SEQ) : SEQ + (int)((row - MP) % DT);
        for (int i = 0; i < 16; ++i) { const float2 cs = RT[p * 16 + i]; const float x1 = s[384 + i], x2 = s[384 + 16 + i]; const float y1 = x1 * cs.x - x2 * cs.y, y2 = x1 * cs.y + x2 * cs.x;
            okpe[i] = y1; okpe[16 + i] = y2; KPE[row * 32 + 2 * i] = f2bf(y1); KPE[row * 32 + 2 * i + 1] = f2bf(y2); }
        for (int h = 0; h < 8; ++h) { BG[row * 16 + 8 + h] = 1.f / (1.f + __expf(-s[416 + h])); BG[row * 16 + h] = -__expf(alog[h]) * softplus_f(s[424 + h] + dtb[h]); } } }
__global__ void ks_qrope(const float* QR, const float2* RT, bf16_t* QP) {
    GSTRIDE(i, (size_t)M * 384) { const size_t row = i / 384; const int c2 = (int)(i % 384) * 2; const float a = QR[row * 768 + c2], b = QR[row * 768 + c2 + 1];
        if (c2 < 512) { QP[row * 768 + c2] = f2bf(a * QSCALE); QP[row * 768 + c2 + 1] = f2bf(b * QSCALE); }
        else { const int ii = ((c2 - 512) & 31) >> 1; const int p = row < MP ? (int)(row % SEQ) : SEQ + (int)((row - MP) % DT); const float2 cs = RT[p * 16 + ii];
            QP[row * 768 + c2] = f2bf((a * cs.x - b * cs.y) * QSCALE); QP[row * 768 + c2 + 1] = f2bf((a * cs.y + b * cs.x) * QSCALE); } } }
__global__ void ks_gconv(const bf16_t* QKVR, const float* hist, const float* cw, float* G) {
    GSTRIDE(i, (size_t)M * CONVD) { const size_t row = i / CONVD; const int c = (int)(i % CONVD); int t; size_t base; const float* hs = nullptr;
        if (row < MP) { t = (int)(row % SEQ); base = row - t; } else { const size_t r = row - MP; t = (int)(r % DT); base = row - t; hs = hist + (r / DT) * 3 * CONVD; }
        float a = 0.f;
        for (int j = 0; j < 4; ++j) { const int tt = t + j - 3; float x; if (tt >= 0) x = bf2f(QKVR[(base + tt) * CONVD + c]); else x = hs ? hs[(tt + 3) * CONVD + c] : 0.f; a += cw[j * CONVD + c] * x; }
        G[i] = silu_f(a); } }
__global__ void ks_gnorm(float* G) { GSTRIDE(i, (size_t)M * 16) { const size_t row = i / 16; const int w = (int)(i % 16); float* p = G + row * CONVD + w * 64; float ss = 0.f; for (int j = 0; j < 64; ++j) ss += p[j] * p[j];
        const float r = rsqrtf(ss + 1e-6f) * (w < 8 ? 0.125f : 1.f); for (int j = 0; j < 64; ++j) p[j] *= r; } }
__global__ void __launch_bounds__(64) ks_gdn(const float* G, const float* BG, const bf16_t* Z, const float* gnw, const float* S0, bf16_t* MIX, float* out) {
    const int chain = blockIdx.x, lane = threadIdx.x; int T, h; size_t row0; float* so; float S[64];
    if (chain < BATCH * H) { const int b = chain / H; h = chain % H; T = SEQ; row0 = (size_t)b * SEQ; so = out + O_PGDN + (size_t)chain * 4096;
#pragma unroll
        for (int d = 0; d < 64; ++d) S[d] = 0.f; }
    else { const int c2 = chain - BATCH * H, sb = c2 / H; h = c2 % H; T = DT; row0 = MP + (size_t)sb * DT; so = out + O_SGDN + (size_t)c2 * 4096;
#pragma unroll
        for (int d = 0; d < 64; ++d) S[d] = S0[(size_t)c2 * 4096 + d * 64 + lane]; }
    const float gw = gnw[lane];
    for (int t = 0; t < T; ++t) { const size_t row = row0 + t; const float g = BG[row * 16 + h], beta = BG[row * 16 + 8 + h], eg = __expf(g);
        const float* q = G + row * CONVD + h * 64; const float* k = q + 512; const float vt = G[row * CONVD + 1024 + h * 64 + lane];
        float ks = 0.f;
#pragma unroll
        for (int d = 0; d < 64; ++d) ks += k[d] * S[d];
        const float vn = beta * (vt - eg * ks); float o = 0.f;
#pragma unroll
        for (int d = 0; d < 64; ++d) { S[d] = eg * S[d] + k[d] * vn; o += q[d] * S[d]; }
        float ms = o * o;
#pragma unroll
        for (int x = 1; x < 64; x <<= 1) ms += __shfl_xor(ms, x);
        const float on = o * rsqrtf(ms * (1.f / 64.f) + RMS_EPS) * gw; const float zz = bf2f(Z[row * 512 + h * 64 + lane]);
        MIX[row * 1024 + h * 64 + lane] = f2bf(on * silu_f(zz)); }
#pragma unroll
    for (int d = 0; d < 64; ++d) so[d * 64 + lane] = S[d];
}
__global__ void __launch_bounds__(256) ks_attn_p(const bf16_t* QP, const bf16_t* KNV, const bf16_t* KPE, bf16_t* MIX) {
    const size_t gid = (size_t)blockIdx.x * 256 + threadIdx.x; const int q = (int)(gid % SEQ), h = (int)((gid / SEQ) % H), b = (int)(gid / ((size_t)SEQ * H));
    const size_t row = (size_t)b * SEQ + q; float qv[96], o[64];
#pragma unroll
    for (int i = 0; i < 64; ++i) { qv[i] = bf2f(QP[row * 768 + h * 64 + i]); o[i] = 0.f; }
#pragma unroll
    for (int i = 0; i < 32; ++i) qv[64 + i] = bf2f(QP[row * 768 + 512 + h * 32 + i]);
    float m = -INFINITY, l = 0.f;
    for (int key = 0; key <= q; ++key) { const size_t kr = (size_t)b * SEQ + key; const bf16_t* kn = KNV + kr * 1024 + h * 64; const bf16_t* kp = KPE + kr * 32; float s = 0.f;
#pragma unroll
        for (int i = 0; i < 64; ++i) s += qv[i] * bf2f(kn[i]);
#pragma unroll
        for (int i = 0; i < 32; ++i) s += qv[64 + i] * bf2f(kp[i]);
        const float mn = fmaxf(m, s), f = exp2f(m - mn), p = exp2f(s - mn); l = l * f + p; m = mn; const bf16_t* vv = kn + 512;
#pragma unroll
        for (int i = 0; i < 64; ++i) o[i] = o[i] * f + p * bf2f(vv[i]); }
    const float il = 1.f / l;
#pragma unroll
    for (int i = 0; i < 64; ++i) MIX[row * 1024 + 512 + h * 64 + i] = f2bf(o[i] * il);
}
__global__ void ks_qlat(const bf16_t* QP, const float* w_uk, float* QLAT) {
    GSTRIDE(i, (size_t)MS * 8 * 160) { const int r = (int)(i % 160), h = (int)((i / 160) % 8); const size_t row = MP + i / 1280; float a;
        if (r < 128) { a = 0.f; for (int n = 0; n < 64; ++n) a += bf2f(QP[row * 768 + h * 64 + n]) * w_uk[(size_t)r * 512 + h * 64 + n]; }
        else { const int p = r - 128; a = bf2f(QP[row * 768 + 512 + h * 32 + (p < 16 ? 2 * p : 2 * (p - 16) + 1)]); }
        QLAT[i] = a; } }
__global__ void __launch_bounds__(256) ks_score(const float* QLAT, const float* cckv, const float* ckpe, const int* pt, const float* out, float* SC) {
    const int sb = blockIdx.y, kk = blockIdx.x * 256 + threadIdx.x; if (kk >= PAST + DT) return;
    const float* kc; const float* kp;
    if (kk < PAST) { const size_t pg = (size_t)pt[sb * NPAGES + kk / PAGE] * PAGE + kk % PAGE; kc = cckv + pg * KVL; kp = ckpe + pg * ROPE; }
    else { const size_t r = (size_t)sb * DT + (kk - PAST); kc = out + O_SCKV + r * KVL; kp = out + O_SKPE + r * ROPE; }
    float acc[64];
#pragma unroll
    for (int j = 0; j < 64; ++j) acc[j] = 0.f;
    for (int r = 0; r < 160; ++r) { const float kv = r < 128 ? kc[r] : kp[r - 128];
#pragma unroll
        for (int j = 0; j < 64; ++j) acc[j] += kv * QLAT[((size_t)(sb * DT + (j & 7)) * 8 + (j >> 3)) * 160 + r]; }
#pragma unroll
    for (int j = 0; j < 64; ++j) { const bool vis = kk < PAST || (kk - PAST) <= (j & 7); SC[((size_t)sb * 64 + j) * (PAST + DT) + kk] = vis ? acc[j] : -INFINITY; }
}
__global__ void __launch_bounds__(64) ks_stats(const float* SC, float* ST) { const size_t r = blockIdx.x; const float* s = SC + r * (PAST + DT); float m = -INFINITY;
    for (int k = threadIdx.x; k < PAST + DT; k += 64) m = fmaxf(m, s[k]);
    for (int x = 1; x < 64; x <<= 1) m = fmaxf(m, __shfl_xor(m, x));
    float l = 0.f; for (int k = threadIdx.x; k < PAST + DT; k += 64) l += exp2f(s[k] - m);
    for (int x = 1; x < 64; x <<= 1) l += __shfl_xor(l, x);
    if (threadIdx.x == 0) { ST[r * 2] = m; ST[r * 2 + 1] = l; } }
__global__ void __launch_bounds__(128) ks_pv(const float* SC, const float* ST, const float* cckv, const int* pt, const float* out, float* OLAT) {
    const size_t r = blockIdx.x; const int sb = (int)(r / 64), c = threadIdx.x; const float* s = SC + r * (PAST + DT); const float m = ST[r * 2], il = 1.f / ST[r * 2 + 1]; float o = 0.f;
    for (int kk = 0; kk < PAST + DT; ++kk) { const float* kc;
        if (kk < PAST) kc = cckv + ((size_t)pt[sb * NPAGES + kk / PAGE] * PAGE + kk % PAGE) * KVL; else kc = out + O_SCKV + ((size_t)sb * DT + (kk - PAST)) * KVL;
        o += exp2f(s[kk] - m) * kc[c]; }
    OLAT[r * 128 + c] = o * il; }
__global__ void ks_omla(const float* OLAT, const float* w_uv, bf16_t* MIX) {
    GSTRIDE(i, (size_t)MS * 512) { const int v = (int)(i % 64), h = (int)((i / 64) % 8); const size_t rs = i / 512; const int sb = (int)(rs / DT), t = (int)(rs % DT);
        const float* o = OLAT + ((size_t)sb * 64 + h * 8 + t) * 128; float a = 0.f; for (int r = 0; r < 128; ++r) a += o[r] * w_uv[(size_t)r * 512 + h * 64 + v];
        MIX[(MP + rs) * 1024 + 512 + h * 64 + v] = f2bf(a); } }
__global__ void __launch_bounds__(256) ks_ln(const float* in, const float* g, const float* bta, float* outp, bf16_t* ob, int rows) {
    const int lane = threadIdx.x & 63; const size_t row = (size_t)blockIdx.x * 4 + (threadIdx.x >> 6); if (row >= (size_t)rows) return;
    const float* x = in + row * D; float v[16]; float s = 0.f;
#pragma unroll
    for (int j = 0; j < 16; ++j) { v[j] = x[lane + 64 * j]; s += v[j]; }
    for (int o = 1; o < 64; o <<= 1) s += __shfl_xor(s, o);
    const float mu = s * (1.f / D); float q = 0.f;
#pragma unroll
    for (int j = 0; j < 16; ++j) { v[j] -= mu; q += v[j] * v[j]; }
    for (int o = 1; o < 64; o <<= 1) q += __shfl_xor(q, o);
    const float rs = rsqrtf(q * (1.f / D) + LN_EPS);
#pragma unroll
    for (int j = 0; j < 16; ++j) { const int c = lane + 64 * j; const float y = v[j] * rs * g[c] + bta[c]; outp[row * D + c] = y; if (ob) ob[row * D + c] = f2bf(y); } }
__global__ void ks_cg(const bf16_t* U, const float* hist, const float* cw, bf16_t* HB) {
    GSTRIDE(i, (size_t)M * FF) { const size_t row = i / FF; const int c = (int)(i % FF); int t; size_t base; const float* hs = nullptr;
        if (row < MP) { t = (int)(row % SEQ); base = row - t; } else { const size_t r = row - MP; t = (int)(r % DT); base = row - t; hs = hist + (r / DT) * 2 * FF2; }
        float au = 0.f, ag = 0.f;
        for (int j = 0; j < 3; ++j) { const int tt = t + j - 2; float xu, xg; if (tt >= 0) { xu = bf2f(U[(base + tt) * FF2 + c]); xg = bf2f(U[(base + tt) * FF2 + FF + c]); } else { xu = hs ? hs[(tt + 2) * FF2 + c] : 0.f; xg = hs ? hs[(tt + 2) * FF2 + FF + c] : 0.f; }
            au += cw[j * FF2 + c] * xu; ag += cw[j * FF2 + FF + c] * xg; }
        HB[i] = f2bf(silu_f(ag) * au); } }
struct Bufs { const float* in[N_IN]; const int* pt; float* out; unsigned char* ws;
    bf16_t *XB, *W1T, *WUQT, *WUKVT, *WOUTT, *WUPT, *WDNT, *QKVR, *Z, *CQN, *CN, *KPE, *QP, *KNV, *MIX, *X1B, *U, *HB; float *SM, *BG, *PRE1; float2* RT; };
static Bufs make_bufs(void* const* d_in, void* d_out, void* d_ws) {
    Bufs b{}; for (int i = 0; i < N_IN; ++i) b.in[i] = (const float*)d_in[i]; b.pt = (const int*)d_in[I_PT]; b.out = (float*)d_out; unsigned char* w = (unsigned char*)d_ws; b.ws = w;
    b.XB = (bf16_t*)(w + WS_XB); b.W1T = (bf16_t*)(w + WS_W1T); b.WUQT = (bf16_t*)(w + WS_WUQT); b.WUKVT = (bf16_t*)(w + WS_WUKVT); b.WOUTT = (bf16_t*)(w + WS_WOUTT); b.WUPT = (bf16_t*)(w + WS_WUPT); b.WDNT = (bf16_t*)(w + WS_WDNT);
    b.QKVR = (bf16_t*)(w + WS_QKVR); b.Z = (bf16_t*)(w + WS_Z); b.CQN = (bf16_t*)(w + WS_CQN); b.CN = (bf16_t*)(w + WS_CN); b.KPE = (bf16_t*)(w + WS_KPE); b.QP = (bf16_t*)(w + WS_QP); b.KNV = (bf16_t*)(w + WS_KNV);
    b.MIX = (bf16_t*)(w + WS_MIX); b.X1B = (bf16_t*)(w + WS_X1B); b.U = (bf16_t*)(w + WS_U); b.HB = (bf16_t*)(w + WS_HB); b.SM = (float*)(w + WS_SM); b.BG = (float*)(w + WS_BG); b.PRE1 = (float*)(w + WS_PRE1); b.RT = (float2*)(w + WS_ROPE);
    return b; }
#define GS 2048, 256, 0, st
static void slow_u0(const Bufs& b, hipStream_t st) {
    ks_xb<<<GS>>>(b.in[I_XP], b.in[I_XS], b.XB); ks_w1t<<<GS>>>(b.in[I_WIN], b.W1T); ks_wuqt<<<GS>>>(b.in[I_WUQ], b.in[I_QNW], b.WUQT); ks_wukvt<<<GS>>>(b.in[I_WUK], b.in[I_WUV], b.WUKVT);
    ks_wt<<<GS>>>(b.in[I_WOUT], b.WOUTT, 1024, 1024); ks_wt<<<GS>>>(b.in[I_WUP], b.WUPT, 1024, FF2); ks_wt<<<GS>>>(b.in[I_WDN], b.WDNT, FF, 1024); ks_rope<<<GS>>>(b.RT); }
static void slow_u1(const Bufs& b, hipStream_t st) { ks_gemm<SE1><<<dim3(N1 / 64, M / 64), 256, 0, st>>>(b.XB, b.W1T, 1024, SE1{b.QKVR, b.Z, b.SM, b.out}); }
static void slow_u2(const Bufs& b, hipStream_t st) { ks_tok<<<GS>>>(b.SM, b.in[I_KVNW], b.in[I_ALOG], b.in[I_DTB], b.RT, b.CQN, b.CN, b.KPE, b.BG, b.out); }
static void slow_u3(const Bufs& b, hipStream_t st) { float* QR = (float*)(b.ws + WS_SLOW);
    ks_gemm<SEF32><<<dim3(NQ / 64, M / 64), 256, 0, st>>>(b.CQN, b.WUQT, 256, SEF32{QR, NQ, 0}); ks_qrope<<<GS>>>(QR, b.RT, b.QP);
    ks_gemm<SEB16><<<dim3(1024 / 64, MP / 64), 256, 0, st>>>(b.CN, b.WUKVT, 256, SEB16{b.KNV, 1024, 0}); }
static void slow_u4a(const Bufs& b, hipStream_t st) { ks_attn_p<<<(unsigned)((size_t)MP * H / 256), 256, 0, st>>>(b.QP, b.KNV, b.KPE, b.MIX); }
static void slow_u4bd(const Bufs& b, hipStream_t st, int which  ) { float* G = (float*)(b.ws + WS_SLOW + 256 * MiB);
    ks_gconv<<<GS>>>(b.QKVR, b.in[I_SGC], b.in[I_GCW], G); ks_gnorm<<<GS>>>(G);
    if (which == 3) ks_gdn<<<BATCH * H + DB * H, 64, 0, st>>>(G, b.BG, b.Z, b.in[I_GNW], b.in[I_SGDN], b.MIX, b.out); }
static void slow_u4c(const Bufs& b, hipStream_t st) { unsigned char* s = b.ws + WS_SLOW + 700 * MiB; float* QLAT = (float*)s; float* SC = (float*)(s + 8 * MiB); float* ST = (float*)(s + 560 * MiB); float* OLAT = (float*)(s + 562 * MiB);
    ks_qlat<<<GS>>>(b.QP, b.in[I_WUK], QLAT); ks_score<<<dim3((PAST + DT + 255) / 256, DB), 256, 0, st>>>(QLAT, b.in[I_CCKV], b.in[I_CKPE], b.pt, b.out, SC);
    ks_stats<<<DB * 64, 64, 0, st>>>(SC, ST); ks_pv<<<DB * 64, 128, 0, st>>>(SC, ST, b.in[I_CCKV], b.pt, b.out, OLAT); ks_omla<<<GS>>>(OLAT, b.in[I_WUV], b.MIX); }
static void slow_u5(const Bufs& b, hipStream_t st) { ks_gemm<SE5><<<dim3(D / 64, M / 64), 256, 0, st>>>(b.MIX, b.WOUTT, 1024, SE5{b.PRE1, b.in[I_XP], b.in[I_XS]}); }
static void slow_u6(const Bufs& b, hipStream_t st) { ks_ln<<<M / 4, 256, 0, st>>>(b.PRE1, b.in[I_LN1G], b.in[I_LN1B], b.PRE1, b.X1B, M); }
static void slow_u7(const Bufs& b, hipStream_t st) { ks_gemm<SE7><<<dim3(FF2 / 64, M / 64), 256, 0, st>>>(b.X1B, b.WUPT, 1024, SE7{b.U, b.out}); }
static void slow_u8(const Bufs& b, hipStream_t st) { ks_cg<<<GS>>>(b.U, b.in[I_SFC], b.in[I_FCW], b.HB); }
static void slow_u9(const Bufs& b, hipStream_t st) { ks_gemm<SE9><<<dim3(D / 64, M / 64), 256, 0, st>>>(b.HB, b.WDNT, FF, SE9{b.out + O_Y, b.PRE1}); }
static void slow_u10(const Bufs& b, hipStream_t st) { ks_ln<<<M / 4, 256, 0, st>>>(b.out + O_Y, b.in[I_LN2G], b.in[I_LN2B], b.out + O_Y, nullptr, M); }
extern "C" void kernel_launch(void* const* d_in, const int* in_sizes, int n_in, void* d_out, int out_size, void* d_ws, size_t ws_size, hipStream_t stream) {
    if (n_in != N_IN || (size_t)out_size != O_END || ws_size < WS_NEED) { fprintf(stderr, "kernel_launch: unexpected sizes n_in %d out %d ws %zu\n", n_in, out_size, ws_size); return; }
    const Bufs b = make_bufs(d_in, d_out, d_ws); hipStream_t st = stream;
    slow_u0(b, st); slow_u1(b, st); slow_u2(b, st); slow_u3(b, st); slow_u4a(b, st); slow_u4bd(b, st, 3); slow_u4c(b, st);
    slow_u5(b, st); slow_u6(b, st); slow_u7(b, st); slow_u8(b, st); slow_u9(b, st); slow_u10(b, st);
}
```

```cpp
#include <hip/hip_runtime.h>
#include <cstdio>
#include <cstdint>
#include <cmath>
constexpr int D = 1024, BATCH = 32, SEQ = 2048, DB = 128, DT = 8, PAST = 16384, PAGE = 128, NPAGES = 128;
constexpr int MP = BATCH * SEQ, MS = DB * DT, M = MP + MS;
constexpr int H = 8, DK = 64, DV = 64, CONVD = 1536, GCONV = 4;
constexpr int QL = 256, KVL = 128, NOPE = 64, ROPE = 32, VD = 64;
constexpr int INC = 2480, N1 = 2560, FF = 2816, FF2 = 5632, NQ = 768;
constexpr float ALPHA = 1.189207115002721f;
constexpr float RMS_EPS = 1e-6f, LN_EPS = 1e-5f;
constexpr float MLA_SCALE = 0.10206207261596577f;
constexpr float LOG2E = 1.4426950408889634f;
constexpr float QSCALE = MLA_SCALE * LOG2E;
constexpr size_t O_Y = 0;
constexpr size_t O_PCKV = (size_t)M * D;
constexpr size_t O_PKPE = O_PCKV + (size_t)MP * KVL;
constexpr size_t O_PGDN = O_PKPE + (size_t)MP * ROPE;
constexpr size_t O_PGC = O_PGDN + (size_t)BATCH * H * DK * DV;
constexpr size_t O_PFC = O_PGC + (size_t)BATCH * 3 * CONVD;
constexpr size_t O_SCKV = O_PFC + (size_t)BATCH * 2 * FF2;
constexpr size_t O_SKPE = O_SCKV + (size_t)MS * KVL;
constexpr size_t O_SGDN = O_SKPE + (size_t)MS * ROPE;
constexpr size_t O_SGC = O_SGDN + (size_t)DB * H * DK * DV;
constexpr size_t O_SFC = O_SGC + (size_t)DB * 3 * CONVD;
constexpr size_t O_END = O_SFC + (size_t)DB * 2 * FF2;
static_assert(O_END == 86589440, "out size");
enum { I_XP = 0, I_XS, I_CCKV, I_CKPE, I_PT, I_SGDN, I_SGC, I_SFC, I_WIN, I_GCW, I_ALOG, I_DTB, I_GNW, I_QNW, I_WUQ, I_KVNW, I_WUK, I_WUV, I_WOUT, I_LN1G, I_LN1B, I_WUP, I_FCW, I_WDN, I_LN2G, I_LN2B, N_IN };
constexpr size_t MiB = 1u << 20;
constexpr size_t WS_CTL = 0;
constexpr size_t WS_ROPE = 1 * MiB;
constexpr size_t WS_W1T = 2 * MiB;
constexpr size_t WS_WUQT = 8 * MiB;
constexpr size_t WS_WUKVT = 9 * MiB;
constexpr size_t WS_WOUTT = 10 * MiB;
constexpr size_t WS_WUPT = 12 * MiB;
constexpr size_t WS_WDNT = 24 * MiB;
constexpr size_t WS_XB = 32 * MiB;
constexpr size_t WS_QKVR = 164 * MiB;
constexpr size_t WS_Z = 360 * MiB;
constexpr size_t WS_SM = 426 * MiB;
constexpr size_t WS_CQN = 558 * MiB;
constexpr size_t WS_CN = 592 * MiB;
constexpr size_t WS_KPE = 626 * MiB;
constexpr size_t WS_BG = 632 * MiB;
constexpr size_t WS_QP = 638 * MiB;
constexpr size_t WS_KNV = 736 * MiB;
constexpr size_t WS_MIX = 866 * MiB;
constexpr size_t WS_PRE1 = 998 * MiB;
constexpr size_t WS_X1B = 1260 * MiB;
constexpr size_t WS_U = 1392 * MiB;
constexpr size_t WS_HB = 2108 * MiB;
constexpr size_t WS_SPART = 2468 * MiB;
constexpr size_t WS_SLOW = 2560 * MiB;
constexpr size_t WS_NEED = 4600 * MiB;
typedef unsigned short bf16_t;
__device__ __host__ __forceinline__ float bf2f(bf16_t b) { unsigned u = (unsigned)b << 16; return __builtin_bit_cast(float, u); }
__device__ __host__ __forceinline__ bf16_t f2bf(float f) { unsigned u = __builtin_bit_cast(unsigned, f); return (bf16_t)((u + 0x7fffu + ((u >> 16) & 1u)) >> 16); }
__host__ __device__ __forceinline__ int map1(int n) { if (n < 2048) return n; if (n < 2304) return 2064 + (n - 2048); if (n < 2432) return 2320 + (n - 2304); if (n < 2464) return 2448 + (n - 2432); if (n < 2472) return 2048 + (n - 2464); if (n < 2480) return 2056 + (n - 2472); return -1; }
__host__ __device__ __forceinline__ int mapq(int n) { if (n < 512) return (n >> 6) * 96 + (n & 63); const int m = n - 512, h = m >> 5, j = m & 31; return h * 96 + 64 + (j >> 1) + 16 * (j & 1); }
__device__ __forceinline__ float silu_f(float x) { return x * __builtin_amdgcn_rcpf(1.f + __builtin_amdgcn_exp2f(-1.4426950408889634f * x)); }
__device__ __forceinline__ float softplus_f(float x) { return x > 20.f ? x : log1pf(__expf(x)); }
__constant__ double c_invfreq[16] = {1.0, 0.5623413251903491, 0.31622776601683794, 0.1778279410038923, 0.1, 0.05623413251903491, 0.03162277660168379, 0.01778279410038923, 0.01, 0.005623413251903491, 0.0031622776601683794, 0.0017782794100389228, 0.001, 0.0005623413251903491, 0.00031622776601683794, 0.00017782794100389227};
__device__ __forceinline__ void rope_entry(int p, int i, float& c, float& s) {
    const double pos = (double)(p < SEQ ? p : PAST + (p - SEQ));
    const double rev = pos * c_invfreq[i] * 0.15915494309189535;
    const float fr = (float)(rev - __builtin_rint(rev));
    c = __builtin_amdgcn_cosf(fr); s = __builtin_amdgcn_sinf(fr);
}
#define GAS __attribute__((address_space(1)))
#define LAS __attribute__((address_space(3)))
typedef unsigned v4u __attribute__((ext_vector_type(4)));
typedef float f32x4 __attribute__((ext_vector_type(4)));
typedef short bf16x8 __attribute__((ext_vector_type(8)));
typedef GAS unsigned gu32;
typedef GAS unsigned long long gu64;
#define RLX_AGENT __ATOMIC_RELAXED, __HIP_MEMORY_SCOPE_AGENT
#define LDS_WAIT() asm volatile("s_waitcnt lgkmcnt(0)" ::: "memory")
#define VM_WAIT() asm volatile("s_waitcnt vmcnt(0)" ::: "memory")
__device__ __forceinline__ unsigned long long rt() { return __builtin_amdgcn_s_memrealtime(); }
#define XB_TMO      128
#define XB_XCNT(j)  (256  + 64 * (j))
#define XB_XSUB(j)  (1280 + 64 * (j))
#define XB_XGEN(j)  (2304 + 64 * (j))
#define XB_TOP      3328
#define XB_TOPGEN   3392
#define XCD_BAR_WORDS 3456
#define XB_SPIN_CAP (1u << 18)

__device__ __forceinline__ unsigned xb_ld(unsigned* p)              { return __hip_atomic_load(p, __ATOMIC_RELAXED, __HIP_MEMORY_SCOPE_AGENT); }
__device__ __forceinline__ unsigned xb_add(unsigned* p, unsigned v) { return __hip_atomic_fetch_add(p, v, __ATOMIC_RELAXED, __HIP_MEMORY_SCOPE_AGENT); }
__device__ __forceinline__ unsigned xb_xcc_id() { return (unsigned)__builtin_amdgcn_s_getreg((3 << 11) | 20) & 0xFu; }
#define XB_SPIN(cond, bar) do { unsigned _sp = 0; while (cond) { __builtin_amdgcn_s_sleep(1); \
    if ((++_sp & 255u) == 0u) { if (xb_ld(&(bar)[XB_TMO])) break; if (_sp > XB_SPIN_CAP) { atomicAdd(&(bar)[XB_TMO], 1u); break; } } } } while (0)

struct XcdBarrier {
    unsigned* bar; unsigned x; unsigned lead;
    volatile LAS unsigned* st;
};

__device__ __forceinline__ bool xb_lane0() { int l; asm volatile("v_mbcnt_lo_u32_b32 %0, -1, 0\n\tv_mbcnt_hi_u32_b32 %0, -1, %0" : "=v"(l)); return l == 0; }
__device__ __forceinline__ XcdBarrier xcd_barrier_post(unsigned* bar, volatile LAS unsigned* st, unsigned lead  ) {
    XcdBarrier b; b.bar = bar; b.x = xb_xcc_id(); b.st = st; b.lead = lead;
    if (b.lead && xb_lane0()) (void)xb_add(&bar[XB_XCNT(b.x)], 1u);
    return b;
}
__device__ __forceinline__ void xcd_barrier_complete(unsigned* bar, unsigned x, unsigned& nloc, unsigned& nx) {
    const unsigned G = gridDim.x * gridDim.y * gridDim.z;
    unsigned sum, cnt, mine, sp = 0u;
    for (;;) {
        sum = 0u; cnt = 0u; mine = 0u;
#pragma unroll
        for (unsigned j = 0; j < 16; ++j) { const unsigned c = xb_ld(&bar[XB_XCNT(j)]); sum += c; cnt += (c > 0u) ? 1u : 0u; mine = (j == x) ? c : mine; }
        if (sum == G) break;
        __builtin_amdgcn_s_sleep(1);
        if ((++sp & 255u) == 0u) { if (xb_ld(&bar[XB_TMO])) break; if (sp > XB_SPIN_CAP) { atomicAdd(&bar[XB_TMO], 1u); break; } }
    }
    nloc = mine > 0u ? mine : 1u; nx = cnt > 0u ? cnt : 1u;
}

__device__ __forceinline__ void xcd_barrier(const XcdBarrier& b) {
    asm volatile("s_waitcnt vmcnt(0)" ::: "memory");
    __syncthreads();
    if (b.lead && xb_lane0()) {
        unsigned* bar = b.bar;
        __builtin_amdgcn_s_waitcnt(0);
        unsigned nloc = b.st[0], nx = b.st[1];
        if (nloc == 0u) { xcd_barrier_complete(bar, b.x, nloc, nx); b.st[0] = nloc; b.st[1] = nx; }
        const unsigned old = xb_add(&bar[XB_XSUB(b.x)], 1u);
        const unsigned gen = old / nloc;
        if (old + 1u == (gen + 1u) * nloc) {
            __builtin_amdgcn_fence(__ATOMIC_RELEASE, "agent");
            asm volatile("s_waitcnt vmcnt(0)" ::: "memory");
            const unsigned og = xb_add(&bar[XB_TOP], 1u);
            const unsigned tg = og / nx;
            if (og + 1u == (tg + 1u) * nx) xb_add(&bar[XB_TOPGEN], 1u);
            else XB_SPIN(xb_ld(&bar[XB_TOPGEN]) == tg, bar);
            __builtin_amdgcn_fence(__ATOMIC_ACQUIRE, "agent");
            xb_add(&bar[XB_XGEN(b.x)], 1u);
            asm volatile("s_waitcnt vmcnt(0)" ::: "memory");
        } else {
            XB_SPIN(xb_ld(&bar[XB_XGEN(b.x)]) == gen, bar);
            __builtin_amdgcn_fence(__ATOMIC_ACQUIRE, "agent");
            asm volatile("s_waitcnt vmcnt(0)" ::: "memory");
        }
    }
    __syncthreads();
}
namespace pg8 {
#define PG8_LAS __attribute__((address_space(3)))
typedef unsigned short bf16_t;
typedef short bf16x8 __attribute__((ext_vector_type(8)));
typedef float f32x4 __attribute__((ext_vector_type(4)));
typedef unsigned u32x4 __attribute__((ext_vector_type(4)));
constexpr int BM = 256, BK = 64, HALF = 128, HTB = HALF * BK * 2  , STAGE_BYTES = 8 * HTB, NXCD = 8, WGM = 8;

__host__ __device__ __forceinline__ int lds_byte(int r, int c) { const int st = (r >> 4) * 2 + (c >> 5), rr = r & 15, cc = c & 31, ob = rr * 64 + cc * 2; return st * 1024 + (ob ^ (((ob >> 9) & 1) << 5)); }
__host__ __device__ __forceinline__ void stage_rc(int b, int& R, int& C) { const int st = b / 1024, sb = b % 1024, swz = sb ^ (((sb >> 9) & 1) << 5); R = (st >> 1) * 16 + swz / 64; C = (st & 1) * 32 + (swz % 64) / 2; }
__host__ __device__ __forceinline__ int perm32(int rho) { const int n = rho >> 4, i = rho & 15; return 8 * (i >> 2) + 4 * n + (i & 3); }

struct Unit { int pm, pn; };
struct Gemm { const bf16_t* A; const bf16_t* Bt; int M, N, K; };

struct StaticOrder {
    int nM, nN, nwg, G, c, wgm, pnfast;
    __host__ __device__ void init(int M, int N, int G_, int c_, int wgm_ = WGM, int pnfast_ = 0) { nM = M / BM; nN = N / BM; nwg = nM * nN; G = G_; c = c_; wgm = wgm_; pnfast = pnfast_; }
    __host__ __device__ bool next(int i, Unit& u) const {
        const long L = (long)i * G + c; if (L >= nwg) return false;
        int wgid = (int)L; { const int q = nwg / NXCD, r = nwg % NXCD, xcd = wgid % NXCD, off = wgid / NXCD; wgid = (xcd < r ? xcd * (q + 1) : r * (q + 1) + (xcd - r) * q) + off; }
        const int nig = wgm * nN, gid = wgid / nig, fm = gid * wgm, gsz = (nM - fm) < wgm ? (nM - fm) : wgm;
        if (pnfast) { u.pm = fm + (wgid % nig) / nN; u.pn = (wgid % nig) % nN; } else { u.pm = fm + ((wgid % nig) % gsz); u.pn = (wgid % nig) / gsz; }     return true;
    }
    __device__ __forceinline__ void a_ready(const Unit&) const {}
    __device__ __forceinline__ void done(const Unit&) const {}
};

__device__ __forceinline__ unsigned cvt_pk_bf16(float lo, float hi) { unsigned r; asm volatile("v_cvt_pk_bf16_f32 %0, %1, %2" : "=v"(r) : "v"(lo), "v"(hi)); return r; }
typedef float f32x2 __attribute__((ext_vector_type(2)));
template <class Epi, class Sched, bool ALIGN_EPI = false, bool SP2 = false>
__device__ __forceinline__ void gemm_phase(PG8_LAS unsigned char* lds, const Gemm g, const Sched& S, const Epi& E, const int wave_in) {
    int lane_; asm volatile("v_mbcnt_lo_u32_b32 %0, -1, 0\n\tv_mbcnt_hi_u32_b32 %0, -1, %0" : "=v"(lane_));
    const int lane = lane_, wid = wave_in, tid = wid * 64 + lane,
        wr = wid >> 2, wc = wid & 3, fr = lane & 15, fq = lane >> 4;
    int K_ = g.K; asm volatile("" : "+s"(K_));
    const int K = K_, nt = K / BK;
    unsigned voffA[2], voffB[2];
#pragma unroll
    for (int i = 0; i < 2; ++i) { int R, C; stage_rc(tid * 16 + i * 8192, R, C); const int Rb = Epi::PERM ? ((R & ~31) + perm32(R & 31)) : R;
        const int Ra = Epi::APERM ? ((R & 64) + 4 * (R & 15) + ((R >> 4) & 3)) : R;
        voffA[i] = (unsigned)(Ra * K + C) * 2u; voffB[i] = (unsigned)(Rb * K + C) * 2u; }
    const size_t kstep = (size_t)(BK * 2);
    const size_t hstep = (size_t)HALF * K * 2;
    const size_t tstep = 2 * hstep;
    const unsigned ldsw = (unsigned)wid * 1024u;
    const int aoff = lds_byte(wr * 64 + fr, fq * 8), boff = lds_byte(wc * 32 + fr, fq * 8);
#define PG8_SA(b, h) (((b) * 2 + (h)) * HTB)
#define PG8_SB(b, h) ((4 + (b) * 2 + (h)) * HTB)
#define PG8_STAGE(bufoff, gbase, voff) do { _Pragma("unroll") for (int _i = 0; _i < 2; ++_i) \
        __builtin_amdgcn_global_load_lds((const unsigned*)((const char*)(gbase) + (voff)[_i]), (PG8_LAS unsigned*)(lds + (bufoff) + ldsw + _i * 8192), 16, 0, 0); } while (0)
#define PG8_LDA(dst, b, h) do { _Pragma("unroll") for (int m = 0; m < 4; ++m) _Pragma("unroll") for (int k = 0; k < 2; ++k) dst[m][k] = *(const PG8_LAS bf16x8*)(lds + PG8_SA(b, h) + aoff + m * 2048 + k * 1024); } while (0)
#define PG8_LDB(dst, b, h) do { _Pragma("unroll") for (int n = 0; n < 2; ++n) _Pragma("unroll") for (int k = 0; k < 2; ++k) dst[n][k] = *(const PG8_LAS bf16x8*)(lds + PG8_SB(b, h) + boff + n * 2048 + k * 1024); } while (0)
#define PG8_MMA(ai, bj, At, Bt) do { __builtin_amdgcn_s_setprio(1); _Pragma("unroll") for (int m = 0; m < 4; ++m) _Pragma("unroll") for (int n = 0; n < 2; ++n) _Pragma("unroll") for (int k = 0; k < 2; ++k) \
        acc[ai][bj][m][n] = __builtin_amdgcn_mfma_f32_16x16x32_bf16(Bt[n][k], At[m][k], acc[ai][bj][m][n], 0, 0, 0); __builtin_amdgcn_s_setprio(0); } while (0)
#define PG8_WAIT_V(n) asm volatile("s_waitcnt vmcnt(" #n ")" ::: "memory")
#define PG8_WAIT_L(n) asm volatile("s_waitcnt lgkmcnt(" #n ")" ::: "memory")
#define PG8_BAR __builtin_amdgcn_s_barrier()
#define PG8_SCHED __builtin_amdgcn_sched_barrier(0)
    Unit cur, nxt; int ui = 0;
    if (!S.next(0, cur)) return;
    f32x4 acc[2][2][4][2];
#pragma unroll
    for (int a = 0; a < 2; ++a)
#pragma unroll
        for (int b = 0; b < 2; ++b)
#pragma unroll
            for (int m = 0; m < 4; ++m)
#pragma unroll
                for (int n = 0; n < 2; ++n) acc[a][b][m][n] = (f32x4){0.f, 0.f, 0.f, 0.f};
    bf16x8 At[4][2], B0[2][2], B1[2][2];
    const char* cA = (const char*)g.A + (size_t)cur.pm * tstep; const char* cB = (const char*)g.Bt + (size_t)cur.pn * tstep;
    S.a_ready(cur);
    if constexpr (SP2) {
        PG8_STAGE(PG8_SB(0, 0), cB, voffB); PG8_STAGE(PG8_SB(0, 1), cB + hstep, voffB); PG8_STAGE(PG8_SA(0, 0), cA, voffA); PG8_STAGE(PG8_SA(0, 1), cA + hstep, voffA);
        if (wr == 1) PG8_BAR;
        PG8_WAIT_V(2); PG8_BAR;
        PG8_STAGE(PG8_SB(1, 0), cB + kstep, voffB); PG8_STAGE(PG8_SA(1, 0), cA + kstep, voffA); PG8_STAGE(PG8_SB(1, 1), cB + hstep + kstep, voffB);
        PG8_WAIT_V(6); PG8_BAR;
    } else {
        PG8_STAGE(PG8_SB(0, 0), cB, voffB); PG8_STAGE(PG8_SA(0, 0), cA, voffA); PG8_STAGE(PG8_SB(0, 1), cB + hstep, voffB); PG8_STAGE(PG8_SA(0, 1), cA + hstep, voffA);
        if (wr == 1) PG8_BAR;
        PG8_WAIT_V(4); PG8_BAR;
        PG8_STAGE(PG8_SB(1, 0), cB + kstep, voffB); PG8_STAGE(PG8_SA(1, 0), cA + kstep, voffA); PG8_STAGE(PG8_SB(1, 1), cB + hstep + kstep, voffB);
        PG8_WAIT_V(6); PG8_BAR;
    }
    for (;;) {
        const bool has_next = S.next(ui + 1, nxt);
        const char* nA = has_next ? (const char*)g.A + (size_t)nxt.pm * tstep : cA; const char* nB = has_next ? (const char*)g.Bt + (size_t)nxt.pn * tstep : cB;
        for (int t = 0; t < nt; t += 2) {
            const bool last = (t == nt - 2);
            const char* a1 = cA + (size_t)(t + 1) * kstep;
            const char* a2 = last ? nA : cA + (size_t)(t + 2) * kstep; const char* b2 = last ? nB : cB + (size_t)(t + 2) * kstep;
            const char* a3 = a2 + kstep; const char* b3 = b2 + kstep;
            if (last && has_next) S.a_ready(nxt);
            if constexpr (SP2) {
            PG8_LDB(B0, 0, 0); PG8_LDB(B1, 0, 1); PG8_SCHED; PG8_LDA(At, 0, 0); PG8_STAGE(PG8_SA(1, 1), a1 + hstep, voffA);
            PG8_WAIT_V(8); PG8_WAIT_L(0); PG8_BAR; PG8_MMA(0, 0, At, B0); PG8_MMA(0, 1, At, B1); PG8_BAR; PG8_SCHED;
            PG8_LDA(At, 0, 1); PG8_STAGE(PG8_SB(0, 0), b2, voffB); PG8_STAGE(PG8_SB(0, 1), b2 + hstep, voffB); PG8_STAGE(PG8_SA(0, 0), a2, voffA);
            PG8_WAIT_V(8); PG8_WAIT_L(0); PG8_BAR; PG8_MMA(1, 0, At, B0); PG8_MMA(1, 1, At, B1); PG8_BAR; PG8_SCHED;
            PG8_LDB(B0, 1, 0); PG8_LDB(B1, 1, 1); PG8_SCHED; PG8_LDA(At, 1, 0); PG8_STAGE(PG8_SA(0, 1), a2 + hstep, voffA);
            PG8_WAIT_V(8); PG8_WAIT_L(0); PG8_BAR; PG8_MMA(0, 0, At, B0); PG8_MMA(0, 1, At, B1); PG8_BAR; PG8_SCHED;
            PG8_LDA(At, 1, 1); PG8_STAGE(PG8_SB(1, 0), b3, voffB); PG8_STAGE(PG8_SB(1, 1), b3 + hstep, voffB); PG8_STAGE(PG8_SA(1, 0), a3, voffA);
            PG8_WAIT_V(8); PG8_WAIT_L(0); PG8_BAR; PG8_MMA(1, 0, At, B0); PG8_MMA(1, 1, At, B1); PG8_BAR; PG8_SCHED;
            } else {
            PG8_LDB(B0, 0, 0); PG8_SCHED; PG8_LDA(At, 0, 0); PG8_STAGE(PG8_SA(1, 1), a1 + hstep, voffA);
            PG8_WAIT_L(8); PG8_BAR; PG8_WAIT_L(0); PG8_MMA(0, 0, At, B0); PG8_BAR; PG8_SCHED;
            PG8_LDB(B1, 0, 1); PG8_STAGE(PG8_SB(0, 0), b2, voffB);
            PG8_BAR; PG8_WAIT_L(0); PG8_MMA(0, 1, At, B1); PG8_BAR;
            PG8_LDA(At, 0, 1); PG8_STAGE(PG8_SA(0, 0), a2, voffA);
            PG8_BAR; PG8_WAIT_L(0); PG8_MMA(1, 0, At, B0); PG8_BAR; PG8_SCHED;
            PG8_STAGE(PG8_SB(0, 1), b2 + hstep, voffB);
            PG8_WAIT_V(6); PG8_BAR; PG8_MMA(1, 1, At, B1); PG8_BAR;
            PG8_LDB(B0, 1, 0); PG8_SCHED; PG8_LDA(At, 1, 0); PG8_STAGE(PG8_SA(0, 1), a2 + hstep, voffA);
            PG8_WAIT_L(8); PG8_BAR; PG8_WAIT_L(0); PG8_MMA(0, 0, At, B0); PG8_BAR; PG8_SCHED;
            PG8_LDB(B1, 1, 1); PG8_STAGE(PG8_SB(1, 0), b3, voffB);
            PG8_BAR; PG8_WAIT_L(0); PG8_MMA(0, 1, At, B1); PG8_BAR;
            PG8_LDA(At, 1, 1); PG8_STAGE(PG8_SA(1, 0), a3, voffA);
            PG8_BAR; PG8_WAIT_L(0); PG8_MMA(1, 0, At, B0); PG8_BAR; PG8_SCHED;
            PG8_STAGE(PG8_SB(1, 1), b3 + hstep, voffB);
            PG8_WAIT_V(6); PG8_BAR; PG8_MMA(1, 1, At, B1); PG8_BAR;
            }
        }
        if constexpr (ALIGN_EPI) { if (wr == 0) PG8_BAR; }
        if constexpr (!Epi::AFTER_DRAIN) { E(acc, cur, wr, wc, fr, fq); S.done(cur); }
        if (!has_next) break;
#pragma unroll
        for (int a = 0; a < 2; ++a)
#pragma unroll
            for (int b = 0; b < 2; ++b)
#pragma unroll
                for (int m = 0; m < 4; ++m)
#pragma unroll
                    for (int n = 0; n < 2; ++n) acc[a][b][m][n] = (f32x4){0.f, 0.f, 0.f, 0.f};
        cur = nxt; cA = nA; cB = nB; ++ui;
        if constexpr (ALIGN_EPI) { if (wr == 1) PG8_BAR; }
    }
    PG8_WAIT_V(0);
    if constexpr (!ALIGN_EPI) { if (wr == 0) PG8_BAR; }
    PG8_BAR;
    if constexpr (Epi::AFTER_DRAIN) { E.fused(acc, cur, wr, wc, fr, fq, lds, wid, lane); S.done(cur); }
#undef PG8_SA
#undef PG8_SB
#undef PG8_STAGE
#undef PG8_LDA
#undef PG8_LDB
#undef PG8_MMA
#undef PG8_WAIT_V
#undef PG8_WAIT_L
#undef PG8_BAR
#undef PG8_SCHED
}
}
constexpr int NWAVES = 8;
constexpr int RING_BYTES = 131072;
constexpr int MISC_OFF = RING_BYTES + 20480;
constexpr int LDS_BYTES = MISC_OFF + 256;
constexpr int CW_TMO = 0, CW_BAR = 4096, CW_PQ = 12288, CW_IQ = 12352;
constexpr size_t CTL_ZERO_BYTES = 1 * MiB;
static_assert((CW_BAR + 3456) * 4 <= 32768, "control words");
constexpr size_t WS_GBUP = 65536;
constexpr size_t WS_ST1 = 131072;
static_assert(WS_GBUP + 2 * 5632 * 4 <= WS_ST1 && WS_ST1 + (size_t)66560 * 8 <= 1048576, "per-call zeroed region");
typedef unsigned u32x2 __attribute__((ext_vector_type(2)));
typedef float f32x2 __attribute__((ext_vector_type(2)));
typedef __bf16 bf16x2_t __attribute__((ext_vector_type(2)));
__device__ __forceinline__ unsigned pk2(float lo, float hi) { const f32x2 v = {lo, hi}; const bf16x2_t b = __builtin_convertvector(v, bf16x2_t); return __builtin_bit_cast(unsigned, b); }
__device__ __forceinline__ float wave_sum(float v) {
#pragma unroll
    for (int o = 1; o < 64; o <<= 1) v += __shfl_xor(v, o);
    return v; }

struct Args { const float* in[N_IN]; float* out; unsigned char* ws; int ph_lo, ph_hi; };
static_assert(sizeof(Args) == (N_IN + 2) * 8 + 8, "Args has no padding");
struct Frame {
    LAS unsigned char* lds; volatile LAS unsigned* MISC; gu32* ctl;
    int wave, G, gw, NGW;
    const Args* a; float* out; unsigned char* ws;
#define FB(T, name, off) __device__ __forceinline__ T* name() const { return (T*)(ws + (off)); }
    FB(bf16_t, XB, WS_XB) FB(bf16_t, W1T, WS_W1T) FB(bf16_t, WUQT, WS_WUQT) FB(bf16_t, WUKVT, WS_WUKVT) FB(bf16_t, WOUTT, WS_WOUTT) FB(bf16_t, WUPT, WS_WUPT) FB(bf16_t, WDNT, WS_WDNT)
    FB(bf16_t, QKVR, WS_QKVR) FB(bf16_t, Z, WS_Z) FB(bf16_t, CQN, WS_CQN) FB(bf16_t, CN, WS_CN) FB(bf16_t, KPE, WS_KPE) FB(bf16_t, QP, WS_QP) FB(bf16_t, KNV, WS_KNV)
    FB(bf16_t, MIX, WS_MIX) FB(bf16_t, X1B, WS_X1B) FB(bf16_t, U, WS_U) FB(bf16_t, HB, WS_HB) FB(float, SM, WS_SM) FB(float, BG, WS_BG) FB(float, PRE1, WS_PRE1) FB(float2, RT, WS_ROPE)
#undef FB
};
__device__ __forceinline__ int lane_now() { int l; asm volatile("v_mbcnt_lo_u32_b32 %0, -1, 0\n\tv_mbcnt_hi_u32_b32 %0, -1, %0" : "=v"(l)); return l; }
__device__ __forceinline__ int row_pos(int row) { return row < MP ? (row & (SEQ - 1)) : SEQ + ((row - MP) & (DT - 1)); }

template <class Src> __device__ __forceinline__ void p0_item(const Src& src, bf16_t* WT, int Kd, int Nd, LAS float* scr, int item, int lane) {
    const int nblk = Nd / 32, kb = item / nblk, nb = item % nblk, k0 = 64 * kb, n0 = 32 * nb;
#pragma unroll 8
    for (int i = 0; i < 32; ++i) { const int kk = 2 * i + (lane >> 5); scr[kk * 33 + (lane & 31)] = src(k0 + kk, n0 + (lane & 31)); }
    LDS_WAIT(); asm volatile("" ::: "memory");
    const int c = lane & 7;
#pragma unroll
    for (int j = 0; j < 4; ++j) { const int n = (lane >> 3) + 8 * j; const LAS float* s = scr + (8 * c) * 33 + n;
        v4u o; o.x = pk2(s[0 * 33], s[1 * 33]); o.y = pk2(s[2 * 33], s[3 * 33]); o.z = pk2(s[4 * 33], s[5 * 33]); o.w = pk2(s[6 * 33], s[7 * 33]);
        *(GAS v4u*)(WT + (size_t)(n0 + n) * Kd + k0 + 8 * c) = o; }
    LDS_WAIT(); asm volatile("" ::: "memory");
}
struct SrcW1 { const float* w; __device__ __forceinline__ float operator()(int k, int n) const { const int o = map1(n); return o < 0 ? 0.f : w[(size_t)k * INC + o]; } };
struct SrcUq { const float* w; const float* g; __device__ __forceinline__ float operator()(int k, int n) const { return g[k] * w[(size_t)k * NQ + mapq(n)]; } };
struct SrcUkv { const float* wk; const float* wv; __device__ __forceinline__ float operator()(int k, int n) const { return k >= KVL ? 0.f : (n < 512 ? wk[(size_t)k * 512 + n] : wv[(size_t)k * 512 + n - 512]); } };
struct SrcUp { const float* w; __device__ __forceinline__ float operator()(int k, int n) const { const int j = n & 255, c = (n >> 8) * 128 + (j & 127); return w[(size_t)k * FF2 + (j < 128 ? c : FF + c)]; } };
struct SrcPlain { const float* w; int N; __device__ __forceinline__ float operator()(int k, int n) const { return w[(size_t)k * N + n]; } };
__device__ __forceinline__ void p0_item_up(Frame& F, LAS float* scr, int item, int lane) {
    const float* w = F.a->in[I_WUP]; const float* g1 = F.a->in[I_LN1G]; const float* b1 = F.a->in[I_LN1B]; bf16_t* WT = F.WUPT(); float* G = (float*)(F.ws + WS_GBUP); float* B = G + FF2;
    const int nblk = FF2 / 32, kb = item / nblk, nb = item % nblk, k0 = 64 * kb, n0 = 32 * nb;
    const int nl = n0 + (lane & 31), j = nl & 255, c = (nl >> 8) * 128 + (j & 127), col = j < 128 ? c : FF + c; float sb = 0.f;
#pragma unroll 8
    for (int i = 0; i < 32; ++i) { const int kk = 2 * i + (lane >> 5); const float wv = w[(size_t)(k0 + kk) * FF2 + col]; sb += b1[k0 + kk] * wv; scr[kk * 33 + (lane & 31)] = g1[k0 + kk] * wv; }
    sb += __shfl_xor(sb, 32); if (lane < 32) unsafeAtomicAdd(B + nl, sb);
    LDS_WAIT(); asm volatile("" ::: "memory");
    const int cc = lane & 7;
#pragma unroll
    for (int jj = 0; jj < 4; ++jj) { const int n = (lane >> 3) + 8 * jj; const LAS float* sp = scr + (8 * cc) * 33 + n;
        v4u o; o.x = pk2(sp[0 * 33], sp[1 * 33]); o.y = pk2(sp[2 * 33], sp[3 * 33]); o.z = pk2(sp[4 * 33], sp[5 * 33]); o.w = pk2(sp[6 * 33], sp[7 * 33]);
        *(GAS v4u*)(WT + (size_t)(n0 + n) * 1024 + k0 + 8 * cc) = o;
        float sg = 0.f;
#pragma unroll
        for (int e = 0; e < 4; ++e) sg += __builtin_bit_cast(float, o[e] << 16) + __builtin_bit_cast(float, o[e] & 0xffff0000u);
        sg += __shfl_xor(sg, 1); sg += __shfl_xor(sg, 2); sg += __shfl_xor(sg, 4); if (cc == 0) unsafeAtomicAdd(G + n0 + n, sg); }
    LDS_WAIT(); asm volatile("" ::: "memory");
}
__device__ __forceinline__ void p0_prologue(Frame& F) {
    LAS float* scr = (LAS float*)(F.lds + F.wave * 16384); const int lane = lane_now();
    constexpr int I1 = 16 * (N1 / 32), I2 = 4 * (NQ / 32), I3 = 4 * 32, I4 = 16 * 32, I5 = 16 * (FF2 / 32), I6 = (FF / 64) * 32, NIT = I1 + I2 + I3 + I4 + I5 + I6;
    for (int it = F.gw; it < NIT; it += F.NGW) { int r = it;
        if (r < I1) { p0_item(SrcW1{F.a->in[I_WIN]}, F.W1T(), 1024, N1, scr, r, lane); continue; } r -= I1;
        if (r < I2) { p0_item(SrcUq{F.a->in[I_WUQ], F.a->in[I_QNW]}, F.WUQT(), 256, NQ, scr, r, lane); continue; } r -= I2;
        if (r < I3) { p0_item(SrcUkv{F.a->in[I_WUK], F.a->in[I_WUV]}, F.WUKVT(), 256, 1024, scr, r, lane); continue; } r -= I3;
        if (r < I4) { p0_item(SrcPlain{F.a->in[I_WOUT], 1024}, F.WOUTT(), 1024, 1024, scr, r, lane); continue; } r -= I4;
        if (r < I5) { p0_item_up(F, scr, r, lane); continue; } r -= I5;
        p0_item(SrcPlain{F.a->in[I_WDN], 1024}, F.WDNT(), FF, 1024, scr, r, lane); }
    { const size_t nth = (size_t)F.NGW * 64, t0 = (size_t)F.gw * 64 + lane; const size_t NP8 = (size_t)MP * D / 8, NT8 = (size_t)M * D / 8;
      for (size_t i = t0; i < NT8; i += nth) { const float* s = i < NP8 ? F.a->in[I_XP] + i * 8 : F.a->in[I_XS] + (i - NP8) * 8; const f32x4 a = *(const GAS f32x4*)s, b = *(const GAS f32x4*)(s + 4);
          v4u o; o.x = pk2(a.x, a.y); o.y = pk2(a.z, a.w); o.z = pk2(b.x, b.y); o.w = pk2(b.z, b.w); *(GAS v4u*)(F.XB() + i * 8) = o; } }
    for (int i = F.gw * 64 + lane; i < (SEQ + DT) * 16; i += F.NGW * 64) { float c, s; rope_entry(i / 16, i % 16, c, s); F.RT()[i] = make_float2(c, s); }
}

__device__ __forceinline__ void unpack8(const v4u w, float (&f)[8]) {
#pragma unroll
    for (int i = 0; i < 4; ++i) { f[2 * i] = __builtin_bit_cast(float, w[i] << 16); f[2 * i + 1] = __builtin_bit_cast(float, w[i] & 0xffff0000u); } }
__device__ __forceinline__ v4u pack8(const f32x4 a, const f32x4 b) { v4u w; w.x = pk2(a[0], a[1]); w.y = pk2(a[2], a[3]); w.z = pk2(b[0], b[1]); w.w = pk2(b[2], b[3]); return w; }
template <int NK> __device__ __forceinline__ bool state_row(int row, size_t& off_rows, bool& sample) {
    if (row < MP) { const int t = row & (SEQ - 1); if (t < SEQ - NK) return false; off_rows = (size_t)(row >> 11) * NK + (t - (SEQ - NK)); sample = false; return true; }
    const int r = row - MP, t = r & (DT - 1); if (t < DT - NK) return false; off_rows = (size_t)(r >> 3) * NK + (t - (DT - NK)); sample = true; return true; }
struct Epi1 {
    static constexpr bool PERM = true, AFTER_DRAIN = false, APERM = false;
    bf16_t* QKVR; bf16_t* Z; float* out; LAS float* P; bf16_t* CQN; bf16_t* CN; bf16_t* KPE; float* BG; const float* kvnw; const float* alog; const float* dtb; const float2* RT;
    __device__ __forceinline__ void operator()(const f32x4 (&acc)[2][2][4][2], const pg8::Unit& u, int wr, int wc, int fr, int fq) const {
        if (u.pn < 8) { const int row0 = u.pm * 256 + wr * 64 + fr, cl = wc * 32 + 8 * fq;
#pragma unroll
            for (int ai = 0; ai < 2; ++ai)
#pragma unroll
                for (int m = 0; m < 4; ++m) { const int row = row0 + ai * 128 + m * 16;
                    if (u.pn < 6) { bf16_t* p = QKVR + (size_t)row * 1536 + u.pn * 256 + cl;
#pragma unroll
                        for (int bj = 0; bj < 2; ++bj) *(v4u*)(p + bj * 128) = pack8(acc[ai][bj][m][0], acc[ai][bj][m][1]);
                        size_t orow; bool smp; if (state_row<3>(row, orow, smp)) { float* o = out + (smp ? O_SGC : O_PGC) + orow * CONVD + u.pn * 256 + cl;
#pragma unroll
                            for (int bj = 0; bj < 2; ++bj) { *(f32x4*)(o + bj * 128) = acc[ai][bj][m][0]; *(f32x4*)(o + bj * 128 + 4) = acc[ai][bj][m][1]; } } }
                    else { bf16_t* p = Z + (size_t)row * 512 + (u.pn - 6) * 256 + cl;
#pragma unroll
                        for (int bj = 0; bj < 2; ++bj) *(v4u*)(p + bj * 128) = pack8(acc[ai][bj][m][0], acc[ai][bj][m][1]); } }
            return; }
        { const int lo_ = lane_now(); fr = lo_ & 15; fq = lo_ >> 4; }
        const int row0 = u.pm * 256 + wr * 64 + fr, cl = wc * 32 + 8 * fq;
        const int nb = u.pn == 8 ? 2 : 1;
#pragma unroll
        for (int ai = 0; ai < 2; ++ai)
#pragma unroll
            for (int m = 0; m < 4; ++m) { float ss = 0.f;
#pragma unroll
                for (int bj = 0; bj < 2; ++bj) if (bj < nb) { const f32x4 a = acc[ai][bj][m][0], b = acc[ai][bj][m][1]; ss += (a[0] * a[0] + a[1] * a[1]) + (a[2] * a[2] + a[3] * a[3]) + (b[0] * b[0] + b[1] * b[1]) + (b[2] * b[2] + b[3] * b[3]); }
                ss += __shfl_xor(ss, 16); ss += __shfl_xor(ss, 32);
                if (fq == 0) P[(ai * 128 + wr * 64 + m * 16 + fr) * 4 + wc] = ss; }
        asm volatile("s_waitcnt lgkmcnt(0)\n\ts_barrier" ::: "memory");
#pragma unroll
        for (int ai = 0; ai < 2; ++ai)
#pragma unroll
            for (int m = 0; m < 4; ++m) { const int row = row0 + ai * 128 + m * 16; const f32x4 p4 = *(const LAS f32x4*)(P + (ai * 128 + wr * 64 + m * 16 + fr) * 4);
                const float tot = (p4[0] + p4[1]) + (p4[2] + p4[3]);
                if (u.pn == 8) { const float r = rsqrtf(tot * (1.f / 256.f) + RMS_EPS); bf16_t* p = CQN + (size_t)row * 256 + cl;
#pragma unroll
                    for (int bj = 0; bj < 2; ++bj) *(v4u*)(p + bj * 128) = pack8(acc[ai][bj][m][0] * r, acc[ai][bj][m][1] * r); }
                else { const float r = rsqrtf(tot * (1.f / 128.f) + RMS_EPS); const f32x4 g0 = *(const f32x4*)(kvnw + cl), g1 = *(const f32x4*)(kvnw + cl + 4);
                    const f32x4 c0 = acc[ai][0][m][0] * r * g0, c1 = acc[ai][0][m][1] * r * g1; float* oc = out + O_PCKV + (size_t)row * KVL + cl;
                    *(f32x4*)oc = c0; *(f32x4*)(oc + 4) = c1; *(v4u*)(CN + (size_t)row * 256 + cl) = pack8(c0, c1); *(v4u*)(CN + (size_t)row * 256 + 128 + cl) = (v4u){0u, 0u, 0u, 0u};
                    const f32x4 x0 = acc[ai][1][m][0], x1 = acc[ai][1][m][1];
                    if (wc == 0) { f32x4 q0, q1;
#pragma unroll
                        for (int e = 0; e < 4; ++e) { q0[e] = __shfl_xor(x0[e], 32); q1[e] = __shfl_xor(x1[e], 32); }
                        if (fq < 2) { const float2* rt = RT + (row & (SEQ - 1)) * 16 + 8 * fq; f32x4 ya, yb, za, zb;
#pragma unroll
                            for (int e = 0; e < 4; ++e) { const float2 ca = rt[e], cb = rt[4 + e]; ya[e] = x0[e] * ca.x - q0[e] * ca.y; za[e] = x0[e] * ca.y + q0[e] * ca.x; yb[e] = x1[e] * cb.x - q1[e] * cb.y; zb[e] = x1[e] * cb.y + q1[e] * cb.x; }
                            float* ok = out + O_PKPE + (size_t)row * ROPE + 8 * fq; *(f32x4*)ok = ya; *(f32x4*)(ok + 4) = yb; *(f32x4*)(ok + 16) = za; *(f32x4*)(ok + 20) = zb;
                            bf16_t* kp = KPE + (size_t)row * 32 + 16 * fq;
                            *(v4u*)kp = (v4u){pk2(ya[0], za[0]), pk2(ya[1], za[1]), pk2(ya[2], za[2]), pk2(ya[3], za[3])}; *(v4u*)(kp + 8) = (v4u){pk2(yb[0], zb[0]), pk2(yb[1], zb[1]), pk2(yb[2], zb[2]), pk2(yb[3], zb[3])}; } }
                    else if (wc == 1 && fq == 0) { f32x4 b0, b1;
#pragma unroll
                        for (int e = 0; e < 4; ++e) { b0[e] = 1.f / (1.f + __expf(-x0[e])); b1[e] = 1.f / (1.f + __expf(-x1[e])); }
                        *(f32x4*)(BG + (size_t)row * 16 + 8) = b0; *(f32x4*)(BG + (size_t)row * 16 + 12) = b1; }
                    else if (wc == 1 && fq == 1) { f32x4 gA, gB;
#pragma unroll
                        for (int e = 0; e < 4; ++e) { gA[e] = -__expf(alog[e]) * softplus_f(x0[e] + dtb[e]); gB[e] = -__expf(alog[4 + e]) * softplus_f(x1[e] + dtb[4 + e]); }
                        *(f32x4*)(BG + (size_t)row * 16) = gA; *(f32x4*)(BG + (size_t)row * 16 + 4) = gB; } } }
        asm volatile("s_waitcnt lgkmcnt(0)\n\ts_barrier" ::: "memory");
    }
};
struct EpiQ {
    static constexpr bool PERM = true, AFTER_DRAIN = false, APERM = false;
    bf16_t* QP; const float2* RT;
    __device__ __forceinline__ void operator()(const f32x4 (&acc)[2][2][4][2], const pg8::Unit& u, int wr, int wc, int fr, int fq) const {
        const int row0 = u.pm * 256 + wr * 64 + fr, cl = wc * 32 + 8 * fq;
#pragma unroll
        for (int ai = 0; ai < 2; ++ai)
#pragma unroll
            for (int m = 0; m < 4; ++m) { const int row = row0 + ai * 128 + m * 16; bf16_t* p = QP + (size_t)row * NQ + u.pn * 256 + cl;
                if (u.pn < 2) {
#pragma unroll
                    for (int bj = 0; bj < 2; ++bj) *(v4u*)(p + bj * 128) = pack8(acc[ai][bj][m][0] * QSCALE, acc[ai][bj][m][1] * QSCALE); }
                else { const float2* rt = RT + row_pos(row) * 16 + 4 * fq; const f32x4 cs01 = *(const f32x4*)rt, cs23 = *(const f32x4*)(rt + 2);
#pragma unroll
                    for (int bj = 0; bj < 2; ++bj) { const f32x4 a = acc[ai][bj][m][0], b = acc[ai][bj][m][1]; f32x4 ra, rb;
                        ra[0] = a[0] * cs01[0] - a[1] * cs01[1]; ra[1] = a[0] * cs01[1] + a[1] * cs01[0]; ra[2] = a[2] * cs01[2] - a[3] * cs01[3]; ra[3] = a[2] * cs01[3] + a[3] * cs01[2];
                        rb[0] = b[0] * cs23[0] - b[1] * cs23[1]; rb[1] = b[0] * cs23[1] + b[1] * cs23[0]; rb[2] = b[2] * cs23[2] - b[3] * cs23[3]; rb[3] = b[2] * cs23[3] + b[3] * cs23[2];
                        *(v4u*)(p + bj * 128) = pack8(ra * QSCALE, rb * QSCALE); } } }
    }
};
struct EpiB16 {
    static constexpr bool PERM = true, AFTER_DRAIN = false, APERM = false;
    bf16_t* O; int ld; int pad;
    __device__ __forceinline__ void operator()(const f32x4 (&acc)[2][2][4][2], const pg8::Unit& u, int wr, int wc, int fr, int fq) const {
        const int row0 = u.pm * 256 + wr * 64 + fr, c0 = u.pn * 256 + wc * 32 + 8 * fq;
#pragma unroll
        for (int ai = 0; ai < 2; ++ai)
#pragma unroll
            for (int m = 0; m < 4; ++m) { bf16_t* p = O + (size_t)(row0 + ai * 128 + m * 16) * ld + c0;
#pragma unroll
                for (int bj = 0; bj < 2; ++bj) *(v4u*)(p + bj * 128) = pack8(acc[ai][bj][m][0], acc[ai][bj][m][1]); }
    }
};
struct EpiUp {
    static constexpr bool PERM = true, AFTER_DRAIN = false, APERM = false;
    bf16_t* U; float* out;
    __device__ __forceinline__ void operator()(const f32x4 (&acc)[2][2][4][2], const pg8::Unit& u, int wr, int wc, int fr, int fq) const {
        const int row0 = u.pm * 256 + wr * 64 + fr, c0 = u.pn * 256 + wc * 32 + 8 * fq;
#pragma unroll
        for (int ai = 0; ai < 2; ++ai)
#pragma unroll
            for (int m = 0; m < 4; ++m) { const int row = row0 + ai * 128 + m * 16; bf16_t* p = U + (size_t)row * FF2 + c0;
#pragma unroll
                for (int bj = 0; bj < 2; ++bj) *(v4u*)(p + bj * 128) = pack8(acc[ai][bj][m][0], acc[ai][bj][m][1]);
                size_t orow; bool smp; if (state_row<2>(row, orow, smp)) { float* o = out + (smp ? O_SFC : O_PFC) + orow * FF2 + c0;
#pragma unroll
                    for (int bj = 0; bj < 2; ++bj) { *(f32x4*)(o + bj * 128) = acc[ai][bj][m][0]; *(f32x4*)(o + bj * 128 + 4) = acc[ai][bj][m][1]; } } }
    }
};
struct EpiRes {
    static constexpr bool PERM = false, AFTER_DRAIN = false, APERM = false;
    float* O; const float* R0; const float* R1;
    __device__ __forceinline__ void operator()(const f32x4 (&acc)[2][2][4][2], const pg8::Unit& u, int wr, int wc, int fr, int fq) const {
        const int row0 = u.pm * 256 + wr * 64 + fr, c0 = u.pn * 256 + wc * 32 + 4 * fq;
#pragma unroll
        for (int ai = 0; ai < 2; ++ai)
#pragma unroll
            for (int m = 0; m < 4; ++m) { const int row = row0 + ai * 128 + m * 16; const float* r = (row < MP ? R0 + (size_t)row * D : R1 + (size_t)(row - MP) * D) + c0; float* o = O + (size_t)row * D + c0;
#pragma unroll
                for (int bj = 0; bj < 2; ++bj)
#pragma unroll
                    for (int n = 0; n < 2; ++n) { const f32x4 x = *(const f32x4*)(r + bj * 128 + n * 16); *(f32x4*)(o + bj * 128 + n * 16) = acc[ai][bj][m][n] + ALPHA * x; } }
    }
};

struct EpiPre1 {
    static constexpr bool PERM = true, AFTER_DRAIN = false, APERM = false;
    bf16_t* O; const bf16_t* RB; float* ST;
    __device__ __forceinline__ void operator()(const f32x4 (&acc)[2][2][4][2], const pg8::Unit& u, int wr, int wc, int fr, int fq) const {
        const int row0 = u.pm * 256 + wr * 64 + fr, c0 = u.pn * 256 + wc * 32 + 8 * fq;
#pragma unroll
        for (int ai = 0; ai < 2; ++ai)
#pragma unroll
            for (int m = 0; m < 4; ++m) { const int row = row0 + ai * 128 + m * 16; const size_t off = (size_t)row * D + c0; float s1 = 0.f, s2 = 0.f;
#pragma unroll
                for (int bj = 0; bj < 2; ++bj) { float xx[8]; unpack8(*(const v4u*)(RB + off + bj * 128), xx); const f32x4 x0 = {xx[0], xx[1], xx[2], xx[3]}, x1 = {xx[4], xx[5], xx[6], xx[7]};
                    const f32x4 v0 = acc[ai][bj][m][0] + ALPHA * x0, v1 = acc[ai][bj][m][1] + ALPHA * x1;
                    s1 += (v0[0] + v0[1]) + (v0[2] + v0[3]) + (v1[0] + v1[1]) + (v1[2] + v1[3]);
                    s2 += (v0[0] * v0[0] + v0[1] * v0[1]) + (v0[2] * v0[2] + v0[3] * v0[3]) + (v1[0] * v1[0] + v1[1] * v1[1]) + (v1[2] * v1[2] + v1[3] * v1[3]);
                    *(v4u*)(O + off + bj * 128) = pack8(v0, v1); }
                s1 += __shfl_xor(s1, 16); s1 += __shfl_xor(s1, 32); s2 += __shfl_xor(s2, 16); s2 += __shfl_xor(s2, 32);
                if (fq == 0) { unsafeAtomicAdd(ST + 2 * row, s1); unsafeAtomicAdd(ST + 2 * row + 1, s2); } }
    }
};
__device__ __forceinline__ void ln1_stats(const float* ST, int row, float& mu, float& rstd) { const f32x2 s = *(const f32x2*)(ST + 2 * row); mu = s.x * (1.f / D); rstd = rsqrtf(fmaxf(s.y * (1.f / D) - mu * mu, 0.f) + LN_EPS); }
struct EpiPre2 {
    static constexpr bool PERM = true, AFTER_DRAIN = false, APERM = false;
    bf16_t* O; const bf16_t* R; const float* ST; const float* g1; const float* b1;
    __device__ __forceinline__ void operator()(const f32x4 (&acc)[2][2][4][2], const pg8::Unit& u, int wr, int wc, int fr, int fq) const {
        const int row0 = u.pm * 256 + wr * 64 + fr, c0 = u.pn * 256 + wc * 32 + 8 * fq;
        f32x4 gg[2][2], bb[2][2];
#pragma unroll
        for (int bj = 0; bj < 2; ++bj)
#pragma unroll
            for (int n = 0; n < 2; ++n) { gg[bj][n] = *(const f32x4*)(g1 + c0 + bj * 128 + 4 * n); bb[bj][n] = *(const f32x4*)(b1 + c0 + bj * 128 + 4 * n); }
#pragma unroll
        for (int ai = 0; ai < 2; ++ai)
#pragma unroll
            for (int m = 0; m < 4; ++m) { const int row = row0 + ai * 128 + m * 16; const size_t off = (size_t)row * D + c0; float mu, rstd; ln1_stats(ST, row, mu, rstd);
#pragma unroll
                for (int bj = 0; bj < 2; ++bj) { float x[8]; unpack8(*(const v4u*)(R + off + bj * 128), x);
                    const f32x4 x0 = ((f32x4){x[0], x[1], x[2], x[3]} - mu) * rstd * gg[bj][0] + bb[bj][0], x1 = ((f32x4){x[4], x[5], x[6], x[7]} - mu) * rstd * gg[bj][1] + bb[bj][1];
                    *(v4u*)(O + off + bj * 128) = pack8(acc[ai][bj][m][0] + ALPHA * x0, acc[ai][bj][m][1] + ALPHA * x1); } }
    }
};
struct EpiResB {
    static constexpr bool PERM = false, AFTER_DRAIN = false, APERM = false;
    float* O; const bf16_t* R;
    __device__ __forceinline__ void operator()(const f32x4 (&acc)[2][2][4][2], const pg8::Unit& u, int wr, int wc, int fr, int fq) const {
        const int row0 = u.pm * 256 + wr * 64 + fr, c0 = u.pn * 256 + wc * 32 + 4 * fq;
#pragma unroll
        for (int ai = 0; ai < 2; ++ai)
#pragma unroll
            for (int m = 0; m < 4; ++m) { const size_t off = (size_t)(row0 + ai * 128 + m * 16) * D + c0;
#pragma unroll
                for (int bj = 0; bj < 2; ++bj)
#pragma unroll
                    for (int n = 0; n < 2; ++n) { const u32x2 xr = *(const u32x2*)(R + off + bj * 128 + n * 16);
                        const f32x4 x = {__builtin_bit_cast(float, xr.x << 16), __builtin_bit_cast(float, xr.x & 0xffff0000u), __builtin_bit_cast(float, xr.y << 16), __builtin_bit_cast(float, xr.y & 0xffff0000u)};
                        *(f32x4*)(O + off + bj * 128 + n * 16) = acc[ai][bj][m][n] + ALPHA * x; } }
    }
};
__device__ __forceinline__ float dpp_shr1(float v) { return __builtin_bit_cast(float, __builtin_amdgcn_update_dpp(0, __builtin_bit_cast(int, v), 0x111, 0xf, 0xf, true)); }
constexpr size_t WS_RAWB = (size_t)3100 * MiB, WS_PARTB = (size_t)3160 * MiB;
struct EpiUpCG {
    static constexpr bool PERM = true, AFTER_DRAIN = false, APERM = true;
    bf16_t* U; bf16_t* HB; float* RAWB; float* PARTB; const float* cw; float* out; const float* GB; const float* ST;
    __device__ __forceinline__ void operator()(const f32x4 (&acc_)[2][2][4][2], const pg8::Unit& u, int wr, int wc, int fr, int fq) const {
        f32x4 (&acc)[2][2][4][2] = const_cast<f32x4 (&)[2][2][4][2]>(acc_);
        { const float* Gp = GB + u.pn * 256 + wc * 32 + 8 * fq; f32x4 Gv[2][2], Bv[2][2];
#pragma unroll
          for (int bj = 0; bj < 2; ++bj)
#pragma unroll
              for (int n = 0; n < 2; ++n) { Gv[bj][n] = *(const f32x4*)(Gp + bj * 128 + 4 * n); Bv[bj][n] = *(const f32x4*)(Gp + FF2 + bj * 128 + 4 * n); }
#pragma unroll
          for (int ai = 0; ai < 2; ++ai)
#pragma unroll
              for (int m = 0; m < 4; ++m) { float mu, rstd; ln1_stats(ST, u.pm * 256 + ai * 128 + wr * 64 + 4 * fr + m, mu, rstd);
#pragma unroll
                  for (int bj = 0; bj < 2; ++bj)
#pragma unroll
                      for (int n = 0; n < 2; ++n) acc[ai][bj][m][n] = (acc[ai][bj][m][n] - mu * Gv[bj][n]) * rstd + Bv[bj][n]; } }
        const int c0 = u.pn * 128 + wc * 32 + 8 * fq;
        if (u.pm >= MP / 256) {
#pragma unroll
            for (int ai = 0; ai < 2; ++ai)
#pragma unroll
                for (int m = 0; m < 4; ++m) { const int row = u.pm * 256 + ai * 128 + wr * 64 + 4 * fr + m; bf16_t* p = U + (size_t)row * FF2 + u.pn * 256 + wc * 32 + 8 * fq;
#pragma unroll
                    for (int bj = 0; bj < 2; ++bj) *(v4u*)(p + bj * 128) = pack8(acc[ai][bj][m][0], acc[ai][bj][m][1]);
                    size_t orow; bool smp; if (state_row<2>(row, orow, smp)) { float* o = out + O_SFC + orow * FF2 + c0;
#pragma unroll
                        for (int bj = 0; bj < 2; ++bj) { *(f32x4*)(o + bj * FF) = acc[ai][bj][m][0]; *(f32x4*)(o + bj * FF + 4) = acc[ai][bj][m][1]; } } }
            return; }
#pragma unroll
        for (int ai = 0; ai < 2; ++ai) { const int tok0 = u.pm * 256 + ai * 128 + wr * 64, blk = tok0 >> 6; u32x2 hp0[4];
#pragma unroll
            for (int n = 0; n < 2; ++n) { f32x4 wU[3], wG[3];
#pragma unroll
                for (int j = 0; j < 3; ++j) { wU[j] = *(const f32x4*)(cw + j * FF2 + c0 + 4 * n); wG[j] = *(const f32x4*)(cw + j * FF2 + FF + c0 + 4 * n); }
                const f32x4 u0 = acc[ai][0][0][n], u1 = acc[ai][0][1][n], u2 = acc[ai][0][2][n], u3 = acc[ai][0][3][n], g0 = acc[ai][1][0][n], g1 = acc[ai][1][1][n], g2 = acc[ai][1][2][n], g3 = acc[ai][1][3][n];
                f32x4 su3, su2, sg3, sg2;
#pragma unroll
                for (int e = 0; e < 4; ++e) { su3[e] = dpp_shr1(u3[e]); su2[e] = dpp_shr1(u2[e]); sg3[e] = dpp_shr1(g3[e]); sg2[e] = dpp_shr1(g2[e]); }
                u32x2 hq[4];
                { const f32x4 hu = wU[2] * u0 + wU[1] * su3 + wU[0] * su2, hg = wG[2] * g0 + wG[1] * sg3 + wG[0] * sg2;
                  if (fr == 0) { float* pp = PARTB + (size_t)blk * 2 * FF2 + c0 + 4 * n; *(f32x4*)pp = hu; *(f32x4*)(pp + FF) = hg; }
                  hq[0] = (u32x2){pk2(silu_f(hg[0]) * hu[0], silu_f(hg[1]) * hu[1]), pk2(silu_f(hg[2]) * hu[2], silu_f(hg[3]) * hu[3])}; }
                { const f32x4 hu = wU[2] * u1 + wU[1] * u0 + wU[0] * su3, hg = wG[2] * g1 + wG[1] * g0 + wG[0] * sg3;
                  if (fr == 0) { float* pp = PARTB + (size_t)blk * 2 * FF2 + FF2 + c0 + 4 * n; *(f32x4*)pp = hu; *(f32x4*)(pp + FF) = hg; }
                  hq[1] = (u32x2){pk2(silu_f(hg[0]) * hu[0], silu_f(hg[1]) * hu[1]), pk2(silu_f(hg[2]) * hu[2], silu_f(hg[3]) * hu[3])}; }
                { const f32x4 hu = wU[2] * u2 + wU[1] * u1 + wU[0] * u0, hg = wG[2] * g2 + wG[1] * g1 + wG[0] * g0;
                  hq[2] = (u32x2){pk2(silu_f(hg[0]) * hu[0], silu_f(hg[1]) * hu[1]), pk2(silu_f(hg[2]) * hu[2], silu_f(hg[3]) * hu[3])}; }
                { const f32x4 hu = wU[2] * u3 + wU[1] * u2 + wU[0] * u1, hg = wG[2] * g3 + wG[1] * g2 + wG[0] * g1;
                  hq[3] = (u32x2){pk2(silu_f(hg[0]) * hu[0], silu_f(hg[1]) * hu[1]), pk2(silu_f(hg[2]) * hu[2], silu_f(hg[3]) * hu[3])}; }
                if (fr == 15) { float* rp = RAWB + (size_t)blk * 2 * FF2 + c0 + 4 * n;
                    *(f32x4*)rp = u2; *(f32x4*)(rp + FF) = g2; *(f32x4*)(rp + FF2) = u3; *(f32x4*)(rp + FF2 + FF) = g3;
                    if ((blk & 31) == 31) { float* o = out + O_PFC + (size_t)(blk >> 5) * 2 * FF2 + c0 + 4 * n; *(f32x4*)o = u2; *(f32x4*)(o + FF) = g2; *(f32x4*)(o + FF2) = u3; *(f32x4*)(o + FF2 + FF) = g3; } }
                if (n == 0) {
#pragma unroll
                    for (int m = 0; m < 4; ++m) hp0[m] = hq[m]; }
                else { bf16_t* hp = HB + (size_t)(tok0 + 4 * fr) * FF + c0;
#pragma unroll
                    for (int m = 0; m < 4; ++m) if (fr != 0 || m >= 2) *(v4u*)(hp + (size_t)m * FF) = (v4u){hp0[m].x, hp0[m].y, hq[m].x, hq[m].y}; } } }
    }
};

__device__ __forceinline__ void p_tok(Frame& F) {
    const float* kvnw = F.a->in[I_KVNW]; const float* alog = F.a->in[I_ALOG]; const float* dtb = F.a->in[I_DTB]; const int l = lane_now();
    const f32x2 kvw = *(const f32x2*)(kvnw + 2 * l);
    for (int row = MP + F.gw; row < M; row += F.NGW) { const bf16_t* s = (const bf16_t*)F.SM() + (size_t)row * 512;
        const u32x2 qr = *(const GAS u32x2*)(s + 4 * l); const unsigned cr = *(const GAS unsigned*)(s + 256 + 2 * l); const float sm = bf2f(s[384 + l]);
        const f32x4 q = {__builtin_bit_cast(float, qr.x << 16), __builtin_bit_cast(float, qr.x & 0xffff0000u), __builtin_bit_cast(float, qr.y << 16), __builtin_bit_cast(float, qr.y & 0xffff0000u)}; const f32x2 c = {__builtin_bit_cast(float, cr << 16), __builtin_bit_cast(float, cr & 0xffff0000u)};
        const float r1 = rsqrtf(wave_sum(q.x * q.x + q.y * q.y + q.z * q.z + q.w * q.w) * (1.f / 256.f) + RMS_EPS);
        const float r2 = rsqrtf(wave_sum(c.x * c.x + c.y * c.y) * (1.f / 128.f) + RMS_EPS);
        u32x2 w; w.x = pk2(q.x * r1, q.y * r1); w.y = pk2(q.z * r1, q.w * r1); *(GAS u32x2*)(F.CQN() + (size_t)row * 256 + 4 * l) = w;
        const float c0 = c.x * r2 * kvw.x, c1 = c.y * r2 * kvw.y;
        float* ockv = row < MP ? F.out + O_PCKV + (size_t)row * KVL : F.out + O_SCKV + (size_t)(row - MP) * KVL;
        float* okpe = row < MP ? F.out + O_PKPE + (size_t)row * ROPE : F.out + O_SKPE + (size_t)(row - MP) * ROPE;
        *(GAS f32x2*)(ockv + 2 * l) = (f32x2){c0, c1}; ((GAS unsigned*)(F.CN() + (size_t)row * 256))[l] = pk2(c0, c1); ((GAS unsigned*)(F.CN() + (size_t)row * 256 + 128))[l] = 0u;
        const float x2 = __shfl(sm, (l + 16) & 63);
        if (l < 16) { const float2 cs = F.RT()[row_pos(row) * 16 + l]; const float y1 = sm * cs.x - x2 * cs.y, y2 = sm * cs.y + x2 * cs.x; okpe[l] = y1; okpe[16 + l] = y2; ((GAS unsigned*)(F.KPE() + (size_t)row * 32))[l] = pk2(y1, y2); }
        if (l >= 32 && l < 40) F.BG()[(size_t)row * 16 + 8 + (l - 32)] = 1.f / (1.f + __expf(-sm));
        if (l >= 40 && l < 48) { const int h = l - 40; F.BG()[(size_t)row * 16 + h] = -__expf(alog[h]) * softplus_f(sm + dtb[h]); } }
}
__device__ __forceinline__ void p_ln(Frame& F, const bf16_t* in, const float* g, const float* bt, float* outp, bf16_t* ob) {
    const int l = lane_now(); f32x4 gg[4], bb[4];
#pragma unroll
    for (int j = 0; j < 4; ++j) { gg[j] = *(const f32x4*)(g + 4 * l + 256 * j); bb[j] = *(const f32x4*)(bt + 4 * l + 256 * j); }
    for (int row = F.gw; row < M; row += F.NGW) { const GAS u32x2* xr = (const GAS u32x2*)(in + (size_t)row * D) + l; f32x4 v[4]; float s = 0.f;
#pragma unroll
        for (int j = 0; j < 4; ++j) { const u32x2 r = xr[64 * j]; v[j] = (f32x4){__builtin_bit_cast(float, r.x << 16), __builtin_bit_cast(float, r.x & 0xffff0000u), __builtin_bit_cast(float, r.y << 16), __builtin_bit_cast(float, r.y & 0xffff0000u)}; s += (v[j].x + v[j].y) + (v[j].z + v[j].w); }
        const float mean = wave_sum(s) * (1.f / D); float s2 = 0.f;
#pragma unroll
        for (int j = 0; j < 4; ++j) { v[j] = v[j] - mean; s2 += (v[j].x * v[j].x + v[j].y * v[j].y) + (v[j].z * v[j].z + v[j].w * v[j].w); }
        const float rstd = rsqrtf(wave_sum(s2) * (1.f / D) + LN_EPS);
#pragma unroll
        for (int j = 0; j < 4; ++j) { const f32x4 y = v[j] * rstd * gg[j] + bb[j]; if (outp) *((GAS f32x4*)(outp + (size_t)row * D) + l + 64 * j) = y;
            if (ob) { u32x2 w; w.x = pk2(y.x, y.y); w.y = pk2(y.z, y.w); *((GAS u32x2*)(ob + (size_t)row * D) + l + 64 * j) = w; } } }
}
__device__ __forceinline__ void p_cg(Frame& F) {
    const float* cw = F.a->in[I_FCW]; const float* hist = F.a->in[I_SFC]; const float* RAWB = (const float*)(F.ws + WS_RAWB); const float* PARTB = (const float*)(F.ws + WS_PARTB);
    const int lane = lane_now(); const int gt = F.gw * 64 + lane, gn = F.NGW * 64;
    for (int it = gt; it < (MP / 64) * 2 * (FF / 4); it += gn) { const int c = (it % (FF / 4)) * 4, r = (it / (FF / 4)) & 1, blk = it / (2 * (FF / 4));
        const float* pp = PARTB + ((size_t)blk * 2 + r) * FF2 + c; f32x4 hu = *(const GAS f32x4*)pp, hg = *(const GAS f32x4*)(pp + FF);
        if (blk & 31) { const float* rp = RAWB + (size_t)(blk - 1) * 2 * FF2 + c; const f32x4 u62 = *(const GAS f32x4*)rp, g62 = *(const GAS f32x4*)(rp + FF), u63 = *(const GAS f32x4*)(rp + FF2), g63 = *(const GAS f32x4*)(rp + FF2 + FF);
            const f32x4 wu0 = *(const GAS f32x4*)(cw + c), wg0 = *(const GAS f32x4*)(cw + FF + c), wu1 = *(const GAS f32x4*)(cw + FF2 + c), wg1 = *(const GAS f32x4*)(cw + FF2 + FF + c);
            if (r == 0) { hu += wu1 * u63 + wu0 * u62; hg += wg1 * g63 + wg0 * g62; } else { hu += wu0 * u63; hg += wg0 * g63; } }
        u32x2 w; w.x = pk2(silu_f(hg[0]) * hu[0], silu_f(hg[1]) * hu[1]); w.y = pk2(silu_f(hg[2]) * hu[2], silu_f(hg[3]) * hu[3]);
        *(GAS u32x2*)(F.HB() + (size_t)(blk * 64 + r) * FF + c) = w; }
    for (int it = gt; it < MS * (FF / 8); it += gn) { const int cg = it % (FF / 8), rs = it / (FF / 8), c = cg * 8, row = MP + rs, t = rs & (DT - 1); const int pc = (c >> 7) * 256 + (c & 127);
        float au[8], ag[8];
#pragma unroll
        for (int e = 0; e < 8; ++e) { au[e] = 0.f; ag[e] = 0.f; }
#pragma unroll
        for (int j = 0; j < 3; ++j) { const int tt = t + j - 2; float xu[8], xg[8];
            if (tt >= 0) { const bf16_t* p = F.U() + (size_t)(row - t + tt) * FF2 + pc; unpack8(*(const GAS v4u*)p, xu); unpack8(*(const GAS v4u*)(p + 128), xg); }
            else { const float* h = hist + ((size_t)(rs >> 3) * 2 + (tt + 2)) * FF2 + c;
#pragma unroll
                for (int e = 0; e < 8; ++e) { xu[e] = h[e]; xg[e] = h[FF + e]; } }
#pragma unroll
            for (int e = 0; e < 8; ++e) { au[e] += cw[j * FF2 + c + e] * xu[e]; ag[e] += cw[j * FF2 + FF + c + e] * xg[e]; } }
        v4u w; w.x = pk2(silu_f(ag[0]) * au[0], silu_f(ag[1]) * au[1]); w.y = pk2(silu_f(ag[2]) * au[2], silu_f(ag[3]) * au[3]); w.z = pk2(silu_f(ag[4]) * au[4], silu_f(ag[5]) * au[5]); w.w = pk2(silu_f(ag[6]) * au[6], silu_f(ag[7]) * au[7]);
        *(GAS v4u*)(F.HB() + (size_t)row * FF + c) = w; }
}
namespace pattn {
typedef float f32x16 __attribute__((ext_vector_type(16)));
typedef short s16x4 __attribute__((ext_vector_type(4)));
constexpr int KSTR = 208, VSTR = 192, KBUF = 128 * KSTR, VBUF = 128 * VSTR, BUF = KBUF + VBUF;
__device__ __forceinline__ s16x4 vtr(const LAS unsigned char* p) { return __builtin_bit_cast(s16x4, __builtin_amdgcn_ds_read_tr16_b64_v4i16((LAS s16x4*)p)); }
__device__ __forceinline__ void phase(Frame& F) {
    const int lane = lane_now(), w = F.wave, tid = w * 64 + lane, r32 = lane & 31, hi = lane >> 5;
    const int skey = tid >> 3, sc = tid & 7, pkey = tid >> 2, pc = tid & 3;
    LAS unsigned char* L = F.lds;
    unsigned* qctr = (unsigned*)(F.ctl + CW_PQ); LAS int* qs = (LAS int*)(L + 2 * BUF);
    for (;;) {
        if (tid == 0) *qs = (int)__hip_atomic_fetch_add(qctr, 1u, __ATOMIC_RELAXED, __HIP_MEMORY_SCOPE_AGENT);
        __syncthreads();
        const int item = __builtin_amdgcn_readfirstlane(*qs);
        __syncthreads();
        if (item >= BATCH * H * 8) break;
        const int qb = 7 - (item >> 8), unit = item & 255;
        const int b = unit >> 3, h = unit & 7;
        const bf16_t* KNVb = F.KNV() + (size_t)b * SEQ * 1024 + h * 64; const bf16_t* KPEb = F.KPE() + (size_t)b * SEQ * 32; const bf16_t* QPb = F.QP() + (size_t)b * SEQ * NQ;
        bf16_t* Ob = F.MIX() + (size_t)b * SEQ * 1024 + 512 + h * 64;
        {
            const int q0 = qb * 256 + w * 32, NT = 4 * (qb + 1);
            bf16x8 qf[6];
            { const bf16_t* qrow = QPb + (size_t)(q0 + r32) * NQ;
#pragma unroll
              for (int ks = 0; ks < 4; ++ks) qf[ks] = *(const GAS bf16x8*)(qrow + h * 64 + ks * 16 + hi * 8);
#pragma unroll
              for (int ks = 0; ks < 2; ++ks) qf[4 + ks] = *(const GAS bf16x8*)(qrow + 512 + h * 32 + ks * 16 + hi * 8); }
            f32x16 o0, o1;
#pragma unroll
            for (int i = 0; i < 16; ++i) { o0[i] = 0.f; o1[i] = 0.f; }
            float m = -INFINITY, lsum = 0.f;
            v4u gk[2], gv[2], gp;
#define PA_LOAD(ts) do { _Pragma("unroll") for (int u_ = 0; u_ < 2; ++u_) { const bf16_t* kp_ = KNVb + (size_t)(128 * (ts) + 64 * u_ + skey) * 1024 + sc * 8; gk[u_] = *(const GAS v4u*)kp_; gv[u_] = *(const GAS v4u*)(kp_ + 512); } \
                        gp = *(const GAS v4u*)(KPEb + (size_t)(128 * (ts) + pkey) * 32 + pc * 8); } while (0)
#define PA_STORE(bufi) do { LAS unsigned char* kb_ = L + (bufi) * BUF; _Pragma("unroll") for (int u_ = 0; u_ < 2; ++u_) { *(LAS v4u*)(kb_ + (64 * u_ + skey) * KSTR + sc * 16) = gk[u_]; *(LAS v4u*)(kb_ + KBUF + (64 * u_ + skey) * VSTR + sc * 16) = gv[u_]; } \
                        *(LAS v4u*)(kb_ + pkey * KSTR + 128 + pc * 16) = gp; } while (0)
            PA_LOAD(0); PA_STORE(0); __syncthreads();
            for (int ts = 0; ts < NT / 2; ++ts) {
                if (ts + 1 < NT / 2) PA_LOAD(ts + 1);
#pragma unroll 1
                for (int sub = 0; sub < 2; ++sub) { const int t = 2 * ts + sub;
                if (64 * t <= q0 + 31) {
                    const LAS unsigned char* kb = L + (ts & 1) * BUF + sub * 64 * KSTR; const LAS unsigned char* vb = L + (ts & 1) * BUF + KBUF + sub * 64 * VSTR;
                    f32x16 p0, p1;
#pragma unroll
                    for (int i = 0; i < 16; ++i) { p0[i] = 0.f; p1[i] = 0.f; }
                    __builtin_amdgcn_s_setprio(1);
#pragma unroll
                    for (int ks = 0; ks < 6; ++ks) { const bf16x8 a0 = *(const LAS bf16x8*)(kb + r32 * KSTR + ks * 32 + hi * 16), a1 = *(const LAS bf16x8*)(kb + (32 + r32) * KSTR + ks * 32 + hi * 16);
                        p0 = __builtin_amdgcn_mfma_f32_32x32x16_bf16(a0, qf[ks], p0, 0, 0, 0); p1 = __builtin_amdgcn_mfma_f32_32x32x16_bf16(a1, qf[ks], p1, 0, 0, 0); }
                    __builtin_amdgcn_s_setprio(0);
                    if (64 * t + 63 > q0) { const int qa = q0 + r32, k0 = 64 * t + 4 * hi;
#pragma unroll
                        for (int i = 0; i < 16; ++i) { const int kk = k0 + 8 * (i >> 2) + (i & 3); if (kk > qa) p0[i] = -INFINITY; if (kk + 32 > qa) p1[i] = -INFINITY; } }
                    float mx = fmaxf(p0[0], p1[0]);
#pragma unroll
                    for (int i = 1; i < 16; ++i) mx = fmaxf(mx, fmaxf(p0[i], p1[i]));
                    mx = fmaxf(mx, __shfl_xor(mx, 32));
                    const float mn = fmaxf(m, mx); const bool resc = __any(mx > m);
                    float ps = 0.f;
#pragma unroll
                    for (int i = 0; i < 16; ++i) { p0[i] = __builtin_amdgcn_exp2f(p0[i] - mn); p1[i] = __builtin_amdgcn_exp2f(p1[i] - mn); ps += p0[i] + p1[i]; }
                    if (resc) { const float alpha = __builtin_amdgcn_exp2f(m - mn); lsum *= alpha;
#pragma unroll
                        for (int i = 0; i < 16; ++i) { o0[i] *= alpha; o1[i] *= alpha; } }
                    lsum += ps; m = mn;
                    v4u pf[4];
                    pf[0] = (v4u){pk2(p0[0], p0[1]), pk2(p0[2], p0[3]), pk2(p0[4], p0[5]), pk2(p0[6], p0[7])};
                    pf[1] = (v4u){pk2(p0[8], p0[9]), pk2(p0[10], p0[11]), pk2(p0[12], p0[13]), pk2(p0[14], p0[15])};
                    pf[2] = (v4u){pk2(p1[0], p1[1]), pk2(p1[2], p1[3]), pk2(p1[4], p1[5]), pk2(p1[6], p1[7])};
                    pf[3] = (v4u){pk2(p1[8], p1[9]), pk2(p1[10], p1[11]), pk2(p1[12], p1[13]), pk2(p1[14], p1[15])};
                    const LAS unsigned char* vl = vb + (4 * hi + ((lane & 15) >> 2)) * VSTR + (16 * ((lane >> 4) & 1) + 4 * (lane & 3)) * 2;
                    __builtin_amdgcn_s_setprio(1);
#pragma unroll
                    for (int st = 0; st < 4; ++st) {
#pragma unroll
                        for (int vbk = 0; vbk < 2; ++vbk) { const s16x4 lo = vtr(vl + (16 * st) * VSTR + vbk * 64), hh = vtr(vl + (16 * st + 8) * VSTR + vbk * 64);
                            const bf16x8 af = (bf16x8){lo[0], lo[1], lo[2], lo[3], hh[0], hh[1], hh[2], hh[3]};
                            if (vbk == 0) o0 = __builtin_amdgcn_mfma_f32_32x32x16_bf16(af, __builtin_bit_cast(bf16x8, pf[st]), o0, 0, 0, 0);
                            else o1 = __builtin_amdgcn_mfma_f32_32x32x16_bf16(af, __builtin_bit_cast(bf16x8, pf[st]), o1, 0, 0, 0); } }
                    __builtin_amdgcn_s_setprio(0);
                } }
                if (ts + 1 < NT / 2) PA_STORE((ts + 1) & 1);
                __syncthreads();
            }
#undef PA_LOAD
#undef PA_STORE
            const float il = 1.f / (lsum + __shfl_xor(lsum, 32));
            bf16_t* orow = Ob + (size_t)(q0 + r32) * 1024 + 4 * hi;
#pragma unroll
            for (int g = 0; g < 4; ++g) { u32x2 a, c; a.x = pk2(o0[4 * g] * il, o0[4 * g + 1] * il); a.y = pk2(o0[4 * g + 2] * il, o0[4 * g + 3] * il); c.x = pk2(o1[4 * g] * il, o1[4 * g + 1] * il); c.y = pk2(o1[4 * g + 2] * il, o1[4 * g + 3] * il);
                *(GAS u32x2*)(orow + 8 * g) = a; *(GAS u32x2*)(orow + 32 + 8 * g) = c; }
        }
    }
}
}
namespace sattn {
typedef float f32x16 __attribute__((ext_vector_type(16)));
typedef short s16x4 __attribute__((ext_vector_type(4)));
constexpr int STR = 336, TILE = 128 * STR;
constexpr int OFF_T0 = 0, OFF_T1 = TILE, OFF_Q = 2 * TILE;
constexpr int OFF_ML = 131072;
constexpr int PSTR = 132;
__device__ __forceinline__ s16x4 vtr(const LAS unsigned char* p) { return __builtin_bit_cast(s16x4, __builtin_amdgcn_ds_read_tr16_b64_v4i16((LAS s16x4*)p)); }
__device__ __forceinline__ void phase(Frame& F, int first, int step) {
    const int w = F.wave, qb2 = w & 1, kg = w >> 1;
    LAS unsigned char* L = F.lds; float* SP = (float*)(F.ws + WS_SPART);
    const float* cckv = F.a->in[I_CCKV]; const float* ckpe = F.a->in[I_CKPE]; const int* pt = (const int*)F.a->in[I_PT];
    for (int unit = first; unit < DB * 2; unit += step) {
        const int sb = unit >> 1, sp = unit & 1;
        { const int tid = w * 64 + lane_now(); const int hq = tid >> 3, rg = tid & 7, h = hq >> 3, t = hq & 7; const bf16_t* qrow = F.QP() + (size_t)(MP + sb * DT + t) * NQ;
          float qn[64];
#pragma unroll
          for (int c = 0; c < 8; ++c) { const v4u v = *(const GAS v4u*)(qrow + h * 64 + c * 8);
#pragma unroll
              for (int e = 0; e < 4; ++e) { qn[c * 8 + 2 * e] = __builtin_bit_cast(float, v[e] << 16); qn[c * 8 + 2 * e + 1] = __builtin_bit_cast(float, v[e] & 0xffff0000u); } }
          const float* wk = F.a->in[I_WUK] + (size_t)(rg * 16) * 512 + h * 64; LAS unsigned char* qd = L + OFF_Q + hq * STR + rg * 32;
#pragma unroll 1
          for (int rr = 0; rr < 16; rr += 2) { float a0 = 0.f, a1 = 0.f; const float* w0p = wk + (size_t)rr * 512;
#pragma unroll
              for (int n = 0; n < 64; n += 4) { const f32x4 w0 = *(const GAS f32x4*)(w0p + n), w1 = *(const GAS f32x4*)(w0p + 512 + n);
                  a0 += qn[n] * w0.x + qn[n + 1] * w0.y + qn[n + 2] * w0.z + qn[n + 3] * w0.w; a1 += qn[n] * w1.x + qn[n + 1] * w1.y + qn[n + 2] * w1.z + qn[n + 3] * w1.w; }
              *(LAS unsigned*)(qd + rr * 2) = pk2(a0, a1); }
          if (rg < 4) { const bf16_t* pe = qrow + 512 + h * 32; bf16_t e8[8];
#pragma unroll
              for (int e = 0; e < 8; ++e) { const int p = rg * 8 + e; e8[e] = pe[p < 16 ? 2 * p : 2 * (p - 16) + 1]; }
              v4u o; o.x = e8[0] | ((unsigned)e8[1] << 16); o.y = e8[2] | ((unsigned)e8[3] << 16); o.z = e8[4] | ((unsigned)e8[5] << 16); o.w = e8[6] | ((unsigned)e8[7] << 16);
              *(LAS v4u*)(L + OFF_Q + hq * STR + 256 + rg * 16) = o; } }
        __syncthreads();
        const int lane = lane_now(), tid = w * 64 + lane, r32 = lane & 31, hi = lane >> 5;
        const LAS unsigned char* qlp = L + OFF_Q + (32 * qb2 + r32) * STR + hi * 16;
        f32x16 o[4];
#pragma unroll
        for (int lb = 0; lb < 4; ++lb)
#pragma unroll
            for (int i = 0; i < 16; ++i) o[lb][i] = 0.f;
        float m = -INFINITY, lsum = 0.f;
        f32x4 gcA[8], gpA[2], gcB[8], gpB[2]; const int mypage = pt[sb * NPAGES + sp * (NPAGES / 2) + lane];
#define SA_LOAD(gc, gp, j) do { const size_t pg = (size_t)(unsigned)__builtin_amdgcn_readlane(mypage, (j));     const __amdgpu_buffer_rsrc_t rc_ = __builtin_amdgcn_make_buffer_rsrc((void*)(cckv + pg * (PAGE * KVL)), 0, PAGE * KVL * 4, 0x00020000), rp_ = __builtin_amdgcn_make_buffer_rsrc((void*)(ckpe + pg * (PAGE * ROPE)), 0, PAGE * ROPE * 4, 0x00020000); \
                _Pragma("unroll") for (int i = 0; i < 8; ++i) gc[i] = __builtin_bit_cast(f32x4, __builtin_amdgcn_raw_buffer_load_b128(rc_, tid * 16 + i * 8192, 0, 2));   \
                _Pragma("unroll") for (int i = 0; i < 2; ++i) gp[i] = __builtin_bit_cast(f32x4, __builtin_amdgcn_raw_buffer_load_b128(rp_, tid * 16 + i * 8192, 0, 2)); } while (0)
#define SA_LOADV(gc, gp) do { const float* c0 = F.out + O_SCKV + (size_t)sb * DT * KVL + tid * 4; const float* p0 = F.out + O_SKPE + (size_t)sb * DT * ROPE + tid * 4;     \
                _Pragma("unroll") for (int i = 0; i < 8; ++i) gc[i] = (i == 0 && tid < 256) ? *(const GAS f32x4*)c0 : (f32x4){0.f, 0.f, 0.f, 0.f}; \
                _Pragma("unroll") for (int i = 0; i < 2; ++i) gp[i] = (i == 0 && tid < 64) ? *(const GAS f32x4*)p0 : (f32x4){0.f, 0.f, 0.f, 0.f}; } while (0)
#define SA_STORE(gc, gp, bufi) do { LAS unsigned char* tb = L + (bufi) * TILE; \
            _Pragma("unroll") for (int i = 0; i < 8; ++i) { const int c = tid + 512 * i; u32x2 v; v.x = pk2(gc[i].x, gc[i].y); v.y = pk2(gc[i].z, gc[i].w); *(LAS u32x2*)(tb + (c >> 5) * STR + (c & 31) * 8) = v; } \
            _Pragma("unroll") for (int i = 0; i < 2; ++i) { const int c = tid + 512 * i; u32x2 v; v.x = pk2(gp[i].x, gp[i].y); v.y = pk2(gp[i].z, gp[i].w); *(LAS u32x2*)(tb + (c >> 3) * STR + 256 + (c & 7) * 8) = v; } } while (0)
#define SA_COMPUTE(newk, bufi) do { \
            if (!newk || kg == 0) { \
                const LAS unsigned char* tb = L + (bufi) * TILE + (32 * kg) * STR; \
                f32x16 p; \
                _Pragma("unroll") for (int i = 0; i < 16; ++i) p[i] = 0.f; \
                _Pragma("unroll") for (int ks = 0; ks < 10; ++ks) { const bf16x8 a = *(const LAS bf16x8*)(tb + r32 * STR + ks * 32 + hi * 16), qk = *(const LAS bf16x8*)(qlp + ks * 32); p = __builtin_amdgcn_mfma_f32_32x32x16_bf16(a, qk, p, 0, 0, 0); } \
                if (newk) { const int tq = r32 & 7;                   \
                    _Pragma("unroll") for (int i = 0; i < 16; ++i) { const int kk = 4 * hi + 8 * (i >> 2) + (i & 3); if (kk > tq) p[i] = -INFINITY; } } \
                float mx = p[0]; \
                _Pragma("unroll") for (int i = 1; i < 16; ++i) mx = fmaxf(mx, p[i]); \
                mx = fmaxf(mx, __shfl_xor(mx, 32)); \
                const float mn = fmaxf(m, mx), alpha = __builtin_amdgcn_exp2f(m - mn); m = mn; float ps = 0.f; \
                _Pragma("unroll") for (int i = 0; i < 16; ++i) { p[i] = __builtin_amdgcn_exp2f(p[i] - mn); ps += p[i]; } \
                lsum = lsum * alpha + ps; \
                _Pragma("unroll") for (int lb = 0; lb < 4; ++lb) _Pragma("unroll") for (int i = 0; i < 16; ++i) o[lb][i] *= alpha; \
                v4u pf[2]; \
                pf[0] = (v4u){pk2(p[0], p[1]), pk2(p[2], p[3]), pk2(p[4], p[5]), pk2(p[6], p[7])}; pf[1] = (v4u){pk2(p[8], p[9]), pk2(p[10], p[11]), pk2(p[12], p[13]), pk2(p[14], p[15])}; \
                const LAS unsigned char* vl = tb + (4 * hi + ((lane & 15) >> 2)) * STR + (16 * ((lane >> 4) & 1) + 4 * (lane & 3)) * 2; \
                _Pragma("unroll") for (int st = 0; st < 2; ++st) _Pragma("unroll") for (int lb = 0; lb < 4; ++lb) { const s16x4 lo = vtr(vl + (16 * st) * STR + lb * 64), hh = vtr(vl + (16 * st + 8) * STR + lb * 64); \
                        const bf16x8 af = (bf16x8){lo[0], lo[1], lo[2], lo[3], hh[0], hh[1], hh[2], hh[3]}; \
                        o[lb] = __builtin_amdgcn_mfma_f32_32x32x16_bf16(af, __builtin_bit_cast(bf16x8, pf[st]), o[lb], 0, 0, 0); } \
            } } while (0)
#define SA_BAR() asm volatile("s_waitcnt lgkmcnt(0)\n\ts_barrier" ::: "memory")
        SA_LOAD(gcB, gpB, 0); SA_STORE(gcB, gpB, 0); asm volatile("" ::: "memory");
        SA_LOAD(gcA, gpA, 1);
        SA_LOAD(gcB, gpB, 2);
        SA_BAR();
#define SA_PAIR(jj, LA, LB) do { \
            SA_COMPUTE(false, 0); \
            SA_STORE(gcA, gpA, 1); asm volatile("" ::: "memory"); \
            if (LA) SA_LOAD(gcA, gpA, (jj) + 3); \
            SA_BAR(); \
            SA_COMPUTE(false, 1); \
            if ((jj) + 2 < NPAGES / 2) { SA_STORE(gcB, gpB, 0); asm volatile("" ::: "memory"); if (LB) SA_LOAD(gcB, gpB, (jj) + 4); } \
            SA_BAR(); } while (0)
#pragma unroll 1
        for (int jj = 0; jj < NPAGES / 2 - 4; jj += 2) SA_PAIR(jj, true, true);
        SA_PAIR(NPAGES / 2 - 4, true, false);
        SA_PAIR(NPAGES / 2 - 2, false, false);
#undef SA_PAIR
        if (sp) {
            SA_LOADV(gcB, gpB); SA_STORE(gcB, gpB, 0); SA_BAR();
            SA_COMPUTE(true, 0);
            SA_BAR();
        }
#undef SA_LOADV
#undef SA_LOAD
#undef SA_STORE
#undef SA_COMPUTE
#undef SA_BAR
        lsum += __shfl_xor(lsum, 32);
        LAS float* PO = (LAS float*)L; LAS float* ML = (LAS float*)(L + OFF_ML);
#pragma unroll
        for (int lb = 0; lb < 4; ++lb)
#pragma unroll
            for (int i = 0; i < 16; ++i) PO[w * 4096 + (lb * 16 + i) * 64 + lane] = o[lb][i];
        if (hi == 0) { ML[w * 64 + r32] = m; ML[w * 64 + 32 + r32] = lsum; }
        __syncthreads();
        { const int q2 = w & 1, jb = (w >> 1) * 16; float mk[4], fk[4], Mx = -INFINITY, Ls = 0.f;
#pragma unroll
          for (int g = 0; g < 4; ++g) { mk[g] = ML[(2 * g + q2) * 64 + r32]; Mx = fmaxf(Mx, mk[g]); }
#pragma unroll
          for (int g = 0; g < 4; ++g) { fk[g] = mk[g] == -INFINITY ? 0.f : __builtin_amdgcn_exp2f(mk[g] - Mx); Ls += fk[g] * ML[(2 * g + q2) * 64 + 32 + r32]; }
          float* dst = SP + ((size_t)unit * 64 + 32 * q2 + r32) * PSTR;
#pragma unroll
          for (int j4 = 0; j4 < 4; ++j4) { f32x4 av;
#pragma unroll
              for (int e = 0; e < 4; ++e) { const int j = jb + 4 * j4 + e; float a = 0.f;
#pragma unroll
                  for (int g = 0; g < 4; ++g) a += fk[g] * PO[(2 * g + q2) * 4096 + j * 64 + lane];
                  av[e] = a; }
              *(GAS f32x4*)(dst + 32 * (jb >> 4) + 8 * j4 + 4 * hi) = av; }
          if (jb == 0 && hi == 0) { dst[128] = Mx; dst[129] = Ls; } }
        __syncthreads();
    }
}
__device__ __forceinline__ void combine_phase(Frame& F) {
    const int lane = lane_now(), tid = F.wave * 64 + lane; const float* SP = (const float*)(F.ws + WS_SPART); LAS float* OL = (LAS float*)F.lds;
    for (int u = blockIdx.x; u < DB * 2; u += F.G) { const int sb = u >> 1, hl = tid >> 4, hq = (u & 1) * 32 + hl;
        { const int rg = tid & 15; const float* a = SP + ((size_t)(2 * sb) * 64 + hq) * PSTR; const float* b = a + 64 * PSTR;
          const float ma = a[128], mb = b[128], Mx = fmaxf(ma, mb), fa = __builtin_amdgcn_exp2f(ma - Mx), fb = __builtin_amdgcn_exp2f(mb - Mx), il = 1.f / (fa * a[129] + fb * b[129]);
          const f32x4 a0 = *(const GAS f32x4*)(a + rg * 8), a1 = *(const GAS f32x4*)(a + rg * 8 + 4), b0 = *(const GAS f32x4*)(b + rg * 8), b1 = *(const GAS f32x4*)(b + rg * 8 + 4);
#pragma unroll
          for (int e = 0; e < 4; ++e) { OL[hl * 129 + rg * 8 + e] = (fa * a0[e] + fb * b0[e]) * il; OL[hl * 129 + rg * 8 + 4 + e] = (fa * a1[e] + fb * b1[e]) * il; } }
        __syncthreads();
        { const int vg = tid & 15, h = hq >> 3, t = hq & 7; const float* wv = F.a->in[I_WUV] + h * 64 + vg * 4; float acc[4] = {0.f, 0.f, 0.f, 0.f};
#pragma unroll 8
          for (int r = 0; r < 128; ++r) { const float ov = OL[hl * 129 + r]; const f32x4 w0 = *(const GAS f32x4*)(wv + (size_t)r * 512);
              acc[0] += ov * w0.x; acc[1] += ov * w0.y; acc[2] += ov * w0.z; acc[3] += ov * w0.w; }
          u32x2 o; o.x = pk2(acc[0], acc[1]); o.y = pk2(acc[2], acc[3]);
          *(GAS u32x2*)(F.MIX() + (size_t)(MP + sb * DT + t) * 1024 + 512 + h * 64 + vg * 4) = o; }
        __syncthreads();
    }
}
}
namespace gdn {
typedef short s16x4 __attribute__((ext_vector_type(4)));
constexpr int STRB = 144, IMG = 64 * STRB;
constexpr size_t WS_GI = (size_t)2680 * MiB;
constexpr size_t ITEM_B = 5 * 8192;
constexpr size_t WS_GL = WS_GI + (size_t)8192 * ITEM_B;
__device__ __forceinline__ s16x4 vtr(const LAS unsigned char* p) { return __builtin_bit_cast(s16x4, __builtin_amdgcn_ds_read_tr16_b64_v4i16((LAS s16x4*)p)); }
__device__ __forceinline__ void zero4(f32x4 (&a)[4]) {
#pragma unroll
    for (int t = 0; t < 4; ++t) a[t] = (f32x4){0.f, 0.f, 0.f, 0.f}; }
__device__ __forceinline__ void strip_mm(f32x4 (&acc)[4], const LAS unsigned char* A, const LAS unsigned char* Bt, const int r0, const int lane) {
    const int c16 = lane & 15, q4 = lane >> 4; bf16x8 a[2], b[2][4];
#pragma unroll
    for (int ks = 0; ks < 2; ++ks) { a[ks] = *(const LAS bf16x8*)(A + (r0 + c16) * STRB + (32 * ks + 8 * q4) * 2);
#pragma unroll
        for (int tn = 0; tn < 4; ++tn) b[ks][tn] = *(const LAS bf16x8*)(Bt + (16 * tn + c16) * STRB + (32 * ks + 8 * q4) * 2); }
    __builtin_amdgcn_sched_barrier(0);
#pragma unroll
    for (int ks = 0; ks < 2; ++ks)
#pragma unroll
        for (int tn = 0; tn < 4; ++tn) acc[tn] = __builtin_amdgcn_mfma_f32_16x16x32_bf16(a[ks], b[ks][tn], acc[tn], 0, 0, 0);
}
__device__ __forceinline__ void strip_mm_at(f32x4 (&acc)[4], const LAS unsigned char* AT, const LAS unsigned char* Bt, const int r0, const int lane) {
    const int c16 = lane & 15, q4 = lane >> 4; s16x4 lo[2], hh[2]; bf16x8 b[2][4];
    const LAS unsigned char* ap = AT + (8 * q4 + (c16 >> 2)) * STRB + (r0 + 4 * (lane & 3)) * 2;
#pragma unroll
    for (int ks = 0; ks < 2; ++ks) { lo[ks] = vtr(ap + (32 * ks) * STRB); hh[ks] = vtr(ap + (32 * ks + 4) * STRB);
#pragma unroll
        for (int tn = 0; tn < 4; ++tn) b[ks][tn] = *(const LAS bf16x8*)(Bt + (16 * tn + c16) * STRB + (32 * ks + 8 * q4) * 2); }
    __builtin_amdgcn_sched_barrier(0);
#pragma unroll
    for (int ks = 0; ks < 2; ++ks) { const bf16x8 a = (bf16x8){lo[ks][0], lo[ks][1], lo[ks][2], lo[ks][3], hh[ks][0], hh[ks][1], hh[ks][2], hh[ks][3]};
#pragma unroll
        for (int tn = 0; tn < 4; ++tn) acc[tn] = __builtin_amdgcn_mfma_f32_16x16x32_bf16(a, b[ks][tn], acc[tn], 0, 0, 0); }
}
__device__ __forceinline__ void strip_mm_bk(f32x4 (&acc)[4], const LAS unsigned char* A, const LAS unsigned char* Bk, const int r0, const int lane) {
    const int c16 = lane & 15, q4 = lane >> 4; bf16x8 a[2]; s16x4 lo[2][4], hh[2][4];
    const LAS unsigned char* bp = Bk + (8 * q4 + (c16 >> 2)) * STRB + (4 * (lane & 3)) * 2;
#pragma unroll
    for (int ks = 0; ks < 2; ++ks) { a[ks] = *(const LAS bf16x8*)(A + (r0 + c16) * STRB + (32 * ks + 8 * q4) * 2);
#pragma unroll
        for (int tn = 0; tn < 4; ++tn) { lo[ks][tn] = vtr(bp + (32 * ks) * STRB + tn * 32); hh[ks][tn] = vtr(bp + (32 * ks + 4) * STRB + tn * 32); } }
    __builtin_amdgcn_sched_barrier(0);
#pragma unroll
    for (int ks = 0; ks < 2; ++ks)
#pragma unroll
        for (int tn = 0; tn < 4; ++tn) { const bf16x8 b = (bf16x8){lo[ks][tn][0], lo[ks][tn][1], lo[ks][tn][2], lo[ks][tn][3], hh[ks][tn][0], hh[ks][tn][1], hh[ks][tn][2], hh[ks][tn][3]};
            acc[tn] = __builtin_amdgcn_mfma_f32_16x16x32_bf16(a[ks], b, acc[tn], 0, 0, 0); }
}
__host__ __device__ __forceinline__ constexpr int lr_n(int r) { return ((r + 3) >> 2) << 2; }
__host__ __device__ __forceinline__ constexpr int lr_off(int r) { return r == 0 ? 0 : (8 * ((r - 1) >> 2) * (((r - 1) >> 2) + 1) + 4 * ((r - 1) & 3) * (((r - 1) >> 2) + 1)); }
static_assert(lr_off(63) + lr_n(63) == 2112 && lr_off(1) == 0 && lr_off(2) == 4 && lr_off(5) == 16 && lr_off(6) == 24, "packed L layout");

__device__ __forceinline__ void prep_seg(const bf16_t* QK, const float* cw, const size_t rowbase, const int t0, const int h, const int seg, const int lane, float (&o)[8][8]) {
    const int rg = lane >> 3, cg = lane & 7, col = seg * 512 + h * 64 + cg * 8;
    float wt[4][8];
#pragma unroll
    for (int j = 0; j < 4; ++j) { const f32x4 a = *(const GAS f32x4*)(cw + j * CONVD + col), b = *(const GAS f32x4*)(cw + j * CONVD + col + 4); wt[j][0] = a.x; wt[j][1] = a.y; wt[j][2] = a.z; wt[j][3] = a.w; wt[j][4] = b.x; wt[j][5] = b.y; wt[j][6] = b.z; wt[j][7] = b.w; }
#pragma unroll
    for (int r = 0; r < 8; ++r)
#pragma unroll
        for (int e = 0; e < 8; ++e) o[r][e] = 0.f;
#pragma unroll
    for (int rr = 0; rr < 11; ++rr) { const int t = t0 + 8 * rg + rr - 3; float x[8];
        if (t >= 0) unpack8(*(const GAS v4u*)(QK + (rowbase + t) * CONVD + col), x); else {
#pragma unroll
            for (int e = 0; e < 8; ++e) x[e] = 0.f; }
#pragma unroll
        for (int j = 0; j < 4; ++j) { const int r = rr - j;
            if (r >= 0 && r < 8) {
#pragma unroll
                for (int e = 0; e < 8; ++e) o[r][e] += wt[j][e] * x[e]; } } }
#pragma unroll
    for (int r = 0; r < 8; ++r) { float ss = 0.f;
#pragma unroll
        for (int e = 0; e < 8; ++e) { o[r][e] = silu_f(o[r][e]); ss += o[r][e] * o[r][e]; }
        if (seg < 2) { ss += __shfl_xor(ss, 1); ss += __shfl_xor(ss, 2); ss += __shfl_xor(ss, 4); const float sc = rsqrtf(ss + 1e-6f) * (seg == 0 ? 0.125f : 1.f);
#pragma unroll
            for (int e = 0; e < 8; ++e) o[r][e] *= sc; } }
}
__device__ __forceinline__ v4u pk8(const float (&a)[8], const float s) { return (v4u){pk2(a[0] * s, a[1] * s), pk2(a[2] * s, a[3] * s), pk2(a[4] * s, a[5] * s), pk2(a[6] * s, a[7] * s)}; }

template <int K> struct SolveRow {
    static __device__ __forceinline__ void run(float (&X)[64], const float xk, const f32x4 (&l)[lr_n(K) / 4], const LAS unsigned char* SB, const int lane) {
        f32x4 ln[lr_n(K - 1) / 4 + 1];
        int o_ = lr_off(K - 1) * 4; asm volatile("" : "+v"(o_) : "v"(xk));
        constexpr int NA = lr_n(K - 1) / 4 < 9 ? lr_n(K - 1) / 4 : 9;
#pragma unroll
        for (int q = 0; q < NA; ++q) ln[q] = *(const LAS f32x4*)(SB + o_ + 16 * q);
        __builtin_amdgcn_sched_barrier(0);
#pragma unroll
        for (int q = 0; q < lr_n(K) / 4; ++q)
#pragma unroll
            for (int e = 0; e < 4; ++e) if (4 * q + e < K) X[4 * q + e] = __builtin_fmaf(xk, l[q][e], X[4 * q + e]);
        const float xn = (lane == K - 1 ? 1.f : 0.f) - X[K - 1]; X[K - 1] = xn;
        __builtin_amdgcn_sched_barrier(0);
#pragma unroll
        for (int q = NA; q < lr_n(K - 1) / 4; ++q) ln[q] = *(const LAS f32x4*)(SB + o_ + 16 * q);
        __builtin_amdgcn_sched_barrier(0);
        if constexpr (K > 1) { const f32x4 (&lr)[lr_n(K - 1) / 4] = reinterpret_cast<const f32x4 (&)[lr_n(K - 1) / 4]>(ln); SolveRow<K - 1>::run(X, xn, lr, SB, lane); }
    }
};
__device__ __forceinline__ void st8_pair16(unsigned char* p, const u32x2 w, const bool evenrow, const bool sel) {
    const auto rx = __builtin_amdgcn_permlane16_swap(w.x, w.x, false, false); const auto ry = __builtin_amdgcn_permlane16_swap(w.y, w.y, false, false);
    const unsigned nx = sel ? rx[1] : rx[0], ny = sel ? ry[1] : ry[0];
    if (evenrow) *(GAS v4u*)p = (v4u){w.x, w.y, nx, ny};
}
__device__ __forceinline__ void intra_item(Frame& F, const int item, LAS unsigned char* SA, LAS unsigned char* SB, LAS float* GC, LAS float* BT) {
    const int lane = lane_now();
    const int chain = item >> 5, n = item & 31, b = chain >> 3, h = chain & 7, c16 = lane & 15, q4 = lane >> 4, rg = lane >> 3, cg = lane & 7;
    const size_t rowbase = (size_t)b * SEQ; const int t0 = 64 * n;
    const bool evenrow = !(q4 & 1); const bool sel = [&] { const auto t = __builtin_amdgcn_permlane16_swap((unsigned)lane, (unsigned)lane, false, false); return t[1] == (unsigned)(lane ^ 16); }();
    unsigned char* gi = F.ws + WS_GI + (size_t)item * ITEM_B; const bf16_t* QK = F.QKVR(); const float* cw = F.a->in[I_GCW];
    { const size_t row = rowbase + t0 + lane; float g = F.BG()[row * 16 + h]; const float bt = F.BG()[row * 16 + 8 + h];
#pragma unroll
      for (int o = 1; o < 64; o <<= 1) { const float y = __shfl_up(g, o); if (lane >= o) g += y; }
      GC[lane] = g; BT[lane] = bt; if (lane == 63) *(float*)(F.ws + WS_GL + (size_t)item * 4) = g; }
    const float gl = GC[63];
    float o[8][8];
    prep_seg(QK, cw, rowbase, t0, h, 1, lane, o);
#pragma unroll
    for (int r = 0; r < 8; ++r) { const int c = 8 * rg + r; *(LAS v4u*)(SA + c * STRB + cg * 16) = pk8(o[r], 1.f); *(GAS v4u*)(gi + 3 * 8192 + c * 128 + cg * 16) = pk8(o[r], __expf(gl - GC[c])); }
    prep_seg(QK, cw, rowbase, t0, h, 0, lane, o);
#pragma unroll
    for (int r = 0; r < 8; ++r) { const int c = 8 * rg + r; *(LAS v4u*)(SB + c * STRB + cg * 16) = pk8(o[r], 1.f); *(GAS v4u*)(gi + 2 * 8192 + c * 128 + cg * 16) = pk8(o[r], __expf(GC[c])); }
#pragma unroll 1
    for (int st = 0; st < 4; ++st) { f32x4 acc[4]; zero4(acc); strip_mm(acc, SA, SB, 16 * st, lane);
#pragma unroll
        for (int tn = 0; tn < 4; ++tn) { const int c = 16 * tn + c16, s0 = 16 * st + 4 * q4; const float gcc = GC[c]; float v[4];
#pragma unroll
            for (int i = 0; i < 4; ++i) v[i] = (c >= s0 + i) ? acc[tn][i] * __expf(gcc - GC[s0 + i]) : 0.f;
            st8_pair16(gi + 8192 + c * 128 + s0 * 2, (u32x2){pk2(v[0], v[1]), pk2(v[2], v[3])}, evenrow, sel); } }
#pragma unroll 1
    for (int st = 0; st < 4; ++st) { f32x4 acc[4]; zero4(acc); strip_mm(acc, SA, SA, 16 * st, lane);
#pragma unroll
        for (int tn = 0; tn < 4; ++tn) { const int bb = 16 * tn + c16, k0 = 16 * st + 4 * q4; const float gb = GC[bb], btb = BT[bb];
            if (k0 < lr_n(bb)) { f32x4 v;
#pragma unroll
                for (int i = 0; i < 4; ++i) v[i] = (k0 + i < bb) ? btb * acc[tn][i] * __expf(gb - GC[k0 + i]) : 0.f;
                *(LAS f32x4*)(SB + (lr_off(bb) + k0) * 4) = v; } } }
    float X[64];
#pragma unroll
    for (int k = 0; k < 64; ++k) X[k] = 0.f;
    { f32x4 l63[16];
#pragma unroll
      for (int q = 0; q < 16; ++q) l63[q] = *(const LAS f32x4*)(SB + (lr_off(63) + 4 * q) * 4);
      const float x63 = lane == 63 ? 1.f : 0.f; SolveRow<63>::run(X, x63, l63, SB, lane); X[63] = x63; }
#pragma unroll
    for (int c8 = 0; c8 < 8; ++c8) { float ww[8]; __builtin_amdgcn_sched_barrier(0);
#pragma unroll
        for (int e = 0; e < 8; ++e) { const int s = c8 * 8 + e; ww[e] = X[s] * BT[s] * __expf(GC[s]); }
        *(LAS v4u*)(SB + lane * STRB + c8 * 16) = pk8(ww, 1.f); }
#pragma unroll 1
    for (int st = 0; st < 4; ++st) { f32x4 acc[4]; zero4(acc); strip_mm_at(acc, SA, SB, 16 * st, lane);
#pragma unroll
        for (int tn = 0; tn < 4; ++tn) { const int c = 16 * tn + c16, d0 = 16 * st + 4 * q4; st8_pair16(gi + c * 128 + d0 * 2, (u32x2){pk2(-acc[tn][0], -acc[tn][1]), pk2(-acc[tn][2], -acc[tn][3])}, evenrow, sel); } }
    prep_seg(QK, cw, rowbase, t0, h, 2, lane, o);
#pragma unroll
    for (int r = 0; r < 8; ++r) *(LAS v4u*)(SA + (8 * rg + r) * STRB + cg * 16) = pk8(o[r], 1.f);
#pragma unroll
    for (int c8 = 0; c8 < 8; ++c8) { float uu[8]; __builtin_amdgcn_sched_barrier(0);
#pragma unroll
        for (int e = 0; e < 8; ++e) { const int s = c8 * 8 + e; uu[e] = X[s] * BT[s]; }
        *(LAS v4u*)(SB + lane * STRB + c8 * 16) = pk8(uu, 1.f); }
#pragma unroll 1
    for (int st = 0; st < 4; ++st) { f32x4 acc[4]; zero4(acc); strip_mm_bk(acc, SB, SA, 16 * st, lane);
#pragma unroll
        for (int tn = 0; tn < 4; ++tn) { const int v = 16 * tn + c16, c0 = 16 * st + 4 * q4; st8_pair16(gi + 4 * 8192 + (v * 64 + c0) * 2, (u32x2){pk2(acc[tn][0], acc[tn][1]), pk2(acc[tn][2], acc[tn][3])}, evenrow, sel); } }
}
__device__ __forceinline__ void sample_chain(Frame& F, const int c2, const int lane) {
    const int sb = c2 >> 3, h = c2 & 7; const size_t row0 = MP + (size_t)sb * DT; const float* S0 = F.a->in[I_SGDN] + (size_t)c2 * 4096; const float* hist = F.a->in[I_SGC] + (size_t)sb * 3 * CONVD; const float* cw = F.a->in[I_GCW];
    float S[64];
#pragma unroll
    for (int d = 0; d < 64; ++d) S[d] = S0[d * 64 + lane];
    float wq[4], wk[4], wv[4];
#pragma unroll
    for (int j = 0; j < 4; ++j) { wq[j] = cw[j * CONVD + h * 64 + lane]; wk[j] = cw[j * CONVD + 512 + h * 64 + lane]; wv[j] = cw[j * CONVD + 1024 + h * 64 + lane]; }
    const float gw = F.a->in[I_GNW][lane];
    for (int t = 0; t < DT; ++t) { const size_t row = row0 + t; float aq = 0.f, ak = 0.f, av = 0.f;
#pragma unroll
        for (int j = 0; j < 4; ++j) { const int tt = t - 3 + j; float xq, xk, xv;
            if (tt >= 0) { const bf16_t* p = F.QKVR() + (row0 + tt) * CONVD + h * 64 + lane; xq = bf2f(p[0]); xk = bf2f(p[512]); xv = bf2f(p[1024]); }
            else { const float* p = hist + (tt + 3) * CONVD + h * 64 + lane; xq = p[0]; xk = p[512]; xv = p[1024]; }
            aq += wq[j] * xq; ak += wk[j] * xk; av += wv[j] * xv; }
        aq = silu_f(aq); ak = silu_f(ak); av = silu_f(av);
        const float qd = aq * rsqrtf(wave_sum(aq * aq) + 1e-6f) * 0.125f, kd = ak * rsqrtf(wave_sum(ak * ak) + 1e-6f);
        const float g = F.BG()[row * 16 + h], beta = F.BG()[row * 16 + 8 + h], eg = __expf(g);
        float ks = 0.f;
#pragma unroll
        for (int d = 0; d < 64; ++d) ks += __builtin_bit_cast(float, __builtin_amdgcn_readlane(__builtin_bit_cast(int, kd), d)) * S[d];
        const float vn = beta * (av - eg * ks); float o = 0.f;
#pragma unroll
        for (int d = 0; d < 64; ++d) { S[d] = eg * S[d] + __builtin_bit_cast(float, __builtin_amdgcn_readlane(__builtin_bit_cast(int, kd), d)) * vn; o += __builtin_bit_cast(float, __builtin_amdgcn_readlane(__builtin_bit_cast(int, qd), d)) * S[d]; }
        const float on = o * rsqrtf(wave_sum(o * o) * (1.f / 64.f) + RMS_EPS) * gw; const float zz = bf2f(F.Z()[row * 512 + h * 64 + lane]);
        F.MIX()[row * 1024 + h * 64 + lane] = f2bf(on * silu_f(zz)); }
    float* so = F.out + O_SGDN + (size_t)c2 * 4096;
#pragma unroll
    for (int d = 0; d < 64; ++d) so[d * 64 + lane] = S[d];
}
__device__ __forceinline__ void intra_phase(Frame& F) {
    LAS unsigned char* base = F.lds + F.wave * (2 * IMG + 512);
    LAS float* GC = (LAS float*)(base + 2 * IMG); LAS float* BT = GC + 64;
    for (int i = F.wave; i * F.G + (int)blockIdx.x < DB * H; i += NWAVES) sample_chain(F, i * F.G + (int)blockIdx.x, lane_now());
    unsigned* ictr = (unsigned*)(F.ctl + CW_IQ);
#pragma unroll 1
    for (;;) { unsigned v_ = 0; if (lane_now() == 0) v_ = __hip_atomic_fetch_add(ictr, 1u, __ATOMIC_RELAXED, __HIP_MEMORY_SCOPE_AGENT);
        const int item = (int)__builtin_amdgcn_readfirstlane(v_); if (item >= BATCH * H * (SEQ / 64)) break;
        intra_item(F, item, base, base + IMG, GC, BT); }
    __syncthreads();
}
static_assert(NWAVES * (2 * IMG + 512) <= MISC_OFF, "per-wave LDS arenas");

constexpr int C_WN = 0, C_AM = IMG, C_QG = 2 * IMG, C_KG = 3 * IMG, C_UT = 4 * IMG, C_SET = 5 * IMG;
constexpr int C_S0 = 2 * C_SET, C_S1 = C_S0 + IMG, C_VN = C_S1 + IMG, C_O = C_VN + IMG, C_END = C_O + IMG;
static_assert(C_END + 128 <= MISC_OFF, "scan LDS map");
__device__ __forceinline__ void scan_chain(Frame& F, const int chain) {
    const int lane = lane_now(), w = F.wave, tid = w * 64 + lane, c16 = lane & 15, q4 = lane >> 4, r0 = 16 * (w & 3);
    const int b = chain >> 3, h = chain & 7; const size_t rowbase = (size_t)b * SEQ; LAS unsigned char* L = F.lds;
    const unsigned char* gi0 = F.ws + WS_GI + (size_t)chain * 32 * ITEM_B; const float* GL = (const float*)(F.ws + WS_GL) + chain * 32;
    const int pr = tid >> 3, pc = tid & 7;
    for (int i = tid; i < IMG / 4; i += 512) ((LAS unsigned*)(L + C_S0))[i] = 0u;
    LAS float* EGL = (LAS float*)(L + C_END); if (tid < 32) EGL[tid] = __expf(GL[tid]);
    v4u g4a[5], g4b[5];
#define GS_LOAD(g4, n) do { const unsigned char* gp_ = gi0 + (size_t)(n) * ITEM_B + pr * 128 + pc * 16; _Pragma("unroll") for (int q = 0; q < 5; ++q) g4[q] = *(const GAS v4u*)(gp_ + q * 8192); } while (0)
#define GS_STORE(g4, set) do { LAS unsigned char* lp_ = L + (set) * C_SET + pr * STRB + pc * 16; _Pragma("unroll") for (int q = 0; q < 5; ++q) *(LAS v4u*)(lp_ + q * IMG) = g4[q]; } while (0)
    GS_LOAD(g4a, 0); GS_STORE(g4a, 0); GS_LOAD(g4a, 1);
    f32x4 Sacc[4]; zero4(Sacc);
    const float gw0 = F.a->in[I_GNW][pc * 8 + 0], gw1 = F.a->in[I_GNW][pc * 8 + 1], gw2 = F.a->in[I_GNW][pc * 8 + 2], gw3 = F.a->in[I_GNW][pc * 8 + 3], gw4 = F.a->in[I_GNW][pc * 8 + 4], gw5 = F.a->in[I_GNW][pc * 8 + 5], gw6 = F.a->in[I_GNW][pc * 8 + 6], gw7 = F.a->in[I_GNW][pc * 8 + 7];
    __syncthreads();
#define SCAN_ITER(n, LD4, ST4, ZC, ZN) do { \
        const LAS unsigned char* I = L + (n & 1) * C_SET; const LAS unsigned char* Sold = L + ((n & 1) ? C_S1 : C_S0); LAS unsigned char* Snew = L + ((n & 1) ? C_S0 : C_S1); \
        if (n + 1 < 32) ZN = *(const GAS v4u*)(F.Z() + (rowbase + 64 * (n + 1) + pr) * 512 + h * 64 + pc * 8);     \
        if (n + 2 < 32) GS_LOAD(LD4, n + 2); \
        f32x4 R[4]; \
        if (w < 4) { const LAS unsigned char* ut = I + C_UT + (r0 + 4 * q4) * 2; \
        _Pragma("unroll") \
            for (int tn = 0; tn < 4; ++tn) { const u32x2 ur = *(const LAS u32x2*)(ut + (16 * tn + c16) * STRB); R[tn] = (f32x4){__builtin_bit_cast(float, ur.x << 16), __builtin_bit_cast(float, ur.x & 0xffff0000u), __builtin_bit_cast(float, ur.y << 16), __builtin_bit_cast(float, ur.y & 0xffff0000u)}; } \
            strip_mm(R, I + C_WN, Sold, r0, lane); \
        _Pragma("unroll") \
            for (int tn = 0; tn < 4; ++tn) *(LAS u32x2*)(L + C_VN + (16 * tn + c16) * STRB + (r0 + 4 * q4) * 2) = (u32x2){pk2(R[tn][0], R[tn][1]), pk2(R[tn][2], R[tn][3])}; } \
        else { zero4(R); strip_mm(R, I + C_QG, Sold, r0, lane); } \
        asm volatile("s_waitcnt lgkmcnt(0)\n\ts_barrier" ::: "memory");     \
        if (w < 4) { const float egl = EGL[n]; \
        _Pragma("unroll") \
            for (int tn = 0; tn < 4; ++tn) Sacc[tn] = Sacc[tn] * egl; \
            strip_mm_at(Sacc, I + C_KG, L + C_VN, r0, lane); \
        _Pragma("unroll") \
            for (int tn = 0; tn < 4; ++tn) *(LAS u32x2*)(Snew + (16 * tn + c16) * STRB + (r0 + 4 * q4) * 2) = (u32x2){pk2(Sacc[tn][0], Sacc[tn][1]), pk2(Sacc[tn][2], Sacc[tn][3])}; } \
        else { strip_mm(R, I + C_AM, L + C_VN, r0, lane); \
        _Pragma("unroll") \
            for (int i = 0; i < 4; ++i) { float ss = R[0][i] * R[0][i] + R[1][i] * R[1][i] + R[2][i] * R[2][i] + R[3][i] * R[3][i]; \
                ss += __shfl_xor(ss, 1); ss += __shfl_xor(ss, 2); ss += __shfl_xor(ss, 4); ss += __shfl_xor(ss, 8); \
                const float rs = rsqrtf(ss * (1.f / 64.f) + RMS_EPS); \
        _Pragma("unroll") \
                for (int tn = 0; tn < 4; ++tn) *(LAS bf16_t*)(L + C_O + (r0 + 4 * q4 + i) * STRB + (16 * tn + c16) * 2) = (bf16_t)(pk2(R[tn][i] * rs, 0.f) & 0xffffu); } } \
        if (n + 1 < 32) GS_STORE(ST4, (n + 1) & 1); \
        asm volatile("s_waitcnt lgkmcnt(0)\n\ts_barrier" ::: "memory");     \
        { float on[8], zz[8]; unpack8(*(const LAS v4u*)(L + C_O + pr * STRB + pc * 16), on); unpack8(ZC, zz); \
          v4u ov; ov.x = pk2(on[0] * gw0 * silu_f(zz[0]), on[1] * gw1 * silu_f(zz[1])); ov.y = pk2(on[2] * gw2 * silu_f(zz[2]), on[3] * gw3 * silu_f(zz[3])); \
          ov.z = pk2(on[4] * gw4 * silu_f(zz[4]), on[5] * gw5 * silu_f(zz[5])); ov.w = pk2(on[6] * gw6 * silu_f(zz[6]), on[7] * gw7 * silu_f(zz[7])); \
          *(GAS v4u*)(F.MIX() + (rowbase + 64 * n + pr) * 1024 + h * 64 + pc * 8) = ov; } \
    } while (0)
    v4u zA = *(const GAS v4u*)(F.Z() + (rowbase + pr) * 512 + h * 64 + pc * 8), zB = zA;
    for (int n2 = 0; n2 < 32; n2 += 2) { SCAN_ITER((n2), g4b, g4a, zA, zB); SCAN_ITER((n2 + 1), g4a, g4b, zB, zA); }
#undef SCAN_ITER
#undef GS_LOAD
#undef GS_STORE
    if (w < 4) { float* so = F.out + O_PGDN + (size_t)chain * 4096;
#pragma unroll
        for (int tn = 0; tn < 4; ++tn)
#pragma unroll
            for (int i = 0; i < 4; ++i) so[(r0 + 4 * q4 + i) * 64 + 16 * tn + c16] = Sacc[tn][i]; }
    __syncthreads();
}
__device__ __forceinline__ void scan_phase(Frame& F) { for (int chain = blockIdx.x; chain < BATCH * H; chain += F.G) scan_chain(F, chain); }
}
namespace smallg {
constexpr int STRB = 144, IMG = 64 * STRB;
template <class Epi> __device__ __forceinline__ void run(Frame& F, const bf16_t* A, const bf16_t* Bt, const int K, const int N, const Epi& E) {
    const int lane = lane_now(), w = F.wave, tid = w * 64 + lane, c16 = lane & 15, q4 = lane >> 4, r0 = 16 * (w & 3), n0w = 32 * (w >> 2), pr = tid >> 3, pc = tid & 7;
    LAS unsigned char* L = F.lds;
    const int nct = N / 64;
    for (int t = blockIdx.x; t < (MS / 64) * nct; t += F.G) { const int row0 = MP + (t / nct) * 64, col0 = (t % nct) * 64;
        const bf16_t* ap = A + (size_t)(row0 + pr) * K + pc * 8; const bf16_t* bp = Bt + (size_t)(col0 + pr) * K + pc * 8;
        f32x4 acc[2] = {(f32x4){0.f, 0.f, 0.f, 0.f}, (f32x4){0.f, 0.f, 0.f, 0.f}};
        v4u ga = *(const GAS v4u*)ap, gb = *(const GAS v4u*)bp;
        *(LAS v4u*)(L + pr * STRB + pc * 16) = ga; *(LAS v4u*)(L + IMG + pr * STRB + pc * 16) = gb;
        __syncthreads();
        const int nk = K / 64;
        for (int kc = 0; kc < nk; ++kc) { const LAS unsigned char* Ai = L + (kc & 1) * 2 * IMG; const LAS unsigned char* Bi = Ai + IMG;
            if (kc + 1 < nk) { ga = *(const GAS v4u*)(ap + (kc + 1) * 64); gb = *(const GAS v4u*)(bp + (kc + 1) * 64); }
            bf16x8 a[2], b[2][2];
#pragma unroll
            for (int ks = 0; ks < 2; ++ks) { a[ks] = *(const LAS bf16x8*)(Ai + (r0 + c16) * STRB + (32 * ks + 8 * q4) * 2);
#pragma unroll
                for (int tn = 0; tn < 2; ++tn) b[ks][tn] = *(const LAS bf16x8*)(Bi + (n0w + 16 * tn + c16) * STRB + (32 * ks + 8 * q4) * 2); }
            __builtin_amdgcn_sched_barrier(0);
#pragma unroll
            for (int ks = 0; ks < 2; ++ks)
#pragma unroll
                for (int tn = 0; tn < 2; ++tn) acc[tn] = __builtin_amdgcn_mfma_f32_16x16x32_bf16(a[ks], b[ks][tn], acc[tn], 0, 0, 0);
            if (kc + 1 < nk) { LAS unsigned char* d = L + ((kc + 1) & 1) * 2 * IMG + pr * STRB + pc * 16; *(LAS v4u*)d = ga; *(LAS v4u*)(d + IMG) = gb; }
            __syncthreads(); }
        LAS float* T = (LAS float*)(L + 4 * IMG);
#pragma unroll
        for (int tn = 0; tn < 2; ++tn)
#pragma unroll
            for (int i = 0; i < 4; ++i) T[(r0 + 4 * q4 + i) * 68 + n0w + 16 * tn + c16] = acc[tn][i];
        __syncthreads();
        { float v[8]; const f32x4 a = *(const LAS f32x4*)(T + pr * 68 + pc * 8), b = *(const LAS f32x4*)(T + pr * 68 + pc * 8 + 4); v[0] = a[0]; v[1] = a[1]; v[2] = a[2]; v[3] = a[3]; v[4] = b[0]; v[5] = b[1]; v[6] = b[2]; v[7] = b[3];
          float s1, s2; E.vec(row0 + pr, col0 + pc * 8, v, s1, s2);
          if constexpr (Epi::STATS) { s1 += __shfl_xor(s1, 1); s1 += __shfl_xor(s1, 2); s1 += __shfl_xor(s1, 4); s2 += __shfl_xor(s2, 1); s2 += __shfl_xor(s2, 2); s2 += __shfl_xor(s2, 4); if (pc == 0) E.stat(row0 + pr, s1, s2); } }
        __syncthreads();
    }
}
__device__ __forceinline__ v4u pk8v(const float (&r)[8]) { return (v4u){pk2(r[0], r[1]), pk2(r[2], r[3]), pk2(r[4], r[5]), pk2(r[6], r[7])}; }
struct EWout { static constexpr bool STATS = true; bf16_t* O; const float* xs; float* ST;
    __device__ __forceinline__ void vec(int row, int col, const float (&v)[8], float& s1, float& s2) const { const float* x = xs + (size_t)(row - MP) * D + col; const f32x4 x0 = *(const GAS f32x4*)x, x1 = *(const GAS f32x4*)(x + 4);
        float r[8]; s1 = 0.f; s2 = 0.f;
#pragma unroll
        for (int e = 0; e < 8; ++e) { r[e] = v[e] + ALPHA * (e < 4 ? x0[e] : x1[e - 4]); s1 += r[e]; s2 += r[e] * r[e]; }
        *(GAS v4u*)(O + (size_t)row * D + col) = pk8v(r); }
    __device__ __forceinline__ void stat(int row, float s1, float s2) const { unsafeAtomicAdd(ST + 2 * row, s1); unsafeAtomicAdd(ST + 2 * row + 1, s2); } };
struct EDown { static constexpr bool STATS = false; bf16_t* O; const bf16_t* R; const float* ST; const float* g1; const float* b1;
    __device__ __forceinline__ void vec(int row, int col, const float (&v)[8], float& s1, float& s2) const { float mu, rstd; ln1_stats(ST, row, mu, rstd); float x[8]; unpack8(*(const GAS v4u*)(R + (size_t)row * D + col), x);
        const f32x4 ga = *(const GAS f32x4*)(g1 + col), gb = *(const GAS f32x4*)(g1 + col + 4), ba = *(const GAS f32x4*)(b1 + col), bb = *(const GAS f32x4*)(b1 + col + 4); float r[8];
#pragma unroll
        for (int e = 0; e < 8; ++e) r[e] = v[e] + ALPHA * ((x[e] - mu) * rstd * (e < 4 ? ga[e] : gb[e - 4]) + (e < 4 ? ba[e] : bb[e - 4]));
        *(GAS v4u*)(O + (size_t)row * D + col) = pk8v(r); s1 = 0.f; s2 = 0.f; } };
struct E1 { static constexpr bool STATS = false; bf16_t* QKVR; bf16_t* Z; bf16_t* SMB; float* out;
    __device__ __forceinline__ void vec(int row, int col, const float (&v)[8], float& s1, float& s2) const { s1 = 0.f; s2 = 0.f; const v4u w = pk8v(v);
        if (col < 1536) { *(GAS v4u*)(QKVR + (size_t)row * 1536 + col) = w; const int r = row - MP, sb = r / DT, t = r % DT;
            if (t >= DT - 3) { float* o = out + O_SGC + ((size_t)sb * 3 + (t - (DT - 3))) * CONVD + col; *(GAS f32x4*)o = (f32x4){v[0], v[1], v[2], v[3]}; *(GAS f32x4*)(o + 4) = (f32x4){v[4], v[5], v[6], v[7]}; } }
        else if (col < 2048) *(GAS v4u*)(Z + (size_t)row * 512 + col - 1536) = w;
        else *(GAS v4u*)(SMB + (size_t)row * 512 + col - 2048) = w; } };
}
#define MIXER_PHASES if (IN(4)) { { const int bid_ = (int)blockIdx.x; if ((F.G & 15) == 0) { if ((bid_ >> 3) & 1) sattn::phase(F, (bid_ >> 4) * 8 + (bid_ & 7), F.G >> 1); } else sattn::phase(F, bid_, F.G); }     pattn::phase(F); } if (IN(5)) { gdn::intra_phase(F); SEAM(5); } if (IN(6)) { sattn::combine_phase(F);     gdn::scan_phase(F); SEAM(6); }
__global__ void __launch_bounds__(NWAVES * 64, 2) fwd(Args args) {
    extern __shared__ __attribute__((aligned(16))) unsigned char lds[];
    Frame F;
    F.lds = (LAS unsigned char*)lds; F.MISC = (volatile LAS unsigned*)(F.lds + MISC_OFF);
    F.wave = __builtin_amdgcn_readfirstlane((int)threadIdx.x >> 6); F.G = gridDim.x;
    F.gw = blockIdx.x * NWAVES + F.wave; F.NGW = F.G * NWAVES;
    unsigned char* w = args.ws; F.ws = w; F.ctl = (gu32*)(w + WS_CTL); F.out = args.out; F.a = &args;
    for (int u = F.wave * 64 + lane_now(); u < (LDS_BYTES - MISC_OFF) / 4; u += NWAVES * 64) ((LAS unsigned*)(F.lds + MISC_OFF))[u] = 0u;
    __syncthreads();
    const int lo = args.ph_lo, hi = args.ph_hi;
    const bool multi = (hi - lo) > 1;
    XcdBarrier bar; bar.bar = (unsigned*)(F.ctl + CW_BAR); bar.x = 0; bar.st = nullptr; bar.lead = 0;
    if (multi) bar = xcd_barrier_post((unsigned*)(F.ctl + CW_BAR), F.MISC + 8, F.wave == 0 ? 1u : 0u);
#define IN(k) (lo <= (k) && (k) < hi)
#define SEAM(k) do { if (IN(k) && IN((k) + 1)) xcd_barrier(bar); } while (0)
    if (IN(0)) { p0_prologue(F); SEAM(0); }
    if (IN(1)) { pg8::Gemm g{F.XB(), F.W1T(), MP, N1, 1024}; pg8::StaticOrder S; S.init(MP, N1, F.G, (int)blockIdx.x); Epi1 E{F.QKVR(), F.Z(), F.out, (LAS float*)(F.lds + RING_BYTES), F.CQN(), F.CN(), F.KPE(), F.BG(), F.a->in[I_KVNW], F.a->in[I_ALOG], F.a->in[I_DTB], F.RT()};
        pg8::gemm_phase<Epi1, pg8::StaticOrder, true, true>(F.lds, g, S, E, F.wave);
        smallg::run(F, F.XB(), F.W1T(), 1024, N1, smallg::E1{F.QKVR(), F.Z(), (bf16_t*)F.SM(), F.out}); SEAM(1); }
    if (IN(2)) { p_tok(F); SEAM(2); }
    if (IN(3)) { { pg8::Gemm g{F.CQN(), F.WUQT(), M, NQ, 256}; pg8::StaticOrder S; S.init(M, NQ, F.G, (int)blockIdx.x); EpiQ E{F.QP(), F.RT()};
          pg8::gemm_phase<EpiQ, pg8::StaticOrder, true, true>(F.lds, g, S, E, F.wave); }
        { pg8::Gemm g{F.CN(), F.WUKVT(), MP, 1024, 256}; pg8::StaticOrder S; S.init(MP, 1024, F.G, (int)blockIdx.x); EpiB16 E{F.KNV(), 1024, 0};
          pg8::gemm_phase<EpiB16, pg8::StaticOrder, true, true>(F.lds, g, S, E, F.wave); }
        SEAM(3); }
    MIXER_PHASES
    if (IN(8)) { pg8::Gemm g{F.MIX(), F.WOUTT(), MP, D, 1024}; pg8::StaticOrder S; S.init(MP, D, F.G, (int)blockIdx.x); EpiPre1 E{(bf16_t*)F.PRE1(), F.XB(), (float*)(F.ws + WS_ST1)};
        pg8::gemm_phase<EpiPre1, pg8::StaticOrder, true, true>(F.lds, g, S, E, F.wave);
        smallg::run(F, F.MIX(), F.WOUTT(), 1024, D, smallg::EWout{(bf16_t*)F.PRE1(), F.a->in[I_XS], (float*)(F.ws + WS_ST1)}); SEAM(8); }
    if (IN(10)) { pg8::Gemm g{(const bf16_t*)F.PRE1(), F.WUPT(), M, FF2, 1024}; pg8::StaticOrder S; S.init(M, FF2, F.G, (int)blockIdx.x); EpiUpCG E{F.U(), F.HB(), (float*)(F.ws + WS_RAWB), (float*)(F.ws + WS_PARTB), F.a->in[I_FCW], F.out, (const float*)(F.ws + WS_GBUP), (const float*)(F.ws + WS_ST1)};
        pg8::gemm_phase<EpiUpCG, pg8::StaticOrder, true, true>(F.lds, g, S, E, F.wave); SEAM(10); }
    if (IN(11)) { p_cg(F); SEAM(11); }
    if (IN(12)) { pg8::Gemm g{F.HB(), F.WDNT(), MP, D, FF}; pg8::StaticOrder S; S.init(MP, D, F.G, (int)blockIdx.x); EpiPre2 E{F.X1B(), (const bf16_t*)F.PRE1(), (const float*)(F.ws + WS_ST1), F.a->in[I_LN1G], F.a->in[I_LN1B]};
        pg8::gemm_phase<EpiPre2, pg8::StaticOrder, true, true>(F.lds, g, S, E, F.wave);
        smallg::run(F, F.HB(), F.WDNT(), FF, D, smallg::EDown{F.X1B(), (const bf16_t*)F.PRE1(), (const float*)(F.ws + WS_ST1), F.a->in[I_LN1G], F.a->in[I_LN1B]}); SEAM(12); }
    if (IN(13)) { p_ln(F, F.X1B(), F.a->in[I_LN2G], F.a->in[I_LN2B], F.out + O_Y, nullptr); }
#undef IN
#undef SEAM
}
static int g_grid = 0;
static bool fast_setup() {
    if (g_grid) return g_grid > 0;
    int dev = 0, cus = 0, per_cu = 0;
    if (hipGetDevice(&dev) != hipSuccess || hipDeviceGetAttribute(&cus, hipDeviceAttributeMultiprocessorCount, dev) != hipSuccess) { g_grid = -1; return false; }
    if (hipFuncSetAttribute((const void*)fwd, hipFuncAttributeMaxDynamicSharedMemorySize, LDS_BYTES) != hipSuccess) { fprintf(stderr, "kernel_launch: hipFuncSetAttribute failed\n"); g_grid = -1; return false; }
    if (hipOccupancyMaxActiveBlocksPerMultiprocessor(&per_cu, (const void*)fwd, NWAVES * 64, LDS_BYTES) != hipSuccess || per_cu < 1) { fprintf(stderr, "kernel_launch: occupancy query says %d blocks/CU\n", per_cu); (void)hipGetLastError(); g_grid = -1; return false; }
    g_grid = cus;
    return true; }
static void fast_launch(void* const* d_in, void* d_out, void* d_ws, hipStream_t st, int lo, int hi) {
    Args a{}; for (int i = 0; i < N_IN; ++i) a.in[i] = (const float*)d_in[i]; a.out = (float*)d_out; a.ws = (unsigned char*)d_ws; a.ph_lo = lo; a.ph_hi = hi;
    hipLaunchKernelGGL(fwd, dim3(g_grid), dim3(NWAVES * 64), LDS_BYTES, st, a);
    const hipError_t e = hipPeekAtLastError(); if (e != hipSuccess) fprintf(stderr, "kernel_launch: launch [%d,%d) failed: %s\n", lo, hi, hipGetErrorName(e)); }
extern "C" void kernel_launch(void* const* d_in, const int* in_sizes, int n_in, void* d_out, int out_size, void* d_ws, size_t ws_size, hipStream_t stream) {
    if (n_in != N_IN || (size_t)out_size != O_END || ws_size < WS_NEED) { fprintf(stderr, "kernel_launch: unexpected sizes n_in %d out %d ws %zu\n", n_in, out_size, ws_size); return; }
    if (!fast_setup()) return;
    hipMemsetAsync((char*)d_ws + WS_CTL, 0, CTL_ZERO_BYTES, stream);
    fast_launch(d_in, d_out, d_ws, stream, 0, 14);
}
```

```cpp
#include <hip/hip_runtime.h>
#include <cstdio>
#include <cstdint>
#include <cmath>
constexpr int D = 1024, BATCH = 32, SEQ = 2048, DB = 128, DT = 8, PAST = 16384, PAGE = 128, NPAGES = 128;
constexpr int MP = BATCH * SEQ, MS = DB * DT, M = MP + MS;
constexpr int H = 8, DK = 64, DV = 64, CONVD = 1536, GCONV = 4;
constexpr int QL = 256, KVL = 128, NOPE = 64, ROPE = 32, VD = 64;
constexpr int INC = 2480, N1 = 2560, FF = 2816, FF2 = 5632, NQ = 768;
constexpr float ALPHA = 1.189207115002721f;
constexpr float RMS_EPS = 1e-6f, LN_EPS = 1e-5f;
constexpr float MLA_SCALE = 0.10206207261596577f;
constexpr float LOG2E = 1.4426950408889634f;
constexpr float QSCALE = MLA_SCALE * LOG2E;
constexpr size_t O_Y = 0;
constexpr size_t O_PCKV = (size_t)M * D;
constexpr size_t O_PKPE = O_PCKV + (size_t)MP * KVL;
constexpr size_t O_PGDN = O_PKPE + (size_t)MP * ROPE;
constexpr size_t O_PGC = O_PGDN + (size_t)BATCH * H * DK * DV;
constexpr size_t O_PFC = O_PGC + (size_t)BATCH * 3 * CONVD;
constexpr size_t O_SCKV = O_PFC + (size_t)BATCH * 2 * FF2;
constexpr size_t O_SKPE = O_SCKV + (size_t)MS * KVL;
constexpr size_t O_SGDN = O_SKPE + (size_t)MS * ROPE;
constexpr size_t O_SGC = O_SGDN + (size_t)DB * H * DK * DV;
constexpr size_t O_SFC = O_SGC + (size_t)DB * 3 * CONVD;
constexpr size_t O_END = O_SFC + (size_t)DB * 2 * FF2;
static_assert(O_END == 86589440, "out size");
enum { I_XP = 0, I_XS, I_CCKV, I_CKPE, I_PT, I_SGDN, I_SGC, I_SFC, I_WIN, I_GCW, I_ALOG, I_DTB, I_GNW, I_QNW, I_WUQ, I_KVNW, I_WUK, I_WUV, I_WOUT, I_LN1G, I_LN1B, I_WUP, I_FCW, I_WDN, I_LN2G, I_LN2B, N_IN };
constexpr size_t MiB = 1u << 20;
constexpr size_t WS_CTL = 0;
constexpr size_t WS_ROPE = 1 * MiB;
constexpr size_t WS_W1T = 2 * MiB;
constexpr size_t WS_WUQT = 8 * MiB;
constexpr size_t WS_WUKVT = 9 * MiB;
constexpr size_t WS_WOUTT = 10 * MiB;
constexpr size_t WS_WUPT = 12 * MiB;
constexpr size_t WS_WDNT = 24 * MiB;
constexpr size_t WS_XB = 32 * MiB;
constexpr size_t WS_QKVR = 164 * MiB;
constexpr size_t WS_Z = 360 * MiB;
constexpr size_t WS_SM = 426 * MiB;
constexpr size_t WS_CQN = 558 * MiB;
constexpr size_t WS_CN = 592 * MiB;
constexpr size_t WS_KPE = 626 * MiB;
constexpr size_t WS_BG = 632 * MiB;
constexpr size_t WS_QP = 638 * MiB;
constexpr size_t WS_KNV = 736 * MiB;
constexpr size_t WS_MIX = 866 * MiB;
constexpr size_t WS_PRE1 = 998 * MiB;
constexpr size_t WS_X1B = 1260 * MiB;
constexpr size_t WS_U = 1392 * MiB;
constexpr size_t WS_HB = 2108 * MiB;
constexpr size_t WS_SPART = 2468 * MiB;
constexpr size_t WS_SLOW = 2560 * MiB;
constexpr size_t WS_NEED = 4600 * MiB;
typedef unsigned short bf16_t;
__device__ __host__ __forceinline__ float bf2f(bf16_t b) { unsigned u = (unsigned)b << 16; return __builtin_bit_cast(float, u); }
__device__ __host__ __forceinline__ bf16_t f2bf(float f) { unsigned u = __builtin_bit_cast(unsigned, f); return (bf16_t)((u + 0x7fffu + ((u >> 16) & 1u)) >> 16); }
__host__ __device__ __forceinline__ int map1(int n) { if (n < 2048) return n; if (n < 2304) return 2064 + (n - 2048); if (n < 2432) return 2320 + (n - 2304); if (n < 2464) return 2448 + (n - 2432); if (n < 2472) return 2048 + (n - 2464); if (n < 2480) return 2056 + (n - 2472); return -1; }
__host__ __device__ __forceinline__ int mapq(int n) { if (n < 512) return (n >> 6) * 96 + (n & 63); const int m = n - 512, h = m >> 5, j = m & 31; return h * 96 + 64 + (j >> 1) + 16 * (j & 1); }
__device__ __forceinline__ float silu_f(float x) { return x * __builtin_amdgcn_rcpf(1.f + __builtin_amdgcn_exp2f(-1.4426950408889634f * x)); }
__device__ __forceinline__ float softplus_f(float x) { return x > 20.f ? x : log1pf(__expf(x)); }
__constant__ double c_invfreq[16] = {1.0, 0.5623413251903491, 0.31622776601683794, 0.1778279410038923, 0.1, 0.05623413251903491, 0.03162277660168379, 0.01778279410038923, 0.01, 0.005623413251903491, 0.0031622776601683794, 0.0017782794100389228, 0.001, 0.0005623413251903491, 0.00031622776601683794, 0.00017782794100389227};
__device__ __forceinline__ void rope_entry(int p, int i, float& c, float& s) {
    const double pos = (double)(p < SEQ ? p : PAST + (p - SEQ));
    const double rev = pos * c_invfreq[i] * 0.15915494309189535;
    const float fr = (float)(rev - __builtin_rint(rev));
    c = __builtin_amdgcn_cosf(fr); s = __builtin_amdgcn_sinf(fr);
}
#define GAS __attribute__((address_space(1)))
#define LAS __attribute__((address_space(3)))
typedef unsigned v4u __attribute__((ext_vector_type(4)));
typedef float f32x4 __attribute__((ext_vector_type(4)));
typedef short bf16x8 __attribute__((ext_vector_type(8)));
typedef GAS unsigned gu32;
typedef GAS unsigned long long gu64;
#define RLX_AGENT __ATOMIC_RELAXED, __HIP_MEMORY_SCOPE_AGENT
#define LDS_WAIT() asm volatile("s_waitcnt lgkmcnt(0)" ::: "memory")
#define VM_WAIT() asm volatile("s_waitcnt vmcnt(0)" ::: "memory")
__device__ __forceinline__ unsigned long long rt() { return __builtin_amdgcn_s_memrealtime(); }
#define XB_TMO      128
#define XB_XCNT(j)  (256  + 64 * (j))
#define XB_XSUB(j)  (1280 + 64 * (j))
#define XB_XGEN(j)  (2304 + 64 * (j))
#define XB_TOP      3328
#define XB_TOPGEN   3392
#define XCD_BAR_WORDS 3456
#define XB_SPIN_CAP (1u << 18)

__device__ __forceinline__ unsigned xb_ld(unsigned* p)              { return __hip_atomic_load(p, __ATOMIC_RELAXED, __HIP_MEMORY_SCOPE_AGENT); }
__device__ __forceinline__ unsigned xb_add(unsigned* p, unsigned v) { return __hip_atomic_fetch_add(p, v, __ATOMIC_RELAXED, __HIP_MEMORY_SCOPE_AGENT); }
__device__ __forceinline__ unsigned xb_xcc_id() { return (unsigned)__builtin_amdgcn_s_getreg((3 << 11) | 20) & 0xFu; }
#define XB_SPIN(cond, bar) do { unsigned _sp = 0; while (cond) { __builtin_amdgcn_s_sleep(1); \
    if ((++_sp & 255u) == 0u) { if (xb_ld(&(bar)[XB_TMO])) break; if (_sp > XB_SPIN_CAP) { atomicAdd(&(bar)[XB_TMO], 1u); break; } } } } while (0)

struct XcdBarrier {
    unsigned* bar; unsigned x; unsigned lead;
    volatile LAS unsigned* st;
};

__device__ __forceinline__ bool xb_lane0() { int l; asm volatile("v_mbcnt_lo_u32_b32 %0, -1, 0\n\tv_mbcnt_hi_u32_b32 %0, -1, %0" : "=v"(l)); return l == 0; }
__device__ __forceinline__ XcdBarrier xcd_barrier_post(unsigned* bar, volatile LAS unsigned* st, unsigned lead  ) {
    XcdBarrier b; b.bar = bar; b.x = xb_xcc_id(); b.st = st; b.lead = lead;
    if (b.lead && xb_lane0()) (void)xb_add(&bar[XB_XCNT(b.x)], 1u);
    return b;
}
__device__ __forceinline__ void xcd_barrier_complete(unsigned* bar, unsigned x, unsigned& nloc, unsigned& nx) {
    const unsigned G = gridDim.x * gridDim.y * gridDim.z;
    unsigned sum, cnt, mine, sp = 0u;
    for (;;) {
        sum = 0u; cnt = 0u; mine = 0u;
#pragma unroll
        for (unsigned j = 0; j < 16; ++j) { const unsigned c = xb_ld(&bar[XB_XCNT(j)]); sum += c; cnt += (c > 0u) ? 1u : 0u; mine = (j == x) ? c : mine; }
        if (sum == G) break;
        __builtin_amdgcn_s_sleep(1);
        if ((++sp & 255u) == 0u) { if (xb_ld(&bar[XB_TMO])) break; if (sp > XB_SPIN_CAP) { atomicAdd(&bar[XB_TMO], 1u); break; } }
    }
    nloc = mine > 0u ? mine : 1u; nx = cnt > 0u ? cnt : 1u;
}

__device__ __forceinline__ void xcd_barrier(const XcdBarrier& b) {
    asm volatile("s_waitcnt vmcnt(0)" ::: "memory");
    __syncthreads();
    if (b.lead && xb_lane0()) {
        unsigned* bar = b.bar;
        __builtin_amdgcn_s_waitcnt(0);
        unsigned nloc = b.st[0], nx = b.st[1];
        if (nloc == 0u) { xcd_barrier_complete(bar, b.x, nloc, nx); b.st[0] = nloc; b.st[1] = nx; }
        const unsigned old = xb_add(&bar[XB_XSUB(b.x)], 1u);
        const unsigned gen = old / nloc;
        if (old + 1u == (gen + 1u) * nloc) {
            __builtin_amdgcn_fence(__ATOMIC_RELEASE, "agent");
            asm volatile("s_waitcnt vmcnt(0)" ::: "memory");
            const unsigned og = xb_add(&bar[XB_TOP], 1u);
            const unsigned tg = og / nx;
            if (og + 1u == (tg + 1u) * nx) xb_add(&bar[XB_TOPGEN], 1u);
            else XB_SPIN(xb_ld(&bar[XB_TOPGEN]) == tg, bar);
            __builtin_amdgcn_fence(__ATOMIC_ACQUIRE, "agent");
            xb_add(&bar[XB_XGEN(b.x)], 1u);
            asm volatile("s_waitcnt vmcnt(0)" ::: "memory");
        } else {
            XB_SPIN(xb_ld(&bar[XB_XGEN(b.x)]) == gen, bar);
            __builtin_amdgcn_fence(__ATOMIC_ACQUIRE, "agent");
            asm volatile("s_waitcnt vmcnt(0)" ::: "memory");
        }
    }
    __syncthreads();
}
namespace pg8 {
#define PG8_LAS __attribute__((address_space(3)))
typedef unsigned short bf16_t;
typedef short bf16x8 __attribute__((ext_vector_type(8)));
typedef float f32x4 __attribute__((ext_vector_type(4)));
typedef unsigned u32x4 __attribute__((ext_vector_type(4)));
constexpr int BM = 256, BK = 64, HALF = 128, HTB = HALF * BK * 2  , STAGE_BYTES = 8 * HTB, NXCD = 8, WGM = 8;

__host__ __device__ __forceinline__ int lds_byte(int r, int c) { const int st = (r >> 4) * 2 + (c >> 5), rr = r & 15, cc = c & 31, ob = rr * 64 + cc * 2; return st * 1024 + (ob ^ (((ob >> 9) & 1) << 5)); }
__host__ __device__ __forceinline__ void stage_rc(int b, int& R, int& C) { const int st = b / 1024, sb = b % 1024, swz = sb ^ (((sb >> 9) & 1) << 5); R = (st >> 1) * 16 + swz / 64; C = (st & 1) * 32 + (swz % 64) / 2; }
__host__ __device__ __forceinline__ int perm32(int rho) { const int n = rho >> 4, i = rho & 15; return 8 * (i >> 2) + 4 * n + (i & 3); }

struct Unit { int pm, pn; };
struct Gemm { const bf16_t* A; const bf16_t* Bt; int M, N, K; };

struct StaticOrder {
    int nM, nN, nwg, G, c, wgm, pnfast;
    __host__ __device__ void init(int M, int N, int G_, int c_, int wgm_ = WGM, int pnfast_ = 0) { nM = M / BM; nN = N / BM; nwg = nM * nN; G = G_; c = c_; wgm = wgm_; pnfast = pnfast_; }
    __host__ __device__ bool next(int i, Unit& u) const {
        const long L = (long)i * G + c; if (L >= nwg) return false;
        int wgid = (int)L; { const int q = nwg / NXCD, r = nwg % NXCD, xcd = wgid % NXCD, off = wgid / NXCD; wgid = (xcd < r ? xcd * (q + 1) : r * (q + 1) + (xcd - r) * q) + off; }
        const int nig = wgm * nN, gid = wgid / nig, fm = gid * wgm, gsz = (nM - fm) < wgm ? (nM - fm) : wgm;
        if (pnfast) { u.pm = fm + (wgid % nig) / nN; u.pn = (wgid % nig) % nN; } else { u.pm = fm + ((wgid % nig) % gsz); u.pn = (wgid % nig) / gsz; }     return true;
    }
    __device__ __forceinline__ void a_ready(const Unit&) const {}
    __device__ __forceinline__ void done(const Unit&) const {}
};

__device__ __forceinline__ unsigned cvt_pk_bf16(float lo, float hi) { unsigned r; asm volatile("v_cvt_pk_bf16_f32 %0, %1, %2" : "=v"(r) : "v"(lo), "v"(hi)); return r; }
typedef float f32x2 __attribute__((ext_vector_type(2)));
template <class Epi, class Sched, bool ALIGN_EPI = false, bool SP2 = false>
__device__ __forceinline__ void gemm_phase(PG8_LAS unsigned char* lds, const Gemm g, const Sched& S, const Epi& E, const int wave_in) {
    int lane_; asm volatile("v_mbcnt_lo_u32_b32 %0, -1, 0\n\tv_mbcnt_hi_u32_b32 %0, -1, %0" : "=v"(lane_));
    const int lane = lane_, wid = wave_in, tid = wid * 64 + lane,
        wr = wid >> 2, wc = wid & 3, fr = lane & 15, fq = lane >> 4;
    int K_ = g.K; asm volatile("" : "+s"(K_));
    const int K = K_, nt = K / BK;
    unsigned voffA[2], voffB[2];
#pragma unroll
    for (int i = 0; i < 2; ++i) { int R, C; stage_rc(tid * 16 + i * 8192, R, C); const int Rb = Epi::PERM ? ((R & ~31) + perm32(R & 31)) : R;
        const int Ra = Epi::APERM ? ((R & 64) + 4 * (R & 15) + ((R >> 4) & 3)) : R;
        voffA[i] = (unsigned)(Ra * K + C) * 2u; voffB[i] = (unsigned)(Rb * K + C) * 2u; }
    const size_t kstep = (size_t)(BK * 2);
    const size_t hstep = (size_t)HALF * K * 2;
    const size_t tstep = 2 * hstep;
    const unsigned ldsw = (unsigned)wid * 1024u;
    const int aoff = lds_byte(wr * 64 + fr, fq * 8), boff = lds_byte(wc * 32 + fr, fq * 8);
#define PG8_SA(b, h) (((b) * 2 + (h)) * HTB)
#define PG8_SB(b, h) ((4 + (b) * 2 + (h)) * HTB)
#define PG8_STAGE(bufoff, gbase, voff) do { _Pragma("unroll") for (int _i = 0; _i < 2; ++_i) \
        __builtin_amdgcn_global_load_lds((const unsigned*)((const char*)(gbase) + (voff)[_i]), (PG8_LAS unsigned*)(lds + (bufoff) + ldsw + _i * 8192), 16, 0, 0); } while (0)
#define PG8_LDA(dst, b, h) do { _Pragma("unroll") for (int m = 0; m < 4; ++m) _Pragma("unroll") for (int k = 0; k < 2; ++k) dst[m][k] = *(const PG8_LAS bf16x8*)(lds + PG8_SA(b, h) + aoff + m * 2048 + k * 1024); } while (0)
#define PG8_LDB(dst, b, h) do { _Pragma("unroll") for (int n = 0; n < 2; ++n) _Pragma("unroll") for (int k = 0; k < 2; ++k) dst[n][k] = *(const PG8_LAS bf16x8*)(lds + PG8_SB(b, h) + boff + n * 2048 + k * 1024); } while (0)
#define PG8_MMA(ai, bj, At, Bt) do { __builtin_amdgcn_s_setprio(1); _Pragma("unroll") for (int m = 0; m < 4; ++m) _Pragma("unroll") for (int n = 0; n < 2; ++n) _Pragma("unroll") for (int k = 0; k < 2; ++k) \
        acc[ai][bj][m][n] = __builtin_amdgcn_mfma_f32_16x16x32_bf16(Bt[n][k], At[m][k], acc[ai][bj][m][n], 0, 0, 0); __builtin_amdgcn_s_setprio(0); } while (0)
#define PG8_WAIT_V(n) asm volatile("s_waitcnt vmcnt(" #n ")" ::: "memory")
#define PG8_WAIT_L(n) asm volatile("s_waitcnt lgkmcnt(" #n ")" ::: "memory")
#define PG8_BAR __builtin_amdgcn_s_barrier()
#define PG8_SCHED __builtin_amdgcn_sched_barrier(0)
    Unit cur, nxt; int ui = 0;
    if (!S.next(0, cur)) return;
    f32x4 acc[2][2][4][2];
#pragma unroll
    for (int a = 0; a < 2; ++a)
#pragma unroll
        for (int b = 0; b < 2; ++b)
#pragma unroll
            for (int m = 0; m < 4; ++m)
#pragma unroll
                for (int n = 0; n < 2; ++n) acc[a][b][m][n] = (f32x4){0.f, 0.f, 0.f, 0.f};
    bf16x8 At[4][2], B0[2][2], B1[2][2];
    const char* cA = (const char*)g.A + (size_t)cur.pm * tstep; const char* cB = (const char*)g.Bt + (size_t)cur.pn * tstep;
    S.a_ready(cur);
    if constexpr (SP2) {
        PG8_STAGE(PG8_SB(0, 0), cB, voffB); PG8_STAGE(PG8_SB(0, 1), cB + hstep, voffB); PG8_STAGE(PG8_SA(0, 0), cA, voffA); PG8_STAGE(PG8_SA(0, 1), cA + hstep, voffA);
        if (wr == 1) PG8_BAR;
        PG8_WAIT_V(2); PG8_BAR;
        PG8_STAGE(PG8_SB(1, 0), cB + kstep, voffB); PG8_STAGE(PG8_SA(1, 0), cA + kstep, voffA); PG8_STAGE(PG8_SB(1, 1), cB + hstep + kstep, voffB);
        PG8_WAIT_V(6); PG8_BAR;
    } else {
        PG8_STAGE(PG8_SB(0, 0), cB, voffB); PG8_STAGE(PG8_SA(0, 0), cA, voffA); PG8_STAGE(PG8_SB(0, 1), cB + hstep, voffB); PG8_STAGE(PG8_SA(0, 1), cA + hstep, voffA);
        if (wr == 1) PG8_BAR;
        PG8_WAIT_V(4); PG8_BAR;
        PG8_STAGE(PG8_SB(1, 0), cB + kstep, voffB); PG8_STAGE(PG8_SA(1, 0), cA + kstep, voffA); PG8_STAGE(PG8_SB(1, 1), cB + hstep + kstep, voffB);
        PG8_WAIT_V(6); PG8_BAR;
    }
    for (;;) {
        const bool has_next = S.next(ui + 1, nxt);
        const char* nA = has_next ? (const char*)g.A + (size_t)nxt.pm * tstep : cA; const char* nB = has_next ? (const char*)g.Bt + (size_t)nxt.pn * tstep : cB;
        for (int t = 0; t < nt; t += 2) {
            const bool last = (t == nt - 2);
            const char* a1 = cA + (size_t)(t + 1) * kstep;
            const char* a2 = last ? nA : cA + (size_t)(t + 2) * kstep; const char* b2 = last ? nB : cB + (size_t)(t + 2) * kstep;
            const char* a3 = a2 + kstep; const char* b3 = b2 + kstep;
            if (last && has_next) S.a_ready(nxt);
            if constexpr (SP2) {
            PG8_LDB(B0, 0, 0); PG8_LDB(B1, 0, 1); PG8_SCHED; PG8_LDA(At, 0, 0); PG8_STAGE(PG8_SA(1, 1), a1 + hstep, voffA);
            PG8_WAIT_V(8); PG8_WAIT_L(0); PG8_BAR; PG8_MMA(0, 0, At, B0); PG8_MMA(0, 1, At, B1); PG8_BAR; PG8_SCHED;
            PG8_LDA(At, 0, 1); PG8_STAGE(PG8_SB(0, 0), b2, voffB); PG8_STAGE(PG8_SB(0, 1), b2 + hstep, voffB); PG8_STAGE(PG8_SA(0, 0), a2, voffA);
            PG8_WAIT_V(8); PG8_WAIT_L(0); PG8_BAR; PG8_MMA(1, 0, At, B0); PG8_MMA(1, 1, At, B1); PG8_BAR; PG8_SCHED;
            PG8_LDB(B0, 1, 0); PG8_LDB(B1, 1, 1); PG8_SCHED; PG8_LDA(At, 1, 0); PG8_STAGE(PG8_SA(0, 1), a2 + hstep, voffA);
            PG8_WAIT_V(8); PG8_WAIT_L(0); PG8_BAR; PG8_MMA(0, 0, At, B0); PG8_MMA(0, 1, At, B1); PG8_BAR; PG8_SCHED;
            PG8_LDA(At, 1, 1); PG8_STAGE(PG8_SB(1, 0), b3, voffB); PG8_STAGE(PG8_SB(1, 1), b3 + hstep, voffB); PG8_STAGE(PG8_SA(1, 0), a3, voffA);
            PG8_WAIT_V(8); PG8_WAIT_L(0); PG8_BAR; PG8_MMA(1, 0, At, B0); PG8_MMA(1, 1, At, B1); PG8_BAR; PG8_SCHED;
            } else {
            PG8_LDB(B0, 0, 0); PG8_SCHED; PG8_LDA(At, 0, 0); PG8_STAGE(PG8_SA(1, 1), a1 + hstep, voffA);
            PG8_WAIT_L(8); PG8_BAR; PG8_WAIT_L(0); PG8_MMA(0, 0, At, B0); PG8_BAR; PG8_SCHED;
            PG8_LDB(B1, 0, 1); PG8_STAGE(PG8_SB(0, 0), b2, voffB);
            PG8_BAR; PG8_WAIT_L(0); PG8_MMA(0, 1, At, B1); PG8_BAR;
            PG8_LDA(At, 0, 1); PG8_STAGE(PG8_SA(0, 0), a2, voffA);
            PG8_BAR; PG8_WAIT_L(0); PG8_MMA(1, 0, At, B0); PG8_BAR; PG8_SCHED;
            PG8_STAGE(PG8_SB(0, 1), b2 + hstep, voffB);
            PG8_WAIT_V(6); PG8_BAR; PG8_MMA(1, 1, At, B1); PG8_BAR;
            PG8_LDB(B0, 1, 0); PG8_SCHED; PG8_LDA(At, 1, 0); PG8_STAGE(PG8_SA(0, 1), a2 + hstep, voffA);
            PG8_WAIT_L(8); PG8_BAR; PG8_WAIT_L(0); PG8_MMA(0, 0, At, B0); PG8_BAR; PG8_SCHED;
            PG8_LDB(B1, 1, 1); PG8_STAGE(PG8_SB(1, 0), b3, voffB);
            PG8_BAR; PG8_WAIT_L(0); PG8_MMA(0, 1, At, B1); PG8_BAR;
            PG8_LDA(At, 1, 1); PG8_STAGE(PG8_SA(1, 0), a3, voffA);
            PG8_BAR; PG8_WAIT_L(0); PG8_MMA(1, 0, At, B0); PG8_BAR; PG8_SCHED;
            PG8_STAGE(PG8_SB(1, 1), b3 + hstep, voffB);
            PG8_WAIT_V(6); PG8_BAR; PG8_MMA(1, 1, At, B1); PG8_BAR;
            }
        }
        if constexpr (ALIGN_EPI) { if (wr == 0) PG8_BAR; }
        if constexpr (!Epi::AFTER_DRAIN) { E(acc, cur, wr, wc, fr, fq); S.done(cur); }
        if (!has_next) break;
#pragma unroll
        for (int a = 0; a < 2; ++a)
#pragma unroll
            for (int b = 0; b < 2; ++b)
#pragma unroll
                for (int m = 0; m < 4; ++m)
#pragma unroll
                    for (int n = 0; n < 2; ++n) acc[a][b][m][n] = (f32x4){0.f, 0.f, 0.f, 0.f};
        cur = nxt; cA = nA; cB = nB; ++ui;
        if constexpr (ALIGN_EPI) { if (wr == 1) PG8_BAR; }
    }
    PG8_WAIT_V(0);
    if constexpr (!ALIGN_EPI) { if (wr == 0) PG8_BAR; }
    PG8_BAR;
    if constexpr (Epi::AFTER_DRAIN) { E.fused(acc, cur, wr, wc, fr, fq, lds, wid, lane); S.done(cur); }
#undef PG8_SA
#undef PG8_SB
#undef PG8_STAGE
#undef PG8_LDA
#undef PG8_LDB
#undef PG8_MMA
#undef PG8_WAIT_V
#undef PG8_WAIT_L
#undef PG8_BAR
#undef PG8_SCHED
}
}
constexpr int NWAVES = 8;
constexpr int RING_BYTES = 131072;
constexpr int MISC_OFF = RING_BYTES + 20480;
constexpr int LDS_BYTES = MISC_OFF + 256;
constexpr int CW_TMO = 0, CW_BAR = 4096, CW_PQ = 12288;
constexpr size_t CTL_ZERO_BYTES = 1 * MiB;
static_assert((CW_BAR + 3456) * 4 <= 32768, "control words");
constexpr size_t WS_GBUP = 65536;
constexpr size_t WS_ST1 = 131072;
static_assert(WS_GBUP + 2 * 5632 * 4 <= WS_ST1 && WS_ST1 + (size_t)66560 * 8 <= 1048576, "per-call zeroed region");
typedef unsigned u32x2 __attribute__((ext_vector_type(2)));
typedef float f32x2 __attribute__((ext_vector_type(2)));
typedef __bf16 bf16x2_t __attribute__((ext_vector_type(2)));
__device__ __forceinline__ unsigned pk2(float lo, float hi) { const f32x2 v = {lo, hi}; const bf16x2_t b = __builtin_convertvector(v, bf16x2_t); return __builtin_bit_cast(unsigned, b); }
__device__ __forceinline__ float wave_sum(float v) {
#pragma unroll
    for (int o = 1; o < 64; o <<= 1) v += __shfl_xor(v, o);
    return v; }

struct Args { const float* in[N_IN]; float* out; unsigned char* ws; int ph_lo, ph_hi; };
static_assert(sizeof(Args) == (N_IN + 2) * 8 + 8, "Args has no padding");
struct Frame {
    LAS unsigned char* lds; volatile LAS unsigned* MISC; gu32* ctl;
    int wave, G, gw, NGW;
    const Args* a; float* out; unsigned char* ws;
#define FB(T, name, off) __device__ __forceinline__ T* name() const { return (T*)(ws + (off)); }
    FB(bf16_t, XB, WS_XB) FB(bf16_t, W1T, WS_W1T) FB(bf16_t, WUQT, WS_WUQT) FB(bf16_t, WUKVT, WS_WUKVT) FB(bf16_t, WOUTT, WS_WOUTT) FB(bf16_t, WUPT, WS_WUPT) FB(bf16_t, WDNT, WS_WDNT)
    FB(bf16_t, QKVR, WS_QKVR) FB(bf16_t, Z, WS_Z) FB(bf16_t, CQN, WS_CQN) FB(bf16_t, CN, WS_CN) FB(bf16_t, KPE, WS_KPE) FB(bf16_t, QP, WS_QP) FB(bf16_t, KNV, WS_KNV)
    FB(bf16_t, MIX, WS_MIX) FB(bf16_t, X1B, WS_X1B) FB(bf16_t, U, WS_U) FB(bf16_t, HB, WS_HB) FB(float, SM, WS_SM) FB(float, BG, WS_BG) FB(float, PRE1, WS_PRE1) FB(float2, RT, WS_ROPE)
#undef FB
};
__device__ __forceinline__ int lane_now() { int l; asm volatile("v_mbcnt_lo_u32_b32 %0, -1, 0\n\tv_mbcnt_hi_u32_b32 %0, -1, %0" : "=v"(l)); return l; }
__device__ __forceinline__ int row_pos(int row) { return row < MP ? (row & (SEQ - 1)) : SEQ + ((row - MP) & (DT - 1)); }

template <class Src> __device__ __forceinline__ void p0_item(const Src& src, bf16_t* WT, int Kd, int Nd, LAS float* scr, int item, int lane) {
    const int nblk = Nd / 32, kb = item / nblk, nb = item % nblk, k0 = 64 * kb, n0 = 32 * nb;
#pragma unroll 8
    for (int i = 0; i < 32; ++i) { const int kk = 2 * i + (lane >> 5); scr[kk * 33 + (lane & 31)] = src(k0 + kk, n0 + (lane & 31)); }
    LDS_WAIT(); asm volatile("" ::: "memory");
    const int c = lane & 7;
#pragma unroll
    for (int j = 0; j < 4; ++j) { const int n = (lane >> 3) + 8 * j; const LAS float* s = scr + (8 * c) * 33 + n;
        v4u o; o.x = pk2(s[0 * 33], s[1 * 33]); o.y = pk2(s[2 * 33], s[3 * 33]); o.z = pk2(s[4 * 33], s[5 * 33]); o.w = pk2(s[6 * 33], s[7 * 33]);
        *(GAS v4u*)(WT + (size_t)(n0 + n) * Kd + k0 + 8 * c) = o; }
    LDS_WAIT(); asm volatile("" ::: "memory");
}
struct SrcW1 { const float* w; __device__ __forceinline__ float operator()(int k, int n) const { const int o = map1(n); return o < 0 ? 0.f : w[(size_t)k * INC + o]; } };
struct SrcUq { const float* w; const float* g; __device__ __forceinline__ float operator()(int k, int n) const { return g[k] * w[(size_t)k * NQ + mapq(n)]; } };
struct SrcUkv { const float* wk; const float* wv; __device__ __forceinline__ float operator()(int k, int n) const { return k >= KVL ? 0.f : (n < 512 ? wk[(size_t)k * 512 + n] : wv[(size_t)k * 512 + n - 512]); } };
struct SrcUp { const float* w; __device__ __forceinline__ float operator()(int k, int n) const { const int j = n & 255, c = (n >> 8) * 128 + (j & 127); return w[(size_t)k * FF2 + (j < 128 ? c : FF + c)]; } };
struct SrcPlain { const float* w; int N; __device__ __forceinline__ float operator()(int k, int n) const { return w[(size_t)k * N + n]; } };
__device__ __forceinline__ void p0_item_up(Frame& F, LAS float* scr, int item, int lane) {
    const float* w = F.a->in[I_WUP]; const float* g1 = F.a->in[I_LN1G]; const float* b1 = F.a->in[I_LN1B]; bf16_t* WT = F.WUPT(); float* G = (float*)(F.ws + WS_GBUP); float* B = G + FF2;
    const int nblk = FF2 / 32, kb = item / nblk, nb = item % nblk, k0 = 64 * kb, n0 = 32 * nb;
    const int nl = n0 + (lane & 31), j = nl & 255, c = (nl >> 8) * 128 + (j & 127), col = j < 128 ? c : FF + c; float sb = 0.f;
#pragma unroll 8
    for (int i = 0; i < 32; ++i) { const int kk = 2 * i + (lane >> 5); const float wv = w[(size_t)(k0 + kk) * FF2 + col]; sb += b1[k0 + kk] * wv; scr[kk * 33 + (lane & 31)] = g1[k0 + kk] * wv; }
    sb += __shfl_xor(sb, 32); if (lane < 32) unsafeAtomicAdd(B + nl, sb);
    LDS_WAIT(); asm volatile("" ::: "memory");
    const int cc = lane & 7;
#pragma unroll
    for (int jj = 0; jj < 4; ++jj) { const int n = (lane >> 3) + 8 * jj; const LAS float* sp = scr + (8 * cc) * 33 + n;
        v4u o; o.x = pk2(sp[0 * 33], sp[1 * 33]); o.y = pk2(sp[2 * 33], sp[3 * 33]); o.z = pk2(sp[4 * 33], sp[5 * 33]); o.w = pk2(sp[6 * 33], sp[7 * 33]);
        *(GAS v4u*)(WT + (size_t)(n0 + n) * 1024 + k0 + 8 * cc) = o;
        float sg = 0.f;
#pragma unroll
        for (int e = 0; e < 4; ++e) sg += __builtin_bit_cast(float, o[e] << 16) + __builtin_bit_cast(float, o[e] & 0xffff0000u);
        sg += __shfl_xor(sg, 1); sg += __shfl_xor(sg, 2); sg += __shfl_xor(sg, 4); if (cc == 0) unsafeAtomicAdd(G + n0 + n, sg); }
    LDS_WAIT(); asm volatile("" ::: "memory");
}
__device__ __forceinline__ void p0_prologue(Frame& F) {
    LAS float* scr = (LAS float*)(F.lds + F.wave * 16384); const int lane = lane_now();
    constexpr int I1 = 16 * (N1 / 32), I2 = 4 * (NQ / 32), I3 = 4 * 32, I4 = 16 * 32, I5 = 16 * (FF2 / 32), I6 = (FF / 64) * 32, NIT = I1 + I2 + I3 + I4 + I5 + I6;
    for (int it = F.gw; it < NIT; it += F.NGW) { int r = it;
        if (r < I1) { p0_item(SrcW1{F.a->in[I_WIN]}, F.W1T(), 1024, N1, scr, r, lane); continue; } r -= I1;
        if (r < I2) { p0_item(SrcUq{F.a->in[I_WUQ], F.a->in[I_QNW]}, F.WUQT(), 256, NQ, scr, r, lane); continue; } r -= I2;
        if (r < I3) { p0_item(SrcUkv{F.a->in[I_WUK], F.a->in[I_WUV]}, F.WUKVT(), 256, 1024, scr, r, lane); continue; } r -= I3;
        if (r < I4) { p0_item(SrcPlain{F.a->in[I_WOUT], 1024}, F.WOUTT(), 1024, 1024, scr, r, lane); continue; } r -= I4;
        if (r < I5) { p0_item_up(F, scr, r, lane); continue; } r -= I5;
        p0_item(SrcPlain{F.a->in[I_WDN], 1024}, F.WDNT(), FF, 1024, scr, r, lane); }
    { const size_t nth = (size_t)F.NGW * 64, t0 = (size_t)F.gw * 64 + lane; const size_t NP8 = (size_t)MP * D / 8, NT8 = (size_t)M * D / 8;
      for (size_t i = t0; i < NT8; i += nth) { const float* s = i < NP8 ? F.a->in[I_XP] + i * 8 : F.a->in[I_XS] + (i - NP8) * 8; const f32x4 a = *(const GAS f32x4*)s, b = *(const GAS f32x4*)(s + 4);
          v4u o; o.x = pk2(a.x, a.y); o.y = pk2(a.z, a.w); o.z = pk2(b.x, b.y); o.w = pk2(b.z, b.w); *(GAS v4u*)(F.XB() + i * 8) = o; } }
    for (int i = F.gw * 64 + lane; i < (SEQ + DT) * 16; i += F.NGW * 64) { float c, s; rope_entry(i / 16, i % 16, c, s); F.RT()[i] = make_float2(c, s); }
}

__device__ __forceinline__ void unpack8(const v4u w, float (&f)[8]) {
#pragma unroll
    for (int i = 0; i < 4; ++i) { f[2 * i] = __builtin_bit_cast(float, w[i] << 16); f[2 * i + 1] = __builtin_bit_cast(float, w[i] & 0xffff0000u); } }
__device__ __forceinline__ v4u pack8(const f32x4 a, const f32x4 b) { v4u w; w.x = pk2(a[0], a[1]); w.y = pk2(a[2], a[3]); w.z = pk2(b[0], b[1]); w.w = pk2(b[2], b[3]); return w; }
template <int NK> __device__ __forceinline__ bool state_row(int row, size_t& off_rows, bool& sample) {
    if (row < MP) { const int t = row & (SEQ - 1); if (t < SEQ - NK) return false; off_rows = (size_t)(row >> 11) * NK + (t - (SEQ - NK)); sample = false; return true; }
    const int r = row - MP, t = r & (DT - 1); if (t < DT - NK) return false; off_rows = (size_t)(r >> 3) * NK + (t - (DT - NK)); sample = true; return true; }
struct Epi1 {
    static constexpr bool PERM = true, AFTER_DRAIN = false, APERM = false;
    bf16_t* QKVR; bf16_t* Z; float* out; LAS float* P; bf16_t* CQN; bf16_t* CN; bf16_t* KPE; float* BG; const float* kvnw; const float* alog; const float* dtb; const float2* RT;
    __device__ __forceinline__ void operator()(const f32x4 (&acc)[2][2][4][2], const pg8::Unit& u, int wr, int wc, int fr, int fq) const {
        if (u.pn < 8) { const int row0 = u.pm * 256 + wr * 64 + fr, cl = wc * 32 + 8 * fq;
#pragma unroll
            for (int ai = 0; ai < 2; ++ai)
#pragma unroll
                for (int m = 0; m < 4; ++m) { const int row = row0 + ai * 128 + m * 16;
                    if (u.pn < 6) { bf16_t* p = QKVR + (size_t)row * 1536 + u.pn * 256 + cl;
#pragma unroll
                        for (int bj = 0; bj < 2; ++bj) *(v4u*)(p + bj * 128) = pack8(acc[ai][bj][m][0], acc[ai][bj][m][1]);
                        size_t orow; bool smp; if (state_row<3>(row, orow, smp)) { float* o = out + (smp ? O_SGC : O_PGC) + orow * CONVD + u.pn * 256 + cl;
#pragma unroll
                            for (int bj = 0; bj < 2; ++bj) { *(f32x4*)(o + bj * 128) = acc[ai][bj][m][0]; *(f32x4*)(o + bj * 128 + 4) = acc[ai][bj][m][1]; } } }
                    else { bf16_t* p = Z + (size_t)row * 512 + (u.pn - 6) * 256 + cl;
#pragma unroll
                        for (int bj = 0; bj < 2; ++bj) *(v4u*)(p + bj * 128) = pack8(acc[ai][bj][m][0], acc[ai][bj][m][1]); } }
            return; }
        { const int lo_ = lane_now(); fr = lo_ & 15; fq = lo_ >> 4; }
        const int row0 = u.pm * 256 + wr * 64 + fr, cl = wc * 32 + 8 * fq;
        const int nb = u.pn == 8 ? 2 : 1;
#pragma unroll
        for (int ai = 0; ai < 2; ++ai)
#pragma unroll
            for (int m = 0; m < 4; ++m) { float ss = 0.f;
#pragma unroll
                for (int bj = 0; bj < 2; ++bj) if (bj < nb) { const f32x4 a = acc[ai][bj][m][0], b = acc[ai][bj][m][1]; ss += (a[0] * a[0] + a[1] * a[1]) + (a[2] * a[2] + a[3] * a[3]) + (b[0] * b[0] + b[1] * b[1]) + (b[2] * b[2] + b[3] * b[3]); }
                ss += __shfl_xor(ss, 16); ss += __shfl_xor(ss, 32);
                if (fq == 0) P[(ai * 128 + wr * 64 + m * 16 + fr) * 4 + wc] = ss; }
        asm volatile("s_waitcnt lgkmcnt(0)\n\ts_barrier" ::: "memory");
#pragma unroll
        for (int ai = 0; ai < 2; ++ai)
#pragma unroll
            for (int m = 0; m < 4; ++m) { const int row = row0 + ai * 128 + m * 16; const f32x4 p4 = *(const LAS f32x4*)(P + (ai * 128 + wr * 64 + m * 16 + fr) * 4);
                const float tot = (p4[0] + p4[1]) + (p4[2] + p4[3]);
                if (u.pn == 8) { const float r = rsqrtf(tot * (1.f / 256.f) + RMS_EPS); bf16_t* p = CQN + (size_t)row * 256 + cl;
#pragma unroll
                    for (int bj = 0; bj < 2; ++bj) *(v4u*)(p + bj * 128) = pack8(acc[ai][bj][m][0] * r, acc[ai][bj][m][1] * r); }
                else { const float r = rsqrtf(tot * (1.f / 128.f) + RMS_EPS); const f32x4 g0 = *(const f32x4*)(kvnw + cl), g1 = *(const f32x4*)(kvnw + cl + 4);
                    const f32x4 c0 = acc[ai][0][m][0] * r * g0, c1 = acc[ai][0][m][1] * r * g1; float* oc = out + O_PCKV + (size_t)row * KVL + cl;
                    *(f32x4*)oc = c0; *(f32x4*)(oc + 4) = c1; *(v4u*)(CN + (size_t)row * 256 + cl) = pack8(c0, c1); *(v4u*)(CN + (size_t)row * 256 + 128 + cl) = (v4u){0u, 0u, 0u, 0u};
                    const f32x4 x0 = acc[ai][1][m][0], x1 = acc[ai][1][m][1];
                    if (wc == 0) { f32x4 q0, q1;
#pragma unroll
                        for (int e = 0; e < 4; ++e) { q0[e] = __shfl_xor(x0[e], 32); q1[e] = __shfl_xor(x1[e], 32); }
                        if (fq < 2) { const float2* rt = RT + (row & (SEQ - 1)) * 16 + 8 * fq; f32x4 ya, yb, za, zb;
#pragma unroll
                            for (int e = 0; e < 4; ++e) { const float2 ca = rt[e], cb = rt[4 + e]; ya[e] = x0[e] * ca.x - q0[e] * ca.y; za[e] = x0[e] * ca.y + q0[e] * ca.x; yb[e] = x1[e] * cb.x - q1[e] * cb.y; zb[e] = x1[e] * cb.y + q1[e] * cb.x; }
                            float* ok = out + O_PKPE + (size_t)row * ROPE + 8 * fq; *(f32x4*)ok = ya; *(f32x4*)(ok + 4) = yb; *(f32x4*)(ok + 16) = za; *(f32x4*)(ok + 20) = zb;
                            bf16_t* kp = KPE + (size_t)row * 32 + 16 * fq;
                            *(v4u*)kp = (v4u){pk2(ya[0], za[0]), pk2(ya[1], za[1]), pk2(ya[2], za[2]), pk2(ya[3], za[3])}; *(v4u*)(kp + 8) = (v4u){pk2(yb[0], zb[0]), pk2(yb[1], zb[1]), pk2(yb[2], zb[2]), pk2(yb[3], zb[3])}; } }
                    else if (wc == 1 && fq == 0) { f32x4 b0, b1;
#pragma unroll
                        for (int e = 0; e < 4; ++e) { b0[e] = 1.f / (1.f + __expf(-x0[e])); b1[e] = 1.f / (1.f + __expf(-x1[e])); }
                        *(f32x4*)(BG + (size_t)row * 16 + 8) = b0; *(f32x4*)(BG + (size_t)row * 16 + 12) = b1; }
                    else if (wc == 1 && fq == 1) { f32x4 gA, gB;
#pragma unroll
                        for (int e = 0; e < 4; ++e) { gA[e] = -__expf(alog[e]) * softplus_f(x0[e] + dtb[e]); gB[e] = -__expf(alog[4 + e]) * softplus_f(x1[e] + dtb[4 + e]); }
                        *(f32x4*)(BG + (size_t)row * 16) = gA; *(f32x4*)(BG + (size_t)row * 16 + 4) = gB; } } }
        asm volatile("s_waitcnt lgkmcnt(0)\n\ts_barrier" ::: "memory");
    }
};
struct EpiQ {
    static constexpr bool PERM = true, AFTER_DRAIN = false, APERM = false;
    bf16_t* QP; const float2* RT;
    __device__ __forceinline__ void operator()(const f32x4 (&acc)[2][2][4][2], const pg8::Unit& u, int wr, int wc, int fr, int fq) const {
        const int row0 = u.pm * 256 + wr * 64 + fr, cl = wc * 32 + 8 * fq;
#pragma unroll
        for (int ai = 0; ai < 2; ++ai)
#pragma unroll
            for (int m = 0; m < 4; ++m) { const int row = row0 + ai * 128 + m * 16; bf16_t* p = QP + (size_t)row * NQ + u.pn * 256 + cl;
                if (u.pn < 2) {
#pragma unroll
                    for (int bj = 0; bj < 2; ++bj) *(v4u*)(p + bj * 128) = pack8(acc[ai][bj][m][0] * QSCALE, acc[ai][bj][m][1] * QSCALE); }
                else { const float2* rt = RT + row_pos(row) * 16 + 4 * fq; const f32x4 cs01 = *(const f32x4*)rt, cs23 = *(const f32x4*)(rt + 2);
#pragma unroll
                    for (int bj = 0; bj < 2; ++bj) { const f32x4 a = acc[ai][bj][m][0], b = acc[ai][bj][m][1]; f32x4 ra, rb;
                        ra[0] = a[0] * cs01[0] - a[1] * cs01[1]; ra[1] = a[0] * cs01[1] + a[1] * cs01[0]; ra[2] = a[2] * cs01[2] - a[3] * cs01[3]; ra[3] = a[2] * cs01[3] + a[3] * cs01[2];
                        rb[0] = b[0] * cs23[0] - b[1] * cs23[1]; rb[1] = b[0] * cs23[1] + b[1] * cs23[0]; rb[2] = b[2] * cs23[2] - b[3] * cs23[3]; rb[3] = b[2] * cs23[3] + b[3] * cs23[2];
                        *(v4u*)(p + bj * 128) = pack8(ra * QSCALE, rb * QSCALE); } } }
    }
};
struct EpiB16 {
    static constexpr bool PERM = true, AFTER_DRAIN = false, APERM = false;
    bf16_t* O; int ld; int pad;
    __device__ __forceinline__ void operator()(const f32x4 (&acc)[2][2][4][2], const pg8::Unit& u, int wr, int wc, int fr, int fq) const {
        const int row0 = u.pm * 256 + wr * 64 + fr, c0 = u.pn * 256 + wc * 32 + 8 * fq;
#pragma unroll
        for (int ai = 0; ai < 2; ++ai)
#pragma unroll
            for (int m = 0; m < 4; ++m) { bf16_t* p = O + (size_t)(row0 + ai * 128 + m * 16) * ld + c0;
#pragma unroll
                for (int bj = 0; bj < 2; ++bj) *(v4u*)(p + bj * 128) = pack8(acc[ai][bj][m][0], acc[ai][bj][m][1]); }
    }
};
struct EpiUp {
    static constexpr bool PERM = true, AFTER_DRAIN = false, APERM = false;
    bf16_t* U; float* out;
    __device__ __forceinline__ void operator()(const f32x4 (&acc)[2][2][4][2], const pg8::Unit& u, int wr, int wc, int fr, int fq) const {
        const int row0 = u.pm * 256 + wr * 64 + fr, c0 = u.pn * 256 + wc * 32 + 8 * fq;
#pragma unroll
        for (int ai = 0; ai < 2; ++ai)
#pragma unroll
            for (int m = 0; m < 4; ++m) { const int row = row0 + ai * 128 + m * 16; bf16_t* p = U + (size_t)row * FF2 + c0;
#pragma unroll
                for (int bj = 0; bj < 2; ++bj) *(v4u*)(p + bj * 128) = pack8(acc[ai][bj][m][0], acc[ai][bj][m][1]);
                size_t orow; bool smp; if (state_row<2>(row, orow, smp)) { float* o = out + (smp ? O_SFC : O_PFC) + orow * FF2 + c0;
#pragma unroll
                    for (int bj = 0; bj < 2; ++bj) { *(f32x4*)(o + bj * 128) = acc[ai][bj][m][0]; *(f32x4*)(o + bj * 128 + 4) = acc[ai][bj][m][1]; } } }
    }
};
struct EpiRes {
    static constexpr bool PERM = false, AFTER_DRAIN = false, APERM = false;
    float* O; const float* R0; const float* R1;
    __device__ __forceinline__ void operator()(const f32x4 (&acc)[2][2][4][2], const pg8::Unit& u, int wr, int wc, int fr, int fq) const {
        const int row0 = u.pm * 256 + wr * 64 + fr, c0 = u.pn * 256 + wc * 32 + 4 * fq;
#pragma unroll
        for (int ai = 0; ai < 2; ++ai)
#pragma unroll
            for (int m = 0; m < 4; ++m) { const int row = row0 + ai * 128 + m * 16; const float* r = (row < MP ? R0 + (size_t)row * D : R1 + (size_t)(row - MP) * D) + c0; float* o = O + (size_t)row * D + c0;
#pragma unroll
                for (int bj = 0; bj < 2; ++bj)
#pragma unroll
                    for (int n = 0; n < 2; ++n) { const f32x4 x = *(const f32x4*)(r + bj * 128 + n * 16); *(f32x4*)(o + bj * 128 + n * 16) = acc[ai][bj][m][n] + ALPHA * x; } }
    }
};

struct EpiPre1 {
    static constexpr bool PERM = true, AFTER_DRAIN = false, APERM = false;
    bf16_t* O; const bf16_t* RB; float* ST;
    __device__ __forceinline__ void operator()(const f32x4 (&acc)[2][2][4][2], const pg8::Unit& u, int wr, int wc, int fr, int fq) const {
        const int row0 = u.pm * 256 + wr * 64 + fr, c0 = u.pn * 256 + wc * 32 + 8 * fq;
#pragma unroll
        for (int ai = 0; ai < 2; ++ai)
#pragma unroll
            for (int m = 0; m < 4; ++m) { const int row = row0 + ai * 128 + m * 16; const size_t off = (size_t)row * D + c0; float s1 = 0.f, s2 = 0.f;
#pragma unroll
                for (int bj = 0; bj < 2; ++bj) { float xx[8]; unpack8(*(const v4u*)(RB + off + bj * 128), xx); const f32x4 x0 = {xx[0], xx[1], xx[2], xx[3]}, x1 = {xx[4], xx[5], xx[6], xx[7]};
                    const f32x4 v0 = acc[ai][bj][m][0] + ALPHA * x0, v1 = acc[ai][bj][m][1] + ALPHA * x1;
                    s1 += (v0[0] + v0[1]) + (v0[2] + v0[3]) + (v1[0] + v1[1]) + (v1[2] + v1[3]);
                    s2 += (v0[0] * v0[0] + v0[1] * v0[1]) + (v0[2] * v0[2] + v0[3] * v0[3]) + (v1[0] * v1[0] + v1[1] * v1[1]) + (v1[2] * v1[2] + v1[3] * v1[3]);
                    *(v4u*)(O + off + bj * 128) = pack8(v0, v1); }
                s1 += __shfl_xor(s1, 16); s1 += __shfl_xor(s1, 32); s2 += __shfl_xor(s2, 16); s2 += __shfl_xor(s2, 32);
                if (fq == 0) { unsafeAtomicAdd(ST + 2 * row, s1); unsafeAtomicAdd(ST + 2 * row + 1, s2); } }
    }
};
__device__ __forceinline__ void ln1_stats(const float* ST, int row, float& mu, float& rstd) { const f32x2 s = *(const f32x2*)(ST + 2 * row); mu = s.x * (1.f / D); rstd = rsqrtf(fmaxf(s.y * (1.f / D) - mu * mu, 0.f) + LN_EPS); }
struct EpiPre2 {
    static constexpr bool PERM = true, AFTER_DRAIN = false, APERM = false;
    bf16_t* O; const bf16_t* R; const float* ST; const float* g1; const float* b1;
    __device__ __forceinline__ void operator()(const f32x4 (&acc)[2][2][4][2], const pg8::Unit& u, int wr, int wc, int fr, int fq) const {
        const int row0 = u.pm * 256 + wr * 64 + fr, c0 = u.pn * 256 + wc * 32 + 8 * fq;
        f32x4 gg[2][2], bb[2][2];
#pragma unroll
        for (int bj = 0; bj < 2; ++bj)
#pragma unroll
            for (int n = 0; n < 2; ++n) { gg[bj][n] = *(const f32x4*)(g1 + c0 + bj * 128 + 4 * n); bb[bj][n] = *(const f32x4*)(b1 + c0 + bj * 128 + 4 * n); }
#pragma unroll
        for (int ai = 0; ai < 2; ++ai)
#pragma unroll
            for (int m = 0; m < 4; ++m) { const int row = row0 + ai * 128 + m * 16; const size_t off = (size_t)row * D + c0; float mu, rstd; ln1_stats(ST, row, mu, rstd);
#pragma unroll
                for (int bj = 0; bj < 2; ++bj) { float x[8]; unpack8(*(const v4u*)(R + off + bj * 128), x);
                    const f32x4 x0 = ((f32x4){x[0], x[1], x[2], x[3]} - mu) * rstd * gg[bj][0] + bb[bj][0], x1 = ((f32x4){x[4], x[5], x[6], x[7]} - mu) * rstd * gg[bj][1] + bb[bj][1];
                    *(v4u*)(O + off + bj * 128) = pack8(acc[ai][bj][m][0] + ALPHA * x0, acc[ai][bj][m][1] + ALPHA * x1); } }
    }
};
struct EpiResB {
    static constexpr bool PERM = false, AFTER_DRAIN = false, APERM = false;
    float* O; const bf16_t* R;
    __device__ __forceinline__ void operator()(const f32x4 (&acc)[2][2][4][2], const pg8::Unit& u, int wr, int wc, int fr, int fq) const {
        const int row0 = u.pm * 256 + wr * 64 + fr, c0 = u.pn * 256 + wc * 32 + 4 * fq;
#pragma unroll
        for (int ai = 0; ai < 2; ++ai)
#pragma unroll
            for (int m = 0; m < 4; ++m) { const size_t off = (size_t)(row0 + ai * 128 + m * 16) * D + c0;
#pragma unroll
                for (int bj = 0; bj < 2; ++bj)
#pragma unroll
                    for (int n = 0; n < 2; ++n) { const u32x2 xr = *(const u32x2*)(R + off + bj * 128 + n * 16);
                        const f32x4 x = {__builtin_bit_cast(float, xr.x << 16), __builtin_bit_cast(float, xr.x & 0xffff0000u), __builtin_bit_cast(float, xr.y << 16), __builtin_bit_cast(float, xr.y & 0xffff0000u)};
                        *(f32x4*)(O + off + bj * 128 + n * 16) = acc[ai][bj][m][n] + ALPHA * x; } }
    }
};
__device__ __forceinline__ float dpp_shr1(float v) { return __builtin_bit_cast(float, __builtin_amdgcn_update_dpp(0, __builtin_bit_cast(int, v), 0x111, 0xf, 0xf, true)); }
constexpr size_t WS_RAWB = (size_t)3100 * MiB, WS_PARTB = (size_t)3160 * MiB;
struct EpiUpCG {
    static constexpr bool PERM = true, AFTER_DRAIN = false, APERM = true;
    bf16_t* U; bf16_t* HB; float* RAWB; float* PARTB; const float* cw; float* out; const float* GB; const float* ST;
    __device__ __forceinline__ void operator()(const f32x4 (&acc_)[2][2][4][2], const pg8::Unit& u, int wr, int wc, int fr, int fq) const {
        f32x4 (&acc)[2][2][4][2] = const_cast<f32x4 (&)[2][2][4][2]>(acc_);
        { const float* Gp = GB + u.pn * 256 + wc * 32 + 8 * fq; f32x4 Gv[2][2], Bv[2][2];
#pragma unroll
          for (int bj = 0; bj < 2; ++bj)
#pragma unroll
              for (int n = 0; n < 2; ++n) { Gv[bj][n] = *(const f32x4*)(Gp + bj * 128 + 4 * n); Bv[bj][n] = *(const f32x4*)(Gp + FF2 + bj * 128 + 4 * n); }
#pragma unroll
          for (int ai = 0; ai < 2; ++ai)
#pragma unroll
              for (int m = 0; m < 4; ++m) { float mu, rstd; ln1_stats(ST, u.pm * 256 + ai * 128 + wr * 64 + 4 * fr + m, mu, rstd);
#pragma unroll
                  for (int bj = 0; bj < 2; ++bj)
#pragma unroll
                      for (int n = 0; n < 2; ++n) acc[ai][bj][m][n] = (acc[ai][bj][m][n] - mu * Gv[bj][n]) * rstd + Bv[bj][n]; } }
        const int c0 = u.pn * 128 + wc * 32 + 8 * fq;
        if (u.pm >= MP / 256) {
#pragma unroll
            for (int ai = 0; ai < 2; ++ai)
#pragma unroll
                for (int m = 0; m < 4; ++m) { const int row = u.pm * 256 + ai * 128 + wr * 64 + 4 * fr + m; bf16_t* p = U + (size_t)row * FF2 + u.pn * 256 + wc * 32 + 8 * fq;
#pragma unroll
                    for (int bj = 0; bj < 2; ++bj) *(v4u*)(p + bj * 128) = pack8(acc[ai][bj][m][0], acc[ai][bj][m][1]);
                    size_t orow; bool smp; if (state_row<2>(row, orow, smp)) { float* o = out + O_SFC + orow * FF2 + c0;
#pragma unroll
                        for (int bj = 0; bj < 2; ++bj) { *(f32x4*)(o + bj * FF) = acc[ai][bj][m][0]; *(f32x4*)(o + bj * FF + 4) = acc[ai][bj][m][1]; } } }
            return; }
#pragma unroll
        for (int ai = 0; ai < 2; ++ai) { const int tok0 = u.pm * 256 + ai * 128 + wr * 64, blk = tok0 >> 6; u32x2 hp0[4];
#pragma unroll
            for (int n = 0; n < 2; ++n) { f32x4 wU[3], wG[3];
#pragma unroll
                for (int j = 0; j < 3; ++j) { wU[j] = *(const f32x4*)(cw + j * FF2 + c0 + 4 * n); wG[j] = *(const f32x4*)(cw + j * FF2 + FF + c0 + 4 * n); }
                const f32x4 u0 = acc[ai][0][0][n], u1 = acc[ai][0][1][n], u2 = acc[ai][0][2][n], u3 = acc[ai][0][3][n], g0 = acc[ai][1][0][n], g1 = acc[ai][1][1][n], g2 = acc[ai][1][2][n], g3 = acc[ai][1][3][n];
                f32x4 su3, su2, sg3, sg2;
#pragma unroll
                for (int e = 0; e < 4; ++e) { su3[e] = dpp_shr1(u3[e]); su2[e] = dpp_shr1(u2[e]); sg3[e] = dpp_shr1(g3[e]); sg2[e] = dpp_shr1(g2[e]); }
                u32x2 hq[4];
                { const f32x4 hu = wU[2] * u0 + wU[1] * su3 + wU[0] * su2, hg = wG[2] * g0 + wG[1] * sg3 + wG[0] * sg2;
                  if (fr == 0) { float* pp = PARTB + (size_t)blk * 2 * FF2 + c0 + 4 * n; *(f32x4*)pp = hu; *(f32x4*)(pp + FF) = hg; }
                  hq[0] = (u32x2){pk2(silu_f(hg[0]) * hu[0], silu_f(hg[1]) * hu[1]), pk2(silu_f(hg[2]) * hu[2], silu_f(hg[3]) * hu[3])}; }
                { const f32x4 hu = wU[2] * u1 + wU[1] * u0 + wU[0] * su3, hg = wG[2] * g1 + wG[1] * g0 + wG[0] * sg3;
                  if (fr == 0) { float* pp = PARTB + (size_t)blk * 2 * FF2 + FF2 + c0 + 4 * n; *(f32x4*)pp = hu; *(f32x4*)(pp + FF) = hg; }
                  hq[1] = (u32x2){pk2(silu_f(hg[0]) * hu[0], silu_f(hg[1]) * hu[1]), pk2(silu_f(hg[2]) * hu[2], silu_f(hg[3]) * hu[3])}; }
                { const f32x4 hu = wU[2] * u2 + wU[1] * u1 + wU[0] * u0, hg = wG[2] * g2 + wG[1] * g1 + wG[0] * g0;
                  hq[2] = (u32x2){pk2(silu_f(hg[0]) * hu[0], silu_f(hg[1]) * hu[1]), pk2(silu_f(hg[2]) * hu[2], silu_f(hg[3]) * hu[3])}; }
                { const f32x4 hu = wU[2] * u3 + wU[1] * u2 + wU[0] * u1, hg = wG[2] * g3 + wG[1] * g2 + wG[0] * g1;
                  hq[3] = (u32x2){pk2(silu_f(hg[0]) * hu[0], silu_f(hg[1]) * hu[1]), pk2(silu_f(hg[2]) * hu[2], silu_f(hg[3]) * hu[3])}; }
                if (fr == 15) { float* rp = RAWB + (size_t)blk * 2 * FF2 + c0 + 4 * n;
                    *(f32x4*)rp = u2; *(f32x4*)(rp + FF) = g2; *(f32x4*)(rp + FF2) = u3; *(f32x4*)(rp + FF2 + FF) = g3;
                    if ((blk & 31) == 31) { float* o = out + O_PFC + (size_t)(blk >> 5) * 2 * FF2 + c0 + 4 * n; *(f32x4*)o = u2; *(f32x4*)(o + FF) = g2; *(f32x4*)(o + FF2) = u3; *(f32x4*)(o + FF2 + FF) = g3; } }
                if (n == 0) {
#pragma unroll
                    for (int m = 0; m < 4; ++m) hp0[m] = hq[m]; }
                else { bf16_t* hp = HB + (size_t)(tok0 + 4 * fr) * FF + c0;
#pragma unroll
                    for (int m = 0; m < 4; ++m) if (fr != 0 || m >= 2) *(v4u*)(hp + (size_t)m * FF) = (v4u){hp0[m].x, hp0[m].y, hq[m].x, hq[m].y}; } } }
    }
};

__device__ __forceinline__ void p_tok(Frame& F) {
    const float* kvnw = F.a->in[I_KVNW]; const float* alog = F.a->in[I_ALOG]; const float* dtb = F.a->in[I_DTB]; const int l = lane_now();
    const f32x2 kvw = *(const f32x2*)(kvnw + 2 * l);
    for (int row = MP + F.gw; row < M; row += F.NGW) { const bf16_t* s = (const bf16_t*)F.SM() + (size_t)row * 512;
        const u32x2 qr = *(const GAS u32x2*)(s + 4 * l); const unsigned cr = *(const GAS unsigned*)(s + 256 + 2 * l); const float sm = bf2f(s[384 + l]);
        const f32x4 q = {__builtin_bit_cast(float, qr.x << 16), __builtin_bit_cast(float, qr.x & 0xffff0000u), __builtin_bit_cast(float, qr.y << 16), __builtin_bit_cast(float, qr.y & 0xffff0000u)}; const f32x2 c = {__builtin_bit_cast(float, cr << 16), __builtin_bit_cast(float, cr & 0xffff0000u)};
        const float r1 = rsqrtf(wave_sum(q.x * q.x + q.y * q.y + q.z * q.z + q.w * q.w) * (1.f / 256.f) + RMS_EPS);
        const float r2 = rsqrtf(wave_sum(c.x * c.x + c.y * c.y) * (1.f / 128.f) + RMS_EPS);
        u32x2 w; w.x = pk2(q.x * r1, q.y * r1); w.y = pk2(q.z * r1, q.w * r1); *(GAS u32x2*)(F.CQN() + (size_t)row * 256 + 4 * l) = w;
        const float c0 = c.x * r2 * kvw.x, c1 = c.y * r2 * kvw.y;
        float* ockv = row < MP ? F.out + O_PCKV + (size_t)row * KVL : F.out + O_SCKV + (size_t)(row - MP) * KVL;
        float* okpe = row < MP ? F.out + O_PKPE + (size_t)row * ROPE : F.out + O_SKPE + (size_t)(row - MP) * ROPE;
        *(GAS f32x2*)(ockv + 2 * l) = (f32x2){c0, c1}; ((GAS unsigned*)(F.CN() + (size_t)row * 256))[l] = pk2(c0, c1); ((GAS unsigned*)(F.CN() + (size_t)row * 256 + 128))[l] = 0u;
        const float x2 = __shfl(sm, (l + 16) & 63);
        if (l < 16) { const float2 cs = F.RT()[row_pos(row) * 16 + l]; const float y1 = sm * cs.x - x2 * cs.y, y2 = sm * cs.y + x2 * cs.x; okpe[l] = y1; okpe[16 + l] = y2; ((GAS unsigned*)(F.KPE() + (size_t)row * 32))[l] = pk2(y1, y2); }
        if (l >= 32 && l < 40) F.BG()[(size_t)row * 16 + 8 + (l - 32)] = 1.f / (1.f + __expf(-sm));
        if (l >= 40 && l < 48) { const int h = l - 40; F.BG()[(size_t)row * 16 + h] = -__expf(alog[h]) * softplus_f(sm + dtb[h]); } }
}
__device__ __forceinline__ void p_ln(Frame& F, const bf16_t* in, const float* g, const float* bt, float* outp, bf16_t* ob) {
    const int l = lane_now(); f32x4 gg[4], bb[4];
#pragma unroll
    for (int j = 0; j < 4; ++j) { gg[j] = *(const f32x4*)(g + 4 * l + 256 * j); bb[j] = *(const f32x4*)(bt + 4 * l + 256 * j); }
    for (int row = F.gw; row < M; row += F.NGW) { const GAS u32x2* xr = (const GAS u32x2*)(in + (size_t)row * D) + l; f32x4 v[4]; float s = 0.f;
#pragma unroll
        for (int j = 0; j < 4; ++j) { const u32x2 r = xr[64 * j]; v[j] = (f32x4){__builtin_bit_cast(float, r.x << 16), __builtin_bit_cast(float, r.x & 0xffff0000u), __builtin_bit_cast(float, r.y << 16), __builtin_bit_cast(float, r.y & 0xffff0000u)}; s += (v[j].x + v[j].y) + (v[j].z + v[j].w); }
        const float mean = wave_sum(s) * (1.f / D); float s2 = 0.f;
#pragma unroll
        for (int j = 0; j < 4; ++j) { v[j] = v[j] - mean; s2 += (v[j].x * v[j].x + v[j].y * v[j].y) + (v[j].z * v[j].z + v[j].w * v[j].w); }
        const float rstd = rsqrtf(wave_sum(s2) * (1.f / D) + LN_EPS);
#pragma unroll
        for (int j = 0; j < 4; ++j) { const f32x4 y = v[j] * rstd * gg[j] + bb[j]; if (outp) *((GAS f32x4*)(outp + (size_t)row * D) + l + 64 * j) = y;
            if (ob) { u32x2 w; w.x = pk2(y.x, y.y); w.y = pk2(y.z, y.w); *((GAS u32x2*)(ob + (size_t)row * D) + l + 64 * j) = w; } } }
}
__device__ __forceinline__ void p_cg(Frame& F) {
    const float* cw = F.a->in[I_FCW]; const float* hist = F.a->in[I_SFC]; const float* RAWB = (const float*)(F.ws + WS_RAWB); const float* PARTB = (const float*)(F.ws + WS_PARTB);
    const int lane = lane_now(); const int gt = F.gw * 64 + lane, gn = F.NGW * 64;
    for (int it = gt; it < (MP / 64) * 2 * (FF / 4); it += gn) { const int c = (it % (FF / 4)) * 4, r = (it / (FF / 4)) & 1, blk = it / (2 * (FF / 4));
        const float* pp = PARTB + ((size_t)blk * 2 + r) * FF2 + c; f32x4 hu = *(const GAS f32x4*)pp, hg = *(const GAS f32x4*)(pp + FF);
        if (blk & 31) { const float* rp = RAWB + (size_t)(blk - 1) * 2 * FF2 + c; const f32x4 u62 = *(const GAS f32x4*)rp, g62 = *(const GAS f32x4*)(rp + FF), u63 = *(const GAS f32x4*)(rp + FF2), g63 = *(const GAS f32x4*)(rp + FF2 + FF);
            const f32x4 wu0 = *(const GAS f32x4*)(cw + c), wg0 = *(const GAS f32x4*)(cw + FF + c), wu1 = *(const GAS f32x4*)(cw + FF2 + c), wg1 = *(const GAS f32x4*)(cw + FF2 + FF + c);
            if (r == 0) { hu += wu1 * u63 + wu0 * u62; hg += wg1 * g63 + wg0 * g62; } else { hu += wu0 * u63; hg += wg0 * g63; } }
        u32x2 w; w.x = pk2(silu_f(hg[0]) * hu[0], silu_f(hg[1]) * hu[1]); w.y = pk2(silu_f(hg[2]) * hu[2], silu_f(hg[3]) * hu[3]);
        *(GAS u32x2*)(F.HB() + (size_t)(blk * 64 + r) * FF + c) = w; }
    for (int it = gt; it < MS * (FF / 8); it += gn) { const int cg = it % (FF / 8), rs = it / (FF / 8), c = cg * 8, row = MP + rs, t = rs & (DT - 1); const int pc = (c >> 7) * 256 + (c & 127);
        float au[8], ag[8];
#pragma unroll
        for (int e = 0; e < 8; ++e) { au[e] = 0.f; ag[e] = 0.f; }
#pragma unroll
        for (int j = 0; j < 3; ++j) { const int tt = t + j - 2; float xu[8], xg[8];
            if (tt >= 0) { const bf16_t* p = F.U() + (size_t)(row - t + tt) * FF2 + pc; unpack8(*(const GAS v4u*)p, xu); unpack8(*(const GAS v4u*)(p + 128), xg); }
            else { const float* h = hist + ((size_t)(rs >> 3) * 2 + (tt + 2)) * FF2 + c;
#pragma unroll
                for (int e = 0; e < 8; ++e) { xu[e] = h[e]; xg[e] = h[FF + e]; } }
#pragma unroll
            for (int e = 0; e < 8; ++e) { au[e] += cw[j * FF2 + c + e] * xu[e]; ag[e] += cw[j * FF2 + FF + c + e] * xg[e]; } }
        v4u w; w.x = pk2(silu_f(ag[0]) * au[0], silu_f(ag[1]) * au[1]); w.y = pk2(silu_f(ag[2]) * au[2], silu_f(ag[3]) * au[3]); w.z = pk2(silu_f(ag[4]) * au[4], silu_f(ag[5]) * au[5]); w.w = pk2(silu_f(ag[6]) * au[6], silu_f(ag[7]) * au[7]);
        *(GAS v4u*)(F.HB() + (size_t)row * FF + c) = w; }
}
namespace pattn {
typedef float f32x16 __attribute__((ext_vector_type(16)));
typedef short s16x4 __attribute__((ext_vector_type(4)));
constexpr int KSTR = 208, VSTR = 192, KBUF = 128 * KSTR, VBUF = 128 * VSTR, BUF = KBUF + VBUF;
__device__ __forceinline__ s16x4 vtr(const LAS unsigned char* p) { return __builtin_bit_cast(s16x4, __builtin_amdgcn_ds_read_tr16_b64_v4i16((LAS s16x4*)p)); }
__device__ __forceinline__ void phase(Frame& F) {
    const int lane = lane_now(), w = F.wave, tid = w * 64 + lane, r32 = lane & 31, hi = lane >> 5;
    const int skey = tid >> 3, sc = tid & 7, pkey = tid >> 2, pc = tid & 3;
    LAS unsigned char* L = F.lds;
    unsigned* qctr = (unsigned*)(F.ctl + CW_PQ); LAS int* qs = (LAS int*)(L + 2 * BUF);
    for (;;) {
        if (tid == 0) *qs = (int)__hip_atomic_fetch_add(qctr, 1u, __ATOMIC_RELAXED, __HIP_MEMORY_SCOPE_AGENT);
        __syncthreads();
        const int item = __builtin_amdgcn_readfirstlane(*qs);
        __syncthreads();
        if (item >= BATCH * H * 8) break;
        const int qb = 7 - (item >> 8), unit = item & 255;
        const int b = unit >> 3, h = unit & 7;
        const bf16_t* KNVb = F.KNV() + (size_t)b * SEQ * 1024 + h * 64; const bf16_t* KPEb = F.KPE() + (size_t)b * SEQ * 32; const bf16_t* QPb = F.QP() + (size_t)b * SEQ * NQ;
        bf16_t* Ob = F.MIX() + (size_t)b * SEQ * 1024 + 512 + h * 64;
        {
            const int q0 = qb * 256 + w * 32, NT = 4 * (qb + 1);
            bf16x8 qf[6];
            { const bf16_t* qrow = QPb + (size_t)(q0 + r32) * NQ;
#pragma unroll
              for (int ks = 0; ks < 4; ++ks) qf[ks] = *(const GAS bf16x8*)(qrow + h * 64 + ks * 16 + hi * 8);
#pragma unroll
              for (int ks = 0; ks < 2; ++ks) qf[4 + ks] = *(const GAS bf16x8*)(qrow + 512 + h * 32 + ks * 16 + hi * 8); }
            f32x16 o0, o1;
#pragma unroll
            for (int i = 0; i < 16; ++i) { o0[i] = 0.f; o1[i] = 0.f; }
            float m = -INFINITY, lsum = 0.f;
            v4u gk[2], gv[2], gp;
#define PA_LOAD(ts) do { _Pragma("unroll") for (int u_ = 0; u_ < 2; ++u_) { const bf16_t* kp_ = KNVb + (size_t)(128 * (ts) + 64 * u_ + skey) * 1024 + sc * 8; gk[u_] = *(const GAS v4u*)kp_; gv[u_] = *(const GAS v4u*)(kp_ + 512); } \
                        gp = *(const GAS v4u*)(KPEb + (size_t)(128 * (ts) + pkey) * 32 + pc * 8); } while (0)
#define PA_STORE(bufi) do { LAS unsigned char* kb_ = L + (bufi) * BUF; _Pragma("unroll") for (int u_ = 0; u_ < 2; ++u_) { *(LAS v4u*)(kb_ + (64 * u_ + skey) * KSTR + sc * 16) = gk[u_]; *(LAS v4u*)(kb_ + KBUF + (64 * u_ + skey) * VSTR + sc * 16) = gv[u_]; } \
                        *(LAS v4u*)(kb_ + pkey * KSTR + 128 + pc * 16) = gp; } while (0)
            PA_LOAD(0); PA_STORE(0); __syncthreads();
            for (int ts = 0; ts < NT / 2; ++ts) {
                if (ts + 1 < NT / 2) PA_LOAD(ts + 1);
#pragma unroll 1
                for (int sub = 0; sub < 2; ++sub) { const int t = 2 * ts + sub;
                if (64 * t <= q0 + 31) {
                    const LAS unsigned char* kb = L + (ts & 1) * BUF + sub * 64 * KSTR; const LAS unsigned char* vb = L + (ts & 1) * BUF + KBUF + sub * 64 * VSTR;
                    f32x16 p0, p1;
#pragma unroll
                    for (int i = 0; i < 16; ++i) { p0[i] = 0.f; p1[i] = 0.f; }
                    __builtin_amdgcn_s_setprio(1);
#pragma unroll
                    for (int ks = 0; ks < 6; ++ks) { const bf16x8 a0 = *(const LAS bf16x8*)(kb + r32 * KSTR + ks * 32 + hi * 16), a1 = *(const LAS bf16x8*)(kb + (32 + r32) * KSTR + ks * 32 + hi * 16);
                        p0 = __builtin_amdgcn_mfma_f32_32x32x16_bf16(a0, qf[ks], p0, 0, 0, 0); p1 = __builtin_amdgcn_mfma_f32_32x32x16_bf16(a1, qf[ks], p1, 0, 0, 0); }
                    __builtin_amdgcn_s_setprio(0);
                    if (64 * t + 63 > q0) { const int qa = q0 + r32, k0 = 64 * t + 4 * hi;
#pragma unroll
                        for (int i = 0; i < 16; ++i) { const int kk = k0 + 8 * (i >> 2) + (i & 3); if (kk > qa) p0[i] = -INFINITY; if (kk + 32 > qa) p1[i] = -INFINITY; } }
                    float mx = fmaxf(p0[0], p1[0]);
#pragma unroll
                    for (int i = 1; i < 16; ++i) mx = fmaxf(mx, fmaxf(p0[i], p1[i]));
                    mx = fmaxf(mx, __shfl_xor(mx, 32));
                    const float mn = fmaxf(m, mx); const bool resc = __any(mx > m);
                    float ps = 0.f;
#pragma unroll
                    for (int i = 0; i < 16; ++i) { p0[i] = __builtin_amdgcn_exp2f(p0[i] - mn); p1[i] = __builtin_amdgcn_exp2f(p1[i] - mn); ps += p0[i] + p1[i]; }
                    if (resc) { const float alpha = __builtin_amdgcn_exp2f(m - mn); lsum *= alpha;
#pragma unroll
                        for (int i = 0; i < 16; ++i) { o0[i] *= alpha; o1[i] *= alpha; } }
                    lsum += ps; m = mn;
                    v4u pf[4];
                    pf[0] = (v4u){pk2(p0[0], p0[1]), pk2(p0[2], p0[3]), pk2(p0[4], p0[5]), pk2(p0[6], p0[7])};
                    pf[1] = (v4u){pk2(p0[8], p0[9]), pk2(p0[10], p0[11]), pk2(p0[12], p0[13]), pk2(p0[14], p0[15])};
                    pf[2] = (v4u){pk2(p1[0], p1[1]), pk2(p1[2], p1[3]), pk2(p1[4], p1[5]), pk2(p1[6], p1[7])};
                    pf[3] = (v4u){pk2(p1[8], p1[9]), pk2(p1[10], p1[11]), pk2(p1[12], p1[13]), pk2(p1[14], p1[15])};
                    const LAS unsigned char* vl = vb + (4 * hi + ((lane & 15) >> 2)) * VSTR + (16 * ((lane >> 4) & 1) + 4 * (lane & 3)) * 2;
                    __builtin_amdgcn_s_setprio(1);
#pragma unroll
                    for (int st = 0; st < 4; ++st) {
#pragma unroll
                        for (int vbk = 0; vbk < 2; ++vbk) { const s16x4 lo = vtr(vl + (16 * st) * VSTR + vbk * 64), hh = vtr(vl + (16 * st + 8) * VSTR + vbk * 64);
                            const bf16x8 af = (bf16x8){lo[0], lo[1], lo[2], lo[3], hh[0], hh[1], hh[2], hh[3]};
                            if (vbk == 0) o0 = __builtin_amdgcn_mfma_f32_32x32x16_bf16(af, __builtin_bit_cast(bf16x8, pf[st]), o0, 0, 0, 0);
                            else o1 = __builtin_amdgcn_mfma_f32_32x32x16_bf16(af, __builtin_bit_cast(bf16x8, pf[st]), o1, 0, 0, 0); } }
                    __builtin_amdgcn_s_setprio(0);
                } }
                if (ts + 1 < NT / 2) PA_STORE((ts + 1) & 1);
                __syncthreads();
            }
#undef PA_LOAD
#undef PA_STORE
            const float il = 1.f / (lsum + __shfl_xor(lsum, 32));
            bf16_t* orow = Ob + (size_t)(q0 + r32) * 1024 + 4 * hi;
#pragma unroll
            for (int g = 0; g < 4; ++g) { u32x2 a, c; a.x = pk2(o0[4 * g] * il, o0[4 * g + 1] * il); a.y = pk2(o0[4 * g + 2] * il, o0[4 * g + 3] * il); c.x = pk2(o1[4 * g] * il, o1[4 * g + 1] * il); c.y = pk2(o1[4 * g + 2] * il, o1[4 * g + 3] * il);
                *(GAS u32x2*)(orow + 8 * g) = a; *(GAS u32x2*)(orow + 32 + 8 * g) = c; }
        }
    }
}
}
namespace sattn {
typedef float f32x16 __attribute__((ext_vector_type(16)));
typedef short s16x4 __attribute__((ext_vector_type(4)));
constexpr int STR = 336, TILE = 128 * STR;
constexpr int OFF_T0 = 0, OFF_T1 = TILE, OFF_Q = 2 * TILE;
constexpr int OFF_ML = 131072;
constexpr int PSTR = 132;
__device__ __forceinline__ s16x4 vtr(const LAS unsigned char* p) { return __builtin_bit_cast(s16x4, __builtin_amdgcn_ds_read_tr16_b64_v4i16((LAS s16x4*)p)); }
__device__ __forceinline__ void phase(Frame& F, int first, int step) {
    const int w = F.wave, qb2 = w & 1, kg = w >> 1;
    LAS unsigned char* L = F.lds; float* SP = (float*)(F.ws + WS_SPART);
    const float* cckv = F.a->in[I_CCKV]; const float* ckpe = F.a->in[I_CKPE]; const int* pt = (const int*)F.a->in[I_PT];
    for (int unit = first; unit < DB * 2; unit += step) {
        const int sb = unit >> 1, sp = unit & 1;
        { const int tid = w * 64 + lane_now(); const int hq = tid >> 3, rg = tid & 7, h = hq >> 3, t = hq & 7; const bf16_t* qrow = F.QP() + (size_t)(MP + sb * DT + t) * NQ;
          float qn[64];
#pragma unroll
          for (int c = 0; c < 8; ++c) { const v4u v = *(const GAS v4u*)(qrow + h * 64 + c * 8);
#pragma unroll
              for (int e = 0; e < 4; ++e) { qn[c * 8 + 2 * e] = __builtin_bit_cast(float, v[e] << 16); qn[c * 8 + 2 * e + 1] = __builtin_bit_cast(float, v[e] & 0xffff0000u); } }
          const float* wk = F.a->in[I_WUK] + (size_t)(rg * 16) * 512 + h * 64; LAS unsigned char* qd = L + OFF_Q + hq * STR + rg * 32;
#pragma unroll 1
          for (int rr = 0; rr < 16; rr += 2) { float a0 = 0.f, a1 = 0.f; const float* w0p = wk + (size_t)rr * 512;
#pragma unroll
              for (int n = 0; n < 64; n += 4) { const f32x4 w0 = *(const GAS f32x4*)(w0p + n), w1 = *(const GAS f32x4*)(w0p + 512 + n);
                  a0 += qn[n] * w0.x + qn[n + 1] * w0.y + qn[n + 2] * w0.z + qn[n + 3] * w0.w; a1 += qn[n] * w1.x + qn[n + 1] * w1.y + qn[n + 2] * w1.z + qn[n + 3] * w1.w; }
              *(LAS unsigned*)(qd + rr * 2) = pk2(a0, a1); }
          if (rg < 4) { const bf16_t* pe = qrow + 512 + h * 32; bf16_t e8[8];
#pragma unroll
              for (int e = 0; e < 8; ++e) { const int p = rg * 8 + e; e8[e] = pe[p < 16 ? 2 * p : 2 * (p - 16) + 1]; }
              v4u o; o.x = e8[0] | ((unsigned)e8[1] << 16); o.y = e8[2] | ((unsigned)e8[3] << 16); o.z = e8[4] | ((unsigned)e8[5] << 16); o.w = e8[6] | ((unsigned)e8[7] << 16);
              *(LAS v4u*)(L + OFF_Q + hq * STR + 256 + rg * 16) = o; } }
        __syncthreads();
        const int lane = lane_now(), tid = w * 64 + lane, r32 = lane & 31, hi = lane >> 5;
        const LAS unsigned char* qlp = L + OFF_Q + (32 * qb2 + r32) * STR + hi * 16;
        f32x16 o[4];
#pragma unroll
        for (int lb = 0; lb < 4; ++lb)
#pragma unroll
            for (int i = 0; i < 16; ++i) o[lb][i] = 0.f;
        float m = -INFINITY, lsum = 0.f;
        f32x4 gcA[8], gpA[2], gcB[8], gpB[2]; const int mypage = pt[sb * NPAGES + sp * (NPAGES / 2) + lane];
#define SA_LOAD(gc, gp, j) do { const size_t pg = (size_t)(unsigned)__builtin_amdgcn_readlane(mypage, (j));     const __amdgpu_buffer_rsrc_t rc_ = __builtin_amdgcn_make_buffer_rsrc((void*)(cckv + pg * (PAGE * KVL)), 0, PAGE * KVL * 4, 0x00020000), rp_ = __builtin_amdgcn_make_buffer_rsrc((void*)(ckpe + pg * (PAGE * ROPE)), 0, PAGE * ROPE * 4, 0x00020000); \
                _Pragma("unroll") for (int i = 0; i < 8; ++i) gc[i] = __builtin_bit_cast(f32x4, __builtin_amdgcn_raw_buffer_load_b128(rc_, tid * 16 + i * 8192, 0, 2));   \
                _Pragma("unroll") for (int i = 0; i < 2; ++i) gp[i] = __builtin_bit_cast(f32x4, __builtin_amdgcn_raw_buffer_load_b128(rp_, tid * 16 + i * 8192, 0, 2)); } while (0)
#define SA_LOADV(gc, gp) do { const float* c0 = F.out + O_SCKV + (size_t)sb * DT * KVL + tid * 4; const float* p0 = F.out + O_SKPE + (size_t)sb * DT * ROPE + tid * 4;     \
                _Pragma("unroll") for (int i = 0; i < 8; ++i) gc[i] = (i == 0 && tid < 256) ? *(const GAS f32x4*)c0 : (f32x4){0.f, 0.f, 0.f, 0.f}; \
                _Pragma("unroll") for (int i = 0; i < 2; ++i) gp[i] = (i == 0 && tid < 64) ? *(const GAS f32x4*)p0 : (f32x4){0.f, 0.f, 0.f, 0.f}; } while (0)
#define SA_STORE(gc, gp, bufi) do { LAS unsigned char* tb = L + (bufi) * TILE; \
            _Pragma("unroll") for (int i = 0; i < 8; ++i) { const int c = tid + 512 * i; u32x2 v; v.x = pk2(gc[i].x, gc[i].y); v.y = pk2(gc[i].z, gc[i].w); *(LAS u32x2*)(tb + (c >> 5) * STR + (c & 31) * 8) = v; } \
            _Pragma("unroll") for (int i = 0; i < 2; ++i) { const int c = tid + 512 * i; u32x2 v; v.x = pk2(gp[i].x, gp[i].y); v.y = pk2(gp[i].z, gp[i].w); *(LAS u32x2*)(tb + (c >> 3) * STR + 256 + (c & 7) * 8) = v; } } while (0)
#define SA_COMPUTE(newk, bufi) do { \
            if (!newk || kg == 0) { \
                const LAS unsigned char* tb = L + (bufi) * TILE + (32 * kg) * STR; \
                f32x16 p; \
                _Pragma("unroll") for (int i = 0; i < 16; ++i) p[i] = 0.f; \
                _Pragma("unroll") for (int ks = 0; ks < 10; ++ks) { const bf16x8 a = *(const LAS bf16x8*)(tb + r32 * STR + ks * 32 + hi * 16), qk = *(const LAS bf16x8*)(qlp + ks * 32); p = __builtin_amdgcn_mfma_f32_32x32x16_bf16(a, qk, p, 0, 0, 0); } \
                if (newk) { const int tq = r32 & 7;                   \
                    _Pragma("unroll") for (int i = 0; i < 16; ++i) { const int kk = 4 * hi + 8 * (i >> 2) + (i & 3); if (kk > tq) p[i] = -INFINITY; } } \
                float mx = p[0]; \
                _Pragma("unroll") for (int i = 1; i < 16; ++i) mx = fmaxf(mx, p[i]); \
                mx = fmaxf(mx, __shfl_xor(mx, 32)); \
                const float mn = fmaxf(m, mx), alpha = __builtin_amdgcn_exp2f(m - mn); m = mn; float ps = 0.f; \
                _Pragma("unroll") for (int i = 0; i < 16; ++i) { p[i] = __builtin_amdgcn_exp2f(p[i] - mn); ps += p[i]; } \
                lsum = lsum * alpha + ps; \
                _Pragma("unroll") for (int lb = 0; lb < 4; ++lb) _Pragma("unroll") for (int i = 0; i < 16; ++i) o[lb][i] *= alpha; \
                v4u pf[2]; \
                pf[0] = (v4u){pk2(p[0], p[1]), pk2(p[2], p[3]), pk2(p[4], p[5]), pk2(p[6], p[7])}; pf[1] = (v4u){pk2(p[8], p[9]), pk2(p[10], p[11]), pk2(p[12], p[13]), pk2(p[14], p[15])}; \
                const LAS unsigned char* vl = tb + (4 * hi + ((lane & 15) >> 2)) * STR + (16 * ((lane >> 4) & 1) + 4 * (lane & 3)) * 2; \
                _Pragma("unroll") for (int st = 0; st < 2; ++st) _Pragma("unroll") for (int lb = 0; lb < 4; ++lb) { const s16x4 lo = vtr(vl + (16 * st) * STR + lb * 64), hh = vtr(vl + (16 * st + 8) * STR + lb * 64); \
                        const bf16x8 af = (bf16x8){lo[0], lo[1], lo[2], lo[3], hh[0], hh[1], hh[2], hh[3]}; \
                        o[lb] = __builtin_amdgcn_mfma_f32_32x32x16_bf16(af, __builtin_bit_cast(bf16x8, pf[st]), o[lb], 0, 0, 0); } \
            } } while (0)
#define SA_BAR() asm volatile("s_waitcnt lgkmcnt(0)\n\ts_barrier" ::: "memory")
        SA_LOAD(gcB, gpB, 0); SA_STORE(gcB, gpB, 0); asm volatile("" ::: "memory");
        SA_LOAD(gcA, gpA, 1);
        SA_LOAD(gcB, gpB, 2);
        SA_BAR();
#define SA_PAIR(jj, LA, LB) do { \
            SA_COMPUTE(false, 0); \
            SA_STORE(gcA, gpA, 1); asm volatile("" ::: "memory"); \
            if (LA) SA_LOAD(gcA, gpA, (jj) + 3); \
            SA_BAR(); \
            SA_COMPUTE(false, 1); \
            if ((jj) + 2 < NPAGES / 2) { SA_STORE(gcB, gpB, 0); asm volatile("" ::: "memory"); if (LB) SA_LOAD(gcB, gpB, (jj) + 4); } \
            SA_BAR(); } while (0)
#pragma unroll 1
        for (int jj = 0; jj < NPAGES / 2 - 4; jj += 2) SA_PAIR(jj, true, true);
        SA_PAIR(NPAGES / 2 - 4, true, false);
        SA_PAIR(NPAGES / 2 - 2, false, false);
#undef SA_PAIR
        if (sp) {
            SA_LOADV(gcB, gpB); SA_STORE(gcB, gpB, 0); SA_BAR();
            SA_COMPUTE(true, 0);
            SA_BAR();
        }
#undef SA_LOADV
#undef SA_LOAD
#undef SA_STORE
#undef SA_COMPUTE
#undef SA_BAR
        lsum += __shfl_xor(lsum, 32);
        LAS float* PO = (LAS float*)L; LAS float* ML = (LAS float*)(L + OFF_ML);
#pragma unroll
        for (int lb = 0; lb < 4; ++lb)
#pragma unroll
            for (int i = 0; i < 16; ++i) PO[w * 4096 + (lb * 16 + i) * 64 + lane] = o[lb][i];
        if (hi == 0) { ML[w * 64 + r32] = m; ML[w * 64 + 32 + r32] = lsum; }
        __syncthreads();
        { const int q2 = w & 1, jb = (w >> 1) * 16; float mk[4], fk[4], Mx = -INFINITY, Ls = 0.f;
#pragma unroll
          for (int g = 0; g < 4; ++g) { mk[g] = ML[(2 * g + q2) * 64 + r32]; Mx = fmaxf(Mx, mk[g]); }
#pragma unroll
          for (int g = 0; g < 4; ++g) { fk[g] = mk[g] == -INFINITY ? 0.f : __builtin_amdgcn_exp2f(mk[g] - Mx); Ls += fk[g] * ML[(2 * g + q2) * 64 + 32 + r32]; }
          float* dst = SP + ((size_t)unit * 64 + 32 * q2 + r32) * PSTR;
#pragma unroll
          for (int j4 = 0; j4 < 4; ++j4) { f32x4 av;
#pragma unroll
              for (int e = 0; e < 4; ++e) { const int j = jb + 4 * j4 + e; float a = 0.f;
#pragma unroll
                  for (int g = 0; g < 4; ++g) a += fk[g] * PO[(2 * g + q2) * 4096 + j * 64 + lane];
                  av[e] = a; }
              *(GAS f32x4*)(dst + 32 * (jb >> 4) + 8 * j4 + 4 * hi) = av; }
          if (jb == 0 && hi == 0) { dst[128] = Mx; dst[129] = Ls; } }
        __syncthreads();
    }
}
__device__ __forceinline__ void combine_phase(Frame& F) {
    const int lane = lane_now(), tid = F.wave * 64 + lane; const float* SP = (const float*)(F.ws + WS_SPART); LAS float* OL = (LAS float*)F.lds;
    for (int u = blockIdx.x; u < DB * 2; u += F.G) { const int sb = u >> 1, hl = tid >> 4, hq = (u & 1) * 32 + hl;
        { const int rg = tid & 15; const float* a = SP + ((size_t)(2 * sb) * 64 + hq) * PSTR; const float* b = a + 64 * PSTR;
          const float ma = a[128], mb = b[128], Mx = fmaxf(ma, mb), fa = __builtin_amdgcn_exp2f(ma - Mx), fb = __builtin_amdgcn_exp2f(mb - Mx), il = 1.f / (fa * a[129] + fb * b[129]);
          const f32x4 a0 = *(const GAS f32x4*)(a + rg * 8), a1 = *(const GAS f32x4*)(a + rg * 8 + 4), b0 = *(const GAS f32x4*)(b + rg * 8), b1 = *(const GAS f32x4*)(b + rg * 8 + 4);
#pragma unroll
          for (int e = 0; e < 4; ++e) { OL[hl * 129 + rg * 8 + e] = (fa * a0[e] + fb * b0[e]) * il; OL[hl * 129 + rg * 8 + 4 + e] = (fa * a1[e] + fb * b1[e]) * il; } }
        __syncthreads();
        { const int vg = tid & 15, h = hq >> 3, t = hq & 7; const float* wv = F.a->in[I_WUV] + h * 64 + vg * 4; float acc[4] = {0.f, 0.f, 0.f, 0.f};
#pragma unroll 8
          for (int r = 0; r < 128; ++r) { const float ov = OL[hl * 129 + r]; const f32x4 w0 = *(const GAS f32x4*)(wv + (size_t)r * 512);
              acc[0] += ov * w0.x; acc[1] += ov * w0.y; acc[2] += ov * w0.z; acc[3] += ov * w0.w; }
          u32x2 o; o.x = pk2(acc[0], acc[1]); o.y = pk2(acc[2], acc[3]);
          *(GAS u32x2*)(F.MIX() + (size_t)(MP + sb * DT + t) * 1024 + 512 + h * 64 + vg * 4) = o; }
        __syncthreads();
    }
}
}
namespace gdn {
typedef short s16x4 __attribute__((ext_vector_type(4)));
constexpr int STRB = 144, IMG = 64 * STRB;
constexpr size_t WS_GI = (size_t)2680 * MiB;
constexpr size_t ITEM_B = 5 * 8192;
constexpr size_t WS_GL = WS_GI + (size_t)8192 * ITEM_B;
__device__ __forceinline__ s16x4 vtr(const LAS unsigned char* p) { return __builtin_bit_cast(s16x4, __builtin_amdgcn_ds_read_tr16_b64_v4i16((LAS s16x4*)p)); }
__device__ __forceinline__ void zero4(f32x4 (&a)[4]) {
#pragma unroll
    for (int t = 0; t < 4; ++t) a[t] = (f32x4){0.f, 0.f, 0.f, 0.f}; }
__device__ __forceinline__ void strip_mm(f32x4 (&acc)[4], const LAS unsigned char* A, const LAS unsigned char* Bt, const int r0, const int lane) {
    const int c16 = lane & 15, q4 = lane >> 4; bf16x8 a[2], b[2][4];
#pragma unroll
    for (int ks = 0; ks < 2; ++ks) { a[ks] = *(const LAS bf16x8*)(A + (r0 + c16) * STRB + (32 * ks + 8 * q4) * 2);
#pragma unroll
        for (int tn = 0; tn < 4; ++tn) b[ks][tn] = *(const LAS bf16x8*)(Bt + (16 * tn + c16) * STRB + (32 * ks + 8 * q4) * 2); }
    __builtin_amdgcn_sched_barrier(0);
#pragma unroll
    for (int ks = 0; ks < 2; ++ks)
#pragma unroll
        for (int tn = 0; tn < 4; ++tn) acc[tn] = __builtin_amdgcn_mfma_f32_16x16x32_bf16(a[ks], b[ks][tn], acc[tn], 0, 0, 0);
}
__device__ __forceinline__ void strip_mm_at(f32x4 (&acc)[4], const LAS unsigned char* AT, const LAS unsigned char* Bt, const int r0, const int lane) {
    const int c16 = lane & 15, q4 = lane >> 4; s16x4 lo[2], hh[2]; bf16x8 b[2][4];
    const LAS unsigned char* ap = AT + (8 * q4 + (c16 >> 2)) * STRB + (r0 + 4 * (lane & 3)) * 2;
#pragma unroll
    for (int ks = 0; ks < 2; ++ks) { lo[ks] = vtr(ap + (32 * ks) * STRB); hh[ks] = vtr(ap + (32 * ks + 4) * STRB);
#pragma unroll
        for (int tn = 0; tn < 4; ++tn) b[ks][tn] = *(const LAS bf16x8*)(Bt + (16 * tn + c16) * STRB + (32 * ks + 8 * q4) * 2); }
    __builtin_amdgcn_sched_barrier(0);
#pragma unroll
    for (int ks = 0; ks < 2; ++ks) { const bf16x8 a = (bf16x8){lo[ks][0], lo[ks][1], lo[ks][2], lo[ks][3], hh[ks][0], hh[ks][1], hh[ks][2], hh[ks][3]};
#pragma unroll
        for (int tn = 0; tn < 4; ++tn) acc[tn] = __builtin_amdgcn_mfma_f32_16x16x32_bf16(a, b[ks][tn], acc[tn], 0, 0, 0); }
}
__device__ __forceinline__ void strip_mm_bk(f32x4 (&acc)[4], const LAS unsigned char* A, const LAS unsigned char* Bk, const int r0, const int lane) {
    const int c16 = lane & 15, q4 = lane >> 4; bf16x8 a[2]; s16x4 lo[2][4], hh[2][4];
    const LAS unsigned char* bp = Bk + (8 * q4 + (c16 >> 2)) * STRB + (4 * (lane & 3)) * 2;
#pragma unroll
    for (int ks = 0; ks < 2; ++ks) { a[ks] = *(const LAS bf16x8*)(A + (r0 + c16) * STRB + (32 * ks + 8 * q4) * 2);
#pragma unroll
        for (int tn = 0; tn < 4; ++tn) { lo[ks][tn] = vtr(bp + (32 * ks) * STRB + tn * 32); hh[ks][tn] = vtr(bp + (32 * ks + 4) * STRB + tn * 32); } }
    __builtin_amdgcn_sched_barrier(0);
#pragma unroll
    for (int ks = 0; ks < 2; ++ks)
#pragma unroll
        for (int tn = 0; tn < 4; ++tn) { const bf16x8 b = (bf16x8){lo[ks][tn][0], lo[ks][tn][1], lo[ks][tn][2], lo[ks][tn][3], hh[ks][tn][0], hh[ks][tn][1], hh[ks][tn][2], hh[ks][tn][3]};
            acc[tn] = __builtin_amdgcn_mfma_f32_16x16x32_bf16(a[ks], b, acc[tn], 0, 0, 0); }
}
__host__ __device__ __forceinline__ constexpr int lr_n(int r) { return ((r + 3) >> 2) << 2; }
__host__ __device__ __forceinline__ constexpr int lr_off(int r) { return r == 0 ? 0 : (8 * ((r - 1) >> 2) * (((r - 1) >> 2) + 1) + 4 * ((r - 1) & 3) * (((r - 1) >> 2) + 1)); }
static_assert(lr_off(63) + lr_n(63) == 2112 && lr_off(1) == 0 && lr_off(2) == 4 && lr_off(5) == 16 && lr_off(6) == 24, "packed L layout");

__device__ __forceinline__ void prep_seg(const bf16_t* QK, const float* cw, const size_t rowbase, const int t0, const int h, const int seg, const int lane, float (&o)[8][8]) {
    const int rg = lane >> 3, cg = lane & 7, col = seg * 512 + h * 64 + cg * 8;
    float wt[4][8];
#pragma unroll
    for (int j = 0; j < 4; ++j) { const f32x4 a = *(const GAS f32x4*)(cw + j * CONVD + col), b = *(const GAS f32x4*)(cw + j * CONVD + col + 4); wt[j][0] = a.x; wt[j][1] = a.y; wt[j][2] = a.z; wt[j][3] = a.w; wt[j][4] = b.x; wt[j][5] = b.y; wt[j][6] = b.z; wt[j][7] = b.w; }
#pragma unroll
    for (int r = 0; r < 8; ++r)
#pragma unroll
        for (int e = 0; e < 8; ++e) o[r][e] = 0.f;
#pragma unroll
    for (int rr = 0; rr < 11; ++rr) { const int t = t0 + 8 * rg + rr - 3; float x[8];
        if (t >= 0) unpack8(*(const GAS v4u*)(QK + (rowbase + t) * CONVD + col), x); else {
#pragma unroll
            for (int e = 0; e < 8; ++e) x[e] = 0.f; }
#pragma unroll
        for (int j = 0; j < 4; ++j) { const int r = rr - j;
            if (r >= 0 && r < 8) {
#pragma unroll
                for (int e = 0; e < 8; ++e) o[r][e] += wt[j][e] * x[e]; } } }
#pragma unroll
    for (int r = 0; r < 8; ++r) { float ss = 0.f;
#pragma unroll
        for (int e = 0; e < 8; ++e) { o[r][e] = silu_f(o[r][e]); ss += o[r][e] * o[r][e]; }
        if (seg < 2) { ss += __shfl_xor(ss, 1); ss += __shfl_xor(ss, 2); ss += __shfl_xor(ss, 4); const float sc = rsqrtf(ss + 1e-6f) * (seg == 0 ? 0.125f : 1.f);
#pragma unroll
            for (int e = 0; e < 8; ++e) o[r][e] *= sc; } }
}
__device__ __forceinline__ v4u pk8(const float (&a)[8], const float s) { return (v4u){pk2(a[0] * s, a[1] * s), pk2(a[2] * s, a[3] * s), pk2(a[4] * s, a[5] * s), pk2(a[6] * s, a[7] * s)}; }

template <int K> struct SolveRow {
    static __device__ __forceinline__ void run(float (&X)[64], const float xk, const f32x4 (&l)[lr_n(K) / 4], const LAS unsigned char* SB, const int lane) {
        f32x4 ln[lr_n(K - 1) / 4 + 1];
        int o_ = lr_off(K - 1) * 4; asm volatile("" : "+v"(o_) : "v"(xk));
        constexpr int NA = lr_n(K - 1) / 4 < 9 ? lr_n(K - 1) / 4 : 9;
#pragma unroll
        for (int q = 0; q < NA; ++q) ln[q] = *(const LAS f32x4*)(SB + o_ + 16 * q);
        __builtin_amdgcn_sched_barrier(0);
#pragma unroll
        for (int q = 0; q < lr_n(K) / 4; ++q)
#pragma unroll
            for (int e = 0; e < 4; ++e) if (4 * q + e < K) X[4 * q + e] = __builtin_fmaf(xk, l[q][e], X[4 * q + e]);
        const float xn = (lane == K - 1 ? 1.f : 0.f) - X[K - 1]; X[K - 1] = xn;
        __builtin_amdgcn_sched_barrier(0);
#pragma unroll
        for (int q = NA; q < lr_n(K - 1) / 4; ++q) ln[q] = *(const LAS f32x4*)(SB + o_ + 16 * q);
        __builtin_amdgcn_sched_barrier(0);
        if constexpr (K > 1) { const f32x4 (&lr)[lr_n(K - 1) / 4] = reinterpret_cast<const f32x4 (&)[lr_n(K - 1) / 4]>(ln); SolveRow<K - 1>::run(X, xn, lr, SB, lane); }
    }
};
__device__ __forceinline__ void st8_pair16(unsigned char* p, const u32x2 w, const bool evenrow, const bool sel) {
    const auto rx = __builtin_amdgcn_permlane16_swap(w.x, w.x, false, false); const auto ry = __builtin_amdgcn_permlane16_swap(w.y, w.y, false, false);
    const unsigned nx = sel ? rx[1] : rx[0], ny = sel ? ry[1] : ry[0];
    if (evenrow) *(GAS v4u*)p = (v4u){w.x, w.y, nx, ny};
}
__device__ __forceinline__ void intra_item(Frame& F, const int item, LAS unsigned char* SA, LAS unsigned char* SB, LAS float* GC, LAS float* BT) {
    const int lane = lane_now();
    const int chain = item >> 5, n = item & 31, b = chain >> 3, h = chain & 7, c16 = lane & 15, q4 = lane >> 4, rg = lane >> 3, cg = lane & 7;
    const size_t rowbase = (size_t)b * SEQ; const int t0 = 64 * n;
    const bool evenrow = !(q4 & 1); const bool sel = [&] { const auto t = __builtin_amdgcn_permlane16_swap((unsigned)lane, (unsigned)lane, false, false); return t[1] == (unsigned)(lane ^ 16); }();
    unsigned char* gi = F.ws + WS_GI + (size_t)item * ITEM_B; const bf16_t* QK = F.QKVR(); const float* cw = F.a->in[I_GCW];
    { const size_t row = rowbase + t0 + lane; float g = F.BG()[row * 16 + h]; const float bt = F.BG()[row * 16 + 8 + h];
#pragma unroll
      for (int o = 1; o < 64; o <<= 1) { const float y = __shfl_up(g, o); if (lane >= o) g += y; }
      GC[lane] = g; BT[lane] = bt; if (lane == 63) *(float*)(F.ws + WS_GL + (size_t)item * 4) = g; }
    const float gl = GC[63];
    float o[8][8];
    prep_seg(QK, cw, rowbase, t0, h, 1, lane, o);
#pragma unroll
    for (int r = 0; r < 8; ++r) { const int c = 8 * rg + r; *(LAS v4u*)(SA + c * STRB + cg * 16) = pk8(o[r], 1.f); *(GAS v4u*)(gi + 3 * 8192 + c * 128 + cg * 16) = pk8(o[r], __expf(gl - GC[c])); }
    prep_seg(QK, cw, rowbase, t0, h, 0, lane, o);
#pragma unroll
    for (int r = 0; r < 8; ++r) { const int c = 8 * rg + r; *(LAS v4u*)(SB + c * STRB + cg * 16) = pk8(o[r], 1.f); *(GAS v4u*)(gi + 2 * 8192 + c * 128 + cg * 16) = pk8(o[r], __expf(GC[c])); }
#pragma unroll 1
    for (int st = 0; st < 4; ++st) { f32x4 acc[4]; zero4(acc); strip_mm(acc, SA, SB, 16 * st, lane);
#pragma unroll
        for (int tn = 0; tn < 4; ++tn) { const int c = 16 * tn + c16, s0 = 16 * st + 4 * q4; const float gcc = GC[c]; float v[4];
#pragma unroll
            for (int i = 0; i < 4; ++i) v[i] = (c >= s0 + i) ? acc[tn][i] * __expf(gcc - GC[s0 + i]) : 0.f;
            st8_pair16(gi + 8192 + c * 128 + s0 * 2, (u32x2){pk2(v[0], v[1]), pk2(v[2], v[3])}, evenrow, sel); } }
#pragma unroll 1
    for (int st = 0; st < 4; ++st) { f32x4 acc[4]; zero4(acc); strip_mm(acc, SA, SA, 16 * st, lane);
#pragma unroll
        for (int tn = 0; tn < 4; ++tn) { const int bb = 16 * tn + c16, k0 = 16 * st + 4 * q4; const float gb = GC[bb], btb = BT[bb];
            if (k0 < lr_n(bb)) { f32x4 v;
#pragma unroll
                for (int i = 0; i < 4; ++i) v[i] = (k0 + i < bb) ? btb * acc[tn][i] * __expf(gb - GC[k0 + i]) : 0.f;
                *(LAS f32x4*)(SB + (lr_off(bb) + k0) * 4) = v; } } }
    float X[64];
#pragma unroll
    for (int k = 0; k < 64; ++k) X[k] = 0.f;
    { f32x4 l63[16];
#pragma unroll
      for (int q = 0; q < 16; ++q) l63[q] = *(const LAS f32x4*)(SB + (lr_off(63) + 4 * q) * 4);
      const float x63 = lane == 63 ? 1.f : 0.f; SolveRow<63>::run(X, x63, l63, SB, lane); X[63] = x63; }
#pragma unroll
    for (int c8 = 0; c8 < 8; ++c8) { float ww[8]; __builtin_amdgcn_sched_barrier(0);
#pragma unroll
        for (int e = 0; e < 8; ++e) { const int s = c8 * 8 + e; ww[e] = X[s] * BT[s] * __expf(GC[s]); }
        *(LAS v4u*)(SB + lane * STRB + c8 * 16) = pk8(ww, 1.f); }
#pragma unroll 1
    for (int st = 0; st < 4; ++st) { f32x4 acc[4]; zero4(acc); strip_mm_at(acc, SA, SB, 16 * st, lane);
#pragma unroll
        for (int tn = 0; tn < 4; ++tn) { const int c = 16 * tn + c16, d0 = 16 * st + 4 * q4; st8_pair16(gi + c * 128 + d0 * 2, (u32x2){pk2(-acc[tn][0], -acc[tn][1]), pk2(-acc[tn][2], -acc[tn][3])}, evenrow, sel); } }
    prep_seg(QK, cw, rowbase, t0, h, 2, lane, o);
#pragma unroll
    for (int r = 0; r < 8; ++r) *(LAS v4u*)(SA + (8 * rg + r) * STRB + cg * 16) = pk8(o[r], 1.f);
#pragma unroll
    for (int c8 = 0; c8 < 8; ++c8) { float uu[8]; __builtin_amdgcn_sched_barrier(0);
#pragma unroll
        for (int e = 0; e < 8; ++e) { const int s = c8 * 8 + e; uu[e] = X[s] * BT[s]; }
        *(LAS v4u*)(SB + lane * STRB + c8 * 16) = pk8(uu, 1.f); }
#pragma unroll 1
    for (int st = 0; st < 4; ++st) { f32x4 acc[4]; zero4(acc); strip_mm_bk(acc, SB, SA, 16 * st, lane);
#pragma unroll
        for (int tn = 0; tn < 4; ++tn) { const int v = 16 * tn + c16, c0 = 16 * st + 4 * q4; st8_pair16(gi + 4 * 8192 + (v * 64 + c0) * 2, (u32x2){pk2(acc[tn][0], acc[tn][1]), pk2(acc[tn][2], acc[tn][3])}, evenrow, sel); } }
}
__device__ __forceinline__ void sample_chain(Frame& F, const int c2, const int lane) {
    const int sb = c2 >> 3, h = c2 & 7; const size_t row0 = MP + (size_t)sb * DT; const float* S0 = F.a->in[I_SGDN] + (size_t)c2 * 4096; const float* hist = F.a->in[I_SGC] + (size_t)sb * 3 * CONVD; const float* cw = F.a->in[I_GCW];
    float S[64];
#pragma unroll
    for (int d = 0; d < 64; ++d) S[d] = S0[d * 64 + lane];
    float wq[4], wk[4], wv[4];
#pragma unroll
    for (int j = 0; j < 4; ++j) { wq[j] = cw[j * CONVD + h * 64 + lane]; wk[j] = cw[j * CONVD + 512 + h * 64 + lane]; wv[j] = cw[j * CONVD + 1024 + h * 64 + lane]; }
    const float gw = F.a->in[I_GNW][lane];
    for (int t = 0; t < DT; ++t) { const size_t row = row0 + t; float aq = 0.f, ak = 0.f, av = 0.f;
#pragma unroll
        for (int j = 0; j < 4; ++j) { const int tt = t - 3 + j; float xq, xk, xv;
            if (tt >= 0) { const bf16_t* p = F.QKVR() + (row0 + tt) * CONVD + h * 64 + lane; xq = bf2f(p[0]); xk = bf2f(p[512]); xv = bf2f(p[1024]); }
            else { const float* p = hist + (tt + 3) * CONVD + h * 64 + lane; xq = p[0]; xk = p[512]; xv = p[1024]; }
            aq += wq[j] * xq; ak += wk[j] * xk; av += wv[j] * xv; }
        aq = silu_f(aq); ak = silu_f(ak); av = silu_f(av);
        const float qd = aq * rsqrtf(wave_sum(aq * aq) + 1e-6f) * 0.125f, kd = ak * rsqrtf(wave_sum(ak * ak) + 1e-6f);
        const float g = F.BG()[row * 16 + h], beta = F.BG()[row * 16 + 8 + h], eg = __expf(g);
        float ks = 0.f;
#pragma unroll
        for (int d = 0; d < 64; ++d) ks += __builtin_bit_cast(float, __builtin_amdgcn_readlane(__builtin_bit_cast(int, kd), d)) * S[d];
        const float vn = beta * (av - eg * ks); float o = 0.f;
#pragma unroll
        for (int d = 0; d < 64; ++d) { S[d] = eg * S[d] + __builtin_bit_cast(float, __builtin_amdgcn_readlane(__builtin_bit_cast(int, kd), d)) * vn; o += __builtin_bit_cast(float, __builtin_amdgcn_readlane(__builtin_bit_cast(int, qd), d)) * S[d]; }
        const float on = o * rsqrtf(wave_sum(o * o) * (1.f / 64.f) + RMS_EPS) * gw; const float zz = bf2f(F.Z()[row * 512 + h * 64 + lane]);
        F.MIX()[row * 1024 + h * 64 + lane] = f2bf(on * silu_f(zz)); }
    float* so = F.out + O_SGDN + (size_t)c2 * 4096;
#pragma unroll
    for (int d = 0; d < 64; ++d) so[d * 64 + lane] = S[d];
}
__device__ __forceinline__ void intra_phase(Frame& F) {
    LAS unsigned char* base = F.lds + F.wave * (2 * IMG + 512);
    LAS float* GC = (LAS float*)(base + 2 * IMG); LAS float* BT = GC + 64;
#pragma unroll 1
    for (int item = F.gw; item < BATCH * H * (SEQ / 64); item += F.NGW) intra_item(F, item, base, base + IMG, GC, BT);
    for (int i = F.wave; i * F.G + (int)blockIdx.x < DB * H; i += NWAVES) sample_chain(F, i * F.G + (int)blockIdx.x, lane_now());
    __syncthreads();
}
static_assert(NWAVES * (2 * IMG + 512) <= MISC_OFF, "per-wave LDS arenas");

constexpr int C_WN = 0, C_AM = IMG, C_QG = 2 * IMG, C_KG = 3 * IMG, C_UT = 4 * IMG, C_SET = 5 * IMG;
constexpr int C_S0 = 2 * C_SET, C_S1 = C_S0 + IMG, C_VN = C_S1 + IMG, C_O = C_VN + IMG, C_END = C_O + IMG;
static_assert(C_END + 128 <= MISC_OFF, "scan LDS map");
__device__ __forceinline__ void scan_chain(Frame& F, const int chain) {
    const int lane = lane_now(), w = F.wave, tid = w * 64 + lane, c16 = lane & 15, q4 = lane >> 4, r0 = 16 * (w & 3);
    const int b = chain >> 3, h = chain & 7; const size_t rowbase = (size_t)b * SEQ; LAS unsigned char* L = F.lds;
    const unsigned char* gi0 = F.ws + WS_GI + (size_t)chain * 32 * ITEM_B; const float* GL = (const float*)(F.ws + WS_GL) + chain * 32;
    const int pr = tid >> 3, pc = tid & 7;
    for (int i = tid; i < IMG / 4; i += 512) ((LAS unsigned*)(L + C_S0))[i] = 0u;
    LAS float* EGL = (LAS float*)(L + C_END); if (tid < 32) EGL[tid] = __expf(GL[tid]);
    v4u g4a[5], g4b[5];
#define GS_LOAD(g4, n) do { const unsigned char* gp_ = gi0 + (size_t)(n) * ITEM_B + pr * 128 + pc * 16; _Pragma("unroll") for (int q = 0; q < 5; ++q) g4[q] = *(const GAS v4u*)(gp_ + q * 8192); } while (0)
#define GS_STORE(g4, set) do { LAS unsigned char* lp_ = L + (set) * C_SET + pr * STRB + pc * 16; _Pragma("unroll") for (int q = 0; q < 5; ++q) *(LAS v4u*)(lp_ + q * IMG) = g4[q]; } while (0)
    GS_LOAD(g4a, 0); GS_STORE(g4a, 0); GS_LOAD(g4a, 1);
    f32x4 Sacc[4]; zero4(Sacc);
    const float gw0 = F.a->in[I_GNW][pc * 8 + 0], gw1 = F.a->in[I_GNW][pc * 8 + 1], gw2 = F.a->in[I_GNW][pc * 8 + 2], gw3 = F.a->in[I_GNW][pc * 8 + 3], gw4 = F.a->in[I_GNW][pc * 8 + 4], gw5 = F.a->in[I_GNW][pc * 8 + 5], gw6 = F.a->in[I_GNW][pc * 8 + 6], gw7 = F.a->in[I_GNW][pc * 8 + 7];
    __syncthreads();
#define SCAN_ITER(n, LD4, ST4, ZC, ZN) do { \
        const LAS unsigned char* I = L + (n & 1) * C_SET; const LAS unsigned char* Sold = L + ((n & 1) ? C_S1 : C_S0); LAS unsigned char* Snew = L + ((n & 1) ? C_S0 : C_S1); \
        if (n + 1 < 32) ZN = *(const GAS v4u*)(F.Z() + (rowbase + 64 * (n + 1) + pr) * 512 + h * 64 + pc * 8);     \
        if (n + 2 < 32) GS_LOAD(LD4, n + 2); \
        f32x4 R[4]; \
        if (w < 4) { const LAS unsigned char* ut = I + C_UT + (r0 + 4 * q4) * 2; \
        _Pragma("unroll") \
            for (int tn = 0; tn < 4; ++tn) { const u32x2 ur = *(const LAS u32x2*)(ut + (16 * tn + c16) * STRB); R[tn] = (f32x4){__builtin_bit_cast(float, ur.x << 16), __builtin_bit_cast(float, ur.x & 0xffff0000u), __builtin_bit_cast(float, ur.y << 16), __builtin_bit_cast(float, ur.y & 0xffff0000u)}; } \
            strip_mm(R, I + C_WN, Sold, r0, lane); \
        _Pragma("unroll") \
            for (int tn = 0; tn < 4; ++tn) *(LAS u32x2*)(L + C_VN + (16 * tn + c16) * STRB + (r0 + 4 * q4) * 2) = (u32x2){pk2(R[tn][0], R[tn][1]), pk2(R[tn][2], R[tn][3])}; } \
        else { zero4(R); strip_mm(R, I + C_QG, Sold, r0, lane); } \
        asm volatile("s_waitcnt lgkmcnt(0)\n\ts_barrier" ::: "memory");     \
        if (w < 4) { const float egl = EGL[n]; \
        _Pragma("unroll") \
            for (int tn = 0; tn < 4; ++tn) Sacc[tn] = Sacc[tn] * egl; \
            strip_mm_at(Sacc, I + C_KG, L + C_VN, r0, lane); \
        _Pragma("unroll") \
            for (int tn = 0; tn < 4; ++tn) *(LAS u32x2*)(Snew + (16 * tn + c16) * STRB + (r0 + 4 * q4) * 2) = (u32x2){pk2(Sacc[tn][0], Sacc[tn][1]), pk2(Sacc[tn][2], Sacc[tn][3])}; } \
        else { strip_mm(R, I + C_AM, L + C_VN, r0, lane); \
        _Pragma("unroll") \
            for (int i = 0; i < 4; ++i) { float ss = R[0][i] * R[0][i] + R[1][i] * R[1][i] + R[2][i] * R[2][i] + R[3][i] * R[3][i]; \
                ss += __shfl_xor(ss, 1); ss += __shfl_xor(ss, 2); ss += __shfl_xor(ss, 4); ss += __shfl_xor(ss, 8); \
                const float rs = rsqrtf(ss * (1.f / 64.f) + RMS_EPS); \
        _Pragma("unroll") \
                for (int tn = 0; tn < 4; ++tn) *(LAS bf16_t*)(L + C_O + (r0 + 4 * q4 + i) * STRB + (16 * tn + c16) * 2) = (bf16_t)(pk2(R[tn][i] * rs, 0.f) & 0xffffu); } } \
        if (n + 1 < 32) GS_STORE(ST4, (n + 1) & 1); \
        asm volatile("s_waitcnt lgkmcnt(0)\n\ts_barrier" ::: "memory");     \
        { float on[8], zz[8]; unpack8(*(const LAS v4u*)(L + C_O + pr * STRB + pc * 16), on); unpack8(ZC, zz); \
          v4u ov; ov.x = pk2(on[0] * gw0 * silu_f(zz[0]), on[1] * gw1 * silu_f(zz[1])); ov.y = pk2(on[2] * gw2 * silu_f(zz[2]), on[3] * gw3 * silu_f(zz[3])); \
          ov.z = pk2(on[4] * gw4 * silu_f(zz[4]), on[5] * gw5 * silu_f(zz[5])); ov.w = pk2(on[6] * gw6 * silu_f(zz[6]), on[7] * gw7 * silu_f(zz[7])); \
          *(GAS v4u*)(F.MIX() + (rowbase + 64 * n + pr) * 1024 + h * 64 + pc * 8) = ov; } \
    } while (0)
    v4u zA = *(const GAS v4u*)(F.Z() + (rowbase + pr) * 512 + h * 64 + pc * 8), zB = zA;
    for (int n2 = 0; n2 < 32; n2 += 2) { SCAN_ITER((n2), g4b, g4a, zA, zB); SCAN_ITER((n2 + 1), g4a, g4b, zB, zA); }
#undef SCAN_ITER
#undef GS_LOAD
#undef GS_STORE
    if (w < 4) { float* so = F.out + O_PGDN + (size_t)chain * 4096;
#pragma unroll
        for (int tn = 0; tn < 4; ++tn)
#pragma unroll
            for (int i = 0; i < 4; ++i) so[(r0 + 4 * q4 + i) * 64 + 16 * tn + c16] = Sacc[tn][i]; }
    __syncthreads();
}
__device__ __forceinline__ void scan_phase(Frame& F) { for (int chain = blockIdx.x; chain < BATCH * H; chain += F.G) scan_chain(F, chain); }
}
namespace smallg {
constexpr int STRB = 144, IMG = 64 * STRB;
template <class Epi> __device__ __forceinline__ void run(Frame& F, const bf16_t* A, const bf16_t* Bt, const int K, const int N, const Epi& E) {
    const int lane = lane_now(), w = F.wave, tid = w * 64 + lane, c16 = lane & 15, q4 = lane >> 4, r0 = 16 * (w & 3), n0w = 32 * (w >> 2), pr = tid >> 3, pc = tid & 7;
    LAS unsigned char* L = F.lds;
    const int nct = N / 64;
    for (int t = blockIdx.x; t < (MS / 64) * nct; t += F.G) { const int row0 = MP + (t / nct) * 64, col0 = (t % nct) * 64;
        const bf16_t* ap = A + (size_t)(row0 + pr) * K + pc * 8; const bf16_t* bp = Bt + (size_t)(col0 + pr) * K + pc * 8;
        f32x4 acc[2] = {(f32x4){0.f, 0.f, 0.f, 0.f}, (f32x4){0.f, 0.f, 0.f, 0.f}};
        const int nk = K / 64;
#define SG_LD(ga_, gb_, kk) do { const int c_ = (kk) < nk ? (kk) : nk - 1; ga_ = *(const GAS v4u*)(ap + c_ * 64); gb_ = *(const GAS v4u*)(bp + c_ * 64); } while (0)
#define SG_ST(ga_, gb_, bufi) do { LAS unsigned char* d_ = L + (bufi) * 2 * IMG + pr * STRB + pc * 16; *(LAS v4u*)d_ = ga_; *(LAS v4u*)(d_ + IMG) = gb_; } while (0)
#define SG_MM(bufi) do { const LAS unsigned char* Ai = L + (bufi) * 2 * IMG; const LAS unsigned char* Bi = Ai + IMG; bf16x8 a[2], b[2][2]; \
            _Pragma("unroll") for (int ks = 0; ks < 2; ++ks) { a[ks] = *(const LAS bf16x8*)(Ai + (r0 + c16) * STRB + (32 * ks + 8 * q4) * 2); \
                _Pragma("unroll") for (int tn = 0; tn < 2; ++tn) b[ks][tn] = *(const LAS bf16x8*)(Bi + (n0w + 16 * tn + c16) * STRB + (32 * ks + 8 * q4) * 2); } \
            __builtin_amdgcn_sched_barrier(0); \
            _Pragma("unroll") for (int ks = 0; ks < 2; ++ks) _Pragma("unroll") for (int tn = 0; tn < 2; ++tn) acc[tn] = __builtin_amdgcn_mfma_f32_16x16x32_bf16(a[ks], b[ks][tn], acc[tn], 0, 0, 0); } while (0)
#define SG_BAR() asm volatile("s_waitcnt lgkmcnt(0)\n\ts_barrier" ::: "memory")
        v4u ga0, gb0, ga1, gb1;
        SG_LD(ga0, gb0, 0); SG_LD(ga1, gb1, 1);
        SG_ST(ga0, gb0, 0); asm volatile("" ::: "memory");
        SG_LD(ga0, gb0, 2);
        SG_BAR();
#pragma unroll 1
        for (int kc = 0; kc < nk; kc += 2) {
            SG_MM(0); SG_ST(ga1, gb1, 1); asm volatile("" ::: "memory"); SG_LD(ga1, gb1, kc + 3); SG_BAR();
            SG_MM(1); SG_ST(ga0, gb0, 0); asm volatile("" ::: "memory"); SG_LD(ga0, gb0, kc + 4); SG_BAR();
        }
#undef SG_LD
#undef SG_ST
#undef SG_MM
#undef SG_BAR
        __syncthreads();
        LAS float* T = (LAS float*)(L + 4 * IMG);
#pragma unroll
        for (int tn = 0; tn < 2; ++tn)
#pragma unroll
            for (int i = 0; i < 4; ++i) T[(r0 + 4 * q4 + i) * 68 + n0w + 16 * tn + c16] = acc[tn][i];
        __syncthreads();
        { float v[8]; const f32x4 a = *(const LAS f32x4*)(T + pr * 68 + pc * 8), b = *(const LAS f32x4*)(T + pr * 68 + pc * 8 + 4); v[0] = a[0]; v[1] = a[1]; v[2] = a[2]; v[3] = a[3]; v[4] = b[0]; v[5] = b[1]; v[6] = b[2]; v[7] = b[3];
          float s1, s2; E.vec(row0 + pr, col0 + pc * 8, v, s1, s2);
          if constexpr (Epi::STATS) { s1 += __shfl_xor(s1, 1); s1 += __shfl_xor(s1, 2); s1 += __shfl_xor(s1, 4); s2 += __shfl_xor(s2, 1); s2 += __shfl_xor(s2, 2); s2 += __shfl_xor(s2, 4); if (pc == 0) E.stat(row0 + pr, s1, s2); } }
        __syncthreads();
    }
}
__device__ __forceinline__ v4u pk8v(const float (&r)[8]) { return (v4u){pk2(r[0], r[1]), pk2(r[2], r[3]), pk2(r[4], r[5]), pk2(r[6], r[7])}; }
struct EWout { static constexpr bool STATS = true; bf16_t* O; const float* xs; float* ST;
    __device__ __forceinline__ void vec(int row, int col, const float (&v)[8], float& s1, float& s2) const { const float* x = xs + (size_t)(row - MP) * D + col; const f32x4 x0 = *(const GAS f32x4*)x, x1 = *(const GAS f32x4*)(x + 4);
        float r[8]; s1 = 0.f; s2 = 0.f;
#pragma unroll
        for (int e = 0; e < 8; ++e) { r[e] = v[e] + ALPHA * (e < 4 ? x0[e] : x1[e - 4]); s1 += r[e]; s2 += r[e] * r[e]; }
        *(GAS v4u*)(O + (size_t)row * D + col) = pk8v(r); }
    __device__ __forceinline__ void stat(int row, float s1, float s2) const { unsafeAtomicAdd(ST + 2 * row, s1); unsafeAtomicAdd(ST + 2 * row + 1, s2); } };
struct EDown { static constexpr bool STATS = false; bf16_t* O; const bf16_t* R; const float* ST; const float* g1; const float* b1;
    __device__ __forceinline__ void vec(int row, int col, const float (&v)[8], float& s1, float& s2) const { float mu, rstd; ln1_stats(ST, row, mu, rstd); float x[8]; unpack8(*(const GAS v4u*)(R + (size_t)row * D + col), x);
        const f32x4 ga = *(const GAS f32x4*)(g1 + col), gb = *(const GAS f32x4*)(g1 + col + 4), ba = *(const GAS f32x4*)(b1 + col), bb = *(const GAS f32x4*)(b1 + col + 4); float r[8];
#pragma unroll
        for (int e = 0; e < 8; ++e) r[e] = v[e] + ALPHA * ((x[e] - mu) * rstd * (e < 4 ? ga[e] : gb[e - 4]) + (e < 4 ? ba[e] : bb[e - 4]));
        *(GAS v4u*)(O + (size_t)row * D + col) = pk8v(r); s1 = 0.f; s2 = 0.f; } };
struct E1 { static constexpr bool STATS = false; bf16_t* QKVR; bf16_t* Z; bf16_t* SMB; float* out;
    __device__ __forceinline__ void vec(int row, int col, const float (&v)[8], float& s1, float& s2) const { s1 = 0.f; s2 = 0.f; const v4u w = pk8v(v);
        if (col < 1536) { *(GAS v4u*)(QKVR + (size_t)row * 1536 + col) = w; const int r = row - MP, sb = r / DT, t = r % DT;
            if (t >= DT - 3) { float* o = out + O_SGC + ((size_t)sb * 3 + (t - (DT - 3))) * CONVD + col; *(GAS f32x4*)o = (f32x4){v[0], v[1], v[2], v[3]}; *(GAS f32x4*)(o + 4) = (f32x4){v[4], v[5], v[6], v[7]}; } }
        else if (col < 2048) *(GAS v4u*)(Z + (size_t)row * 512 + col - 1536) = w;
        else *(GAS v4u*)(SMB + (size_t)row * 512 + col - 2048) = w; } };
}
#define MIXER_PHASES if (IN(4)) { { const int bid_ = (int)blockIdx.x; if ((F.G & 15) == 0) { if ((bid_ >> 3) & 1) sattn::phase(F, (bid_ >> 4) * 8 + (bid_ & 7), F.G >> 1); } else sattn::phase(F, bid_, F.G); }     pattn::phase(F); } if (IN(5)) { gdn::intra_phase(F); SEAM(5); } if (IN(6)) { sattn::combine_phase(F);     gdn::scan_phase(F); SEAM(6); }
__global__ void __launch_bounds__(NWAVES * 64, 2) fwd(Args args) {
    extern __shared__ __attribute__((aligned(16))) unsigned char lds[];
    Frame F;
    F.lds = (LAS unsigned char*)lds; F.MISC = (volatile LAS unsigned*)(F.lds + MISC_OFF);
    F.wave = __builtin_amdgcn_readfirstlane((int)threadIdx.x >> 6); F.G = gridDim.x;
    F.gw = blockIdx.x * NWAVES + F.wave; F.NGW = F.G * NWAVES;
    unsigned char* w = args.ws; F.ws = w; F.ctl = (gu32*)(w + WS_CTL); F.out = args.out; F.a = &args;
    for (int u = F.wave * 64 + lane_now(); u < (LDS_BYTES - MISC_OFF) / 4; u += NWAVES * 64) ((LAS unsigned*)(F.lds + MISC_OFF))[u] = 0u;
    __syncthreads();
    const int lo = args.ph_lo, hi = args.ph_hi;
    const bool multi = (hi - lo) > 1;
    XcdBarrier bar; bar.bar = (unsigned*)(F.ctl + CW_BAR); bar.x = 0; bar.st = nullptr; bar.lead = 0;
    if (multi) bar = xcd_barrier_post((unsigned*)(F.ctl + CW_BAR), F.MISC + 8, F.wave == 0 ? 1u : 0u);
#define IN(k) (lo <= (k) && (k) < hi)
#define SEAM(k) do { if (IN(k) && IN((k) + 1)) xcd_barrier(bar); } while (0)
    if (IN(0)) { p0_prologue(F); SEAM(0); }
    if (IN(1)) { pg8::Gemm g{F.XB(), F.W1T(), MP, N1, 1024}; pg8::StaticOrder S; S.init(MP, N1, F.G, (int)blockIdx.x); Epi1 E{F.QKVR(), F.Z(), F.out, (LAS float*)(F.lds + RING_BYTES), F.CQN(), F.CN(), F.KPE(), F.BG(), F.a->in[I_KVNW], F.a->in[I_ALOG], F.a->in[I_DTB], F.RT()};
        pg8::gemm_phase<Epi1, pg8::StaticOrder, true, true>(F.lds, g, S, E, F.wave);
        smallg::run(F, F.XB(), F.W1T(), 1024, N1, smallg::E1{F.QKVR(), F.Z(), (bf16_t*)F.SM(), F.out}); SEAM(1); }
    if (IN(2)) { p_tok(F); SEAM(2); }
    if (IN(3)) { { pg8::Gemm g{F.CQN(), F.WUQT(), M, NQ, 256}; pg8::StaticOrder S; S.init(M, NQ, F.G, (int)blockIdx.x); EpiQ E{F.QP(), F.RT()};
          pg8::gemm_phase<EpiQ, pg8::StaticOrder, true, true>(F.lds, g, S, E, F.wave); }
        { pg8::Gemm g{F.CN(), F.WUKVT(), MP, 1024, 256}; pg8::StaticOrder S; S.init(MP, 1024, F.G, (int)blockIdx.x); EpiB16 E{F.KNV(), 1024, 0};
          pg8::gemm_phase<EpiB16, pg8::StaticOrder, true, true>(F.lds, g, S, E, F.wave); }
        SEAM(3); }
    MIXER_PHASES
    if (IN(8)) { pg8::Gemm g{F.MIX(), F.WOUTT(), MP, D, 1024}; pg8::StaticOrder S; S.init(MP, D, F.G, (int)blockIdx.x); EpiPre1 E{(bf16_t*)F.PRE1(), F.XB(), (float*)(F.ws + WS_ST1)};
        pg8::gemm_phase<EpiPre1, pg8::StaticOrder, true, true>(F.lds, g, S, E, F.wave);
        smallg::run(F, F.MIX(), F.WOUTT(), 1024, D, smallg::EWout{(bf16_t*)F.PRE1(), F.a->in[I_XS], (float*)(F.ws + WS_ST1)}); SEAM(8); }
    if (IN(10)) { pg8::Gemm g{(const bf16_t*)F.PRE1(), F.WUPT(), M, FF2, 1024}; pg8::StaticOrder S; S.init(M, FF2, F.G, (int)blockIdx.x); EpiUpCG E{F.U(), F.HB(), (float*)(F.ws + WS_RAWB), (float*)(F.ws + WS_PARTB), F.a->in[I_FCW], F.out, (const float*)(F.ws + WS_GBUP), (const float*)(F.ws + WS_ST1)};
        pg8::gemm_phase<EpiUpCG, pg8::StaticOrder, true, true>(F.lds, g, S, E, F.wave); SEAM(10); }
    if (IN(11)) { p_cg(F); SEAM(11); }
    if (IN(12)) { pg8::Gemm g{F.HB(), F.WDNT(), MP, D, FF}; pg8::StaticOrder S; S.init(MP, D, F.G, (int)blockIdx.x); EpiPre2 E{F.X1B(), (const bf16_t*)F.PRE1(), (const float*)(F.ws + WS_ST1), F.a->in[I_LN1G], F.a->in[I_LN1B]};
        pg8::gemm_phase<EpiPre2, pg8::StaticOrder, true, true>(F.lds, g, S, E, F.wave);
        smallg::run(F, F.HB(), F.WDNT(), FF, D, smallg::EDown{F.X1B(), (const bf16_t*)F.PRE1(), (const float*)(F.ws + WS_ST1), F.a->in[I_LN1G], F.a->in[I_LN1B]}); SEAM(12); }
    if (IN(13)) { p_ln(F, F.X1B(), F.a->in[I_LN2G], F.a->in[I_LN2B], F.out + O_Y, nullptr); }
#undef IN
#undef SEAM
}
static int g_grid = 0;
static bool fast_setup() {
    if (g_grid) return g_grid > 0;
    int dev = 0, cus = 0, per_cu = 0;
    if (hipGetDevice(&dev) != hipSuccess || hipDeviceGetAttribute(&cus, hipDeviceAttributeMultiprocessorCount, dev) != hipSuccess) { g_grid = -1; return false; }
    if (hipFuncSetAttribute((const void*)fwd, hipFuncAttributeMaxDynamicSharedMemorySize, LDS_BYTES) != hipSuccess) { fprintf(stderr, "kernel_launch: hipFuncSetAttribute failed\n"); g_grid = -1; return false; }
    if (hipOccupancyMaxActiveBlocksPerMultiprocessor(&per_cu, (const void*)fwd, NWAVES * 64, LDS_BYTES) != hipSuccess || per_cu < 1) { fprintf(stderr, "kernel_launch: occupancy query says %d blocks/CU\n", per_cu); (void)hipGetLastError(); g_grid = -1; return false; }
    g_grid = cus;
    return true; }
static void fast_launch(void* const* d_in, void* d_out, void* d_ws, hipStream_t st, int lo, int hi) {
    Args a{}; for (int i = 0; i < N_IN; ++i) a.in[i] = (const float*)d_in[i]; a.out = (float*)d_out; a.ws = (unsigned char*)d_ws; a.ph_lo = lo; a.ph_hi = hi;
    hipLaunchKernelGGL(fwd, dim3(g_grid), dim3(NWAVES * 64), LDS_BYTES, st, a);
    const hipError_t e = hipPeekAtLastError(); if (e != hipSuccess) fprintf(stderr, "kernel_launch: launch [%d,%d) failed: %s\n", lo, hi, hipGetErrorName(e)); }
extern "C" void kernel_launch(void* const* d_in, const int* in_sizes, int n_in, void* d_out, int out_size, void* d_ws, size_t ws_size, hipStream_t stream) {
    if (n_in != N_IN || (size_t)out_size != O_END || ws_size < WS_NEED) { fprintf(stderr, "kernel_launch: unexpected sizes n_in %d out %d ws %zu\n", n_in, out_size, ws_size); return; }
    if (!fast_setup()) return;
    hipMemsetAsync((char*)d_ws + WS_CTL, 0, CTL_ZERO_BYTES, stream);
    fast_launch(d_in, d_out, d_ws, stream, 0, 14);
}
```

```cpp
#include <hip/hip_runtime.h>
#include <cstdio>
#include <cstdint>
#include <cmath>
constexpr int D = 1024, BATCH = 32, SEQ = 2048, DB = 128, DT = 8, PAST = 16384, PAGE = 128, NPAGES = 128;
constexpr int MP = BATCH * SEQ, MS = DB * DT, M = MP + MS;
constexpr int H = 8, DK = 64, DV = 64, CONVD = 1536, GCONV = 4;
constexpr int QL = 256, KVL = 128, NOPE = 64, ROPE = 32, VD = 64;
constexpr int INC = 2480, N1 = 2560, FF = 2816, FF2 = 5632, NQ = 768;
constexpr float ALPHA = 1.189207115002721f;
constexpr float RMS_EPS = 1e-6f, LN_EPS = 1e-5f;
constexpr float MLA_SCALE = 0.10206207261596577f;
constexpr float LOG2E = 1.4426950408889634f;
constexpr float QSCALE = MLA_SCALE * LOG2E;
constexpr size_t O_Y = 0;
constexpr size_t O_PCKV = (size_t)M * D;
constexpr size_t O_PKPE = O_PCKV + (size_t)MP * KVL;
constexpr size_t O_PGDN = O_PKPE + (size_t)MP * ROPE;
constexpr size_t O_PGC = O_PGDN + (size_t)BATCH * H * DK * DV;
constexpr size_t O_PFC = O_PGC + (size_t)BATCH * 3 * CONVD;
constexpr size_t O_SCKV = O_PFC + (size_t)BATCH * 2 * FF2;
constexpr size_t O_SKPE = O_SCKV + (size_t)MS * KVL;
constexpr size_t O_SGDN = O_SKPE + (size_t)MS * ROPE;
constexpr size_t O_SGC = O_SGDN + (size_t)DB * H * DK * DV;
constexpr size_t O_SFC = O_SGC + (size_t)DB * 3 * CONVD;
constexpr size_t O_END = O_SFC + (size_t)DB * 2 * FF2;
static_assert(O_END == 86589440, "out size");
enum { I_XP = 0, I_XS, I_CCKV, I_CKPE, I_PT, I_SGDN, I_SGC, I_SFC, I_WIN, I_GCW, I_ALOG, I_DTB, I_GNW, I_QNW, I_WUQ, I_KVNW, I_WUK, I_WUV, I_WOUT, I_LN1G, I_LN1B, I_WUP, I_FCW, I_WDN, I_LN2G, I_LN2B, N_IN };
constexpr size_t MiB = 1u << 20;
constexpr size_t WS_CTL = 0;
constexpr size_t WS_ROPE = 1 * MiB;
constexpr size_t WS_W1T = 2 * MiB;
constexpr size_t WS_WUQT = 8 * MiB;
constexpr size_t WS_WUKVT = 9 * MiB;
constexpr size_t WS_WOUTT = 10 * MiB;
constexpr size_t WS_WUPT = 12 * MiB;
constexpr size_t WS_WDNT = 24 * MiB;
constexpr size_t WS_XB = 32 * MiB;
constexpr size_t WS_QKVR = 164 * MiB;
constexpr size_t WS_Z = 360 * MiB;
constexpr size_t WS_SM = 426 * MiB;
constexpr size_t WS_CQN = 558 * MiB;
constexpr size_t WS_CN = 592 * MiB;
constexpr size_t WS_KPE = 626 * MiB;
constexpr size_t WS_BG = 632 * MiB;
constexpr size_t WS_QP = 638 * MiB;
constexpr size_t WS_KNV = 736 * MiB;
constexpr size_t WS_MIX = 866 * MiB;
constexpr size_t WS_PRE1 = 998 * MiB;
constexpr size_t WS_X1B = 1260 * MiB;
constexpr size_t WS_U = 1392 * MiB;
constexpr size_t WS_HB = 2108 * MiB;
constexpr size_t WS_SPART = 2468 * MiB;
constexpr size_t WS_SLOW = 2560 * MiB;
constexpr size_t WS_NEED = 4600 * MiB;
typedef unsigned short bf16_t;
__device__ __host__ __forceinline__ float bf2f(bf16_t b) { unsigned u = (unsigned)b << 16; return __builtin_bit_cast(float, u); }
__device__ __host__ __forceinline__ bf16_t f2bf(float f) { unsigned u = __builtin_bit_cast(unsigned, f); return (bf16_t)((u + 0x7fffu + ((u >> 16) & 1u)) >> 16); }
__host__ __device__ __forceinline__ int map1(int n) { if (n < 2048) return n; if (n < 2304) return 2064 + (n - 2048); if (n < 2432) return 2320 + (n - 2304); if (n < 2464) return 2448 + (n - 2432); if (n < 2472) return 2048 + (n - 2464); if (n < 2480) return 2056 + (n - 2472); return -1; }
__host__ __device__ __forceinline__ int mapq(int n) { if (n < 512) return (n >> 6) * 96 + (n & 63); const int m = n - 512, h = m >> 5, j = m & 31; return h * 96 + 64 + (j >> 1) + 16 * (j & 1); }
__device__ __forceinline__ float silu_f(float x) { return x * __builtin_amdgcn_rcpf(1.f + __builtin_amdgcn_exp2f(-1.4426950408889634f * x)); }
__device__ __forceinline__ float softplus_f(float x) { return x > 20.f ? x : log1pf(__expf(x)); }
__constant__ double c_invfreq[16] = {1.0, 0.5623413251903491, 0.31622776601683794, 0.1778279410038923, 0.1, 0.05623413251903491, 0.03162277660168379, 0.01778279410038923, 0.01, 0.005623413251903491, 0.0031622776601683794, 0.0017782794100389228, 0.001, 0.0005623413251903491, 0.00031622776601683794, 0.00017782794100389227};
__device__ __forceinline__ void rope_entry(int p, int i, float& c, float& s) {
    const double pos = (double)(p < SEQ ? p : PAST + (p - SEQ));
    const double rev = pos * c_invfreq[i] * 0.15915494309189535;
    const float fr = (float)(rev - __builtin_rint(rev));
    c = __builtin_amdgcn_cosf(fr); s = __builtin_amdgcn_sinf(fr);
}
#define GAS __attribute__((address_space(1)))
#define LAS __attribute__((address_space(3)))
typedef unsigned v4u __attribute__((ext_vector_type(4)));
typedef float f32x4 __attribute__((ext_vector_type(4)));
typedef short bf16x8 __attribute__((ext_vector_type(8)));
typedef GAS unsigned gu32;
typedef GAS unsigned long long gu64;
#define RLX_AGENT __ATOMIC_RELAXED, __HIP_MEMORY_SCOPE_AGENT
#define LDS_WAIT() asm volatile("s_waitcnt lgkmcnt(0)" ::: "memory")
#define VM_WAIT() asm volatile("s_waitcnt vmcnt(0)" ::: "memory")
__device__ __forceinline__ unsigned long long rt() { return __builtin_amdgcn_s_memrealtime(); }
#define XB_TMO      128
#define XB_XCNT(j)  (256  + 64 * (j))
#define XB_XSUB(j)  (1280 + 64 * (j))
#define XB_XGEN(j)  (2304 + 64 * (j))
#define XB_TOP      3328
#define XB_TOPGEN   3392
#define XCD_BAR_WORDS 3456
#define XB_SPIN_CAP (1u << 18)

__device__ __forceinline__ unsigned xb_ld(unsigned* p)              { return __hip_atomic_load(p, __ATOMIC_RELAXED, __HIP_MEMORY_SCOPE_AGENT); }
__device__ __forceinline__ unsigned xb_add(unsigned* p, unsigned v) { return __hip_atomic_fetch_add(p, v, __ATOMIC_RELAXED, __HIP_MEMORY_SCOPE_AGENT); }
__device__ __forceinline__ unsigned xb_xcc_id() { return (unsigned)__builtin_amdgcn_s_getreg((3 << 11) | 20) & 0xFu; }
#define XB_SPIN(cond, bar) do { unsigned _sp = 0; while (cond) { __builtin_amdgcn_s_sleep(1); \
    if ((++_sp & 255u) == 0u) { if (xb_ld(&(bar)[XB_TMO])) break; if (_sp > XB_SPIN_CAP) { atomicAdd(&(bar)[XB_TMO], 1u); break; } } } } while (0)

struct XcdBarrier {
    unsigned* bar; unsigned x; unsigned lead;
    volatile LAS unsigned* st;
};

__device__ __forceinline__ bool xb_lane0() { int l; asm volatile("v_mbcnt_lo_u32_b32 %0, -1, 0\n\tv_mbcnt_hi_u32_b32 %0, -1, %0" : "=v"(l)); return l == 0; }
__device__ __forceinline__ XcdBarrier xcd_barrier_post(unsigned* bar, volatile LAS unsigned* st, unsigned lead  ) {
    XcdBarrier b; b.bar = bar; b.x = xb_xcc_id(); b.st = st; b.lead = lead;
    if (b.lead && xb_lane0()) (void)xb_add(&bar[XB_XCNT(b.x)], 1u);
    return b;
}
__device__ __forceinline__ void xcd_barrier_complete(unsigned* bar, unsigned x, unsigned& nloc, unsigned& nx) {
    const unsigned G = gridDim.x * gridDim.y * gridDim.z;
    unsigned sum, cnt, mine, sp = 0u;
    for (;;) {
        sum = 0u; cnt = 0u; mine = 0u;
#pragma unroll
        for (unsigned j = 0; j < 16; ++j) { const unsigned c = xb_ld(&bar[XB_XCNT(j)]); sum += c; cnt += (c > 0u) ? 1u : 0u; mine = (j == x) ? c : mine; }
        if (sum == G) break;
        __builtin_amdgcn_s_sleep(1);
        if ((++sp & 255u) == 0u) { if (xb_ld(&bar[XB_TMO])) break; if (sp > XB_SPIN_CAP) { atomicAdd(&bar[XB_TMO], 1u); break; } }
    }
    nloc = mine > 0u ? mine : 1u; nx = cnt > 0u ? cnt : 1u;
}

__device__ __forceinline__ void xcd_barrier(const XcdBarrier& b) {
    asm volatile("s_waitcnt vmcnt(0)" ::: "memory");
    __syncthreads();
    if (b.lead && xb_lane0()) {
        unsigned* bar = b.bar;
        __builtin_amdgcn_s_waitcnt(0);
        unsigned nloc = b.st[0], nx = b.st[1];
        if (nloc == 0u) { xcd_barrier_complete(bar, b.x, nloc, nx); b.st[0] = nloc; b.st[1] = nx; }
        const unsigned old = xb_add(&bar[XB_XSUB(b.x)], 1u);
        const unsigned gen = old / nloc;
        if (old + 1u == (gen + 1u) * nloc) {
            __builtin_amdgcn_fence(__ATOMIC_RELEASE, "agent");
            asm volatile("s_waitcnt vmcnt(0)" ::: "memory");
            const unsigned og = xb_add(&bar[XB_TOP], 1u);
            const unsigned tg = og / nx;
            if (og + 1u == (tg + 1u) * nx) xb_add(&bar[XB_TOPGEN], 1u);
            else XB_SPIN(xb_ld(&bar[XB_TOPGEN]) == tg, bar);
            __builtin_amdgcn_fence(__ATOMIC_ACQUIRE, "agent");
            xb_add(&bar[XB_XGEN(b.x)], 1u);
            asm volatile("s_waitcnt vmcnt(0)" ::: "memory");
        } else {
            XB_SPIN(xb_ld(&bar[XB_XGEN(b.x)]) == gen, bar);
            __builtin_amdgcn_fence(__ATOMIC_ACQUIRE, "agent");
            asm volatile("s_waitcnt vmcnt(0)" ::: "memory");
        }
    }
    __syncthreads();
}
namespace pg8 {
#define PG8_LAS __attribute__((address_space(3)))
typedef unsigned short bf16_t;
typedef short bf16x8 __attribute__((ext_vector_type(8)));
typedef float f32x4 __attribute__((ext_vector_type(4)));
typedef unsigned u32x4 __attribute__((ext_vector_type(4)));
constexpr int BM = 256, BK = 64, HALF = 128, HTB = HALF * BK * 2  , STAGE_BYTES = 8 * HTB, NXCD = 8, WGM = 8;

__host__ __device__ __forceinline__ int lds_byte(int r, int c) { const int st = (r >> 4) * 2 + (c >> 5), rr = r & 15, cc = c & 31, ob = rr * 64 + cc * 2; return st * 1024 + (ob ^ (((ob >> 9) & 1) << 5)); }
__host__ __device__ __forceinline__ void stage_rc(int b, int& R, int& C) { const int st = b / 1024, sb = b % 1024, swz = sb ^ (((sb >> 9) & 1) << 5); R = (st >> 1) * 16 + swz / 64; C = (st & 1) * 32 + (swz % 64) / 2; }
__host__ __device__ __forceinline__ int perm32(int rho) { const int n = rho >> 4, i = rho & 15; return 8 * (i >> 2) + 4 * n + (i & 3); }

struct Unit { int pm, pn; };
struct Gemm { const bf16_t* A; const bf16_t* Bt; int M, N, K; };

struct StaticOrder {
    int nM, nN, nwg, G, c, wgm, pnfast;
    __host__ __device__ void init(int M, int N, int G_, int c_, int wgm_ = WGM, int pnfast_ = 0) { nM = M / BM; nN = N / BM; nwg = nM * nN; G = G_; c = c_; wgm = wgm_; pnfast = pnfast_; }
    __host__ __device__ bool next(int i, Unit& u) const {
        const long L = (long)i * G + c; if (L >= nwg) return false;
        int wgid = (int)L; { const int q = nwg / NXCD, r = nwg % NXCD, xcd = wgid % NXCD, off = wgid / NXCD; wgid = (xcd < r ? xcd * (q + 1) : r * (q + 1) + (xcd - r) * q) + off; }
        const int nig = wgm * nN, gid = wgid / nig, fm = gid * wgm, gsz = (nM - fm) < wgm ? (nM - fm) : wgm;
        if (pnfast) { u.pm = fm + (wgid % nig) / nN; u.pn = (wgid % nig) % nN; } else { u.pm = fm + ((wgid % nig) % gsz); u.pn = (wgid % nig) / gsz; }     return true;
    }
    __device__ __forceinline__ void a_ready(const Unit&) const {}
    __device__ __forceinline__ void done(const Unit&) const {}
};

__device__ __forceinline__ unsigned cvt_pk_bf16(float lo, float hi) { unsigned r; asm volatile("v_cvt_pk_bf16_f32 %0, %1, %2" : "=v"(r) : "v"(lo), "v"(hi)); return r; }
typedef float f32x2 __attribute__((ext_vector_type(2)));
template <class Epi, class Sched, bool ALIGN_EPI = false, bool SP2 = false>
__device__ __forceinline__ void gemm_phase(PG8_LAS unsigned char* lds, const Gemm g, const Sched& S, const Epi& E, const int wave_in) {
    int lane_; asm volatile("v_mbcnt_lo_u32_b32 %0, -1, 0\n\tv_mbcnt_hi_u32_b32 %0, -1, %0" : "=v"(lane_));
    const int lane = lane_, wid = wave_in, tid = wid * 64 + lane,
        wr = wid >> 2, wc = wid & 3, fr = lane & 15, fq = lane >> 4;
    int K_ = g.K; asm volatile("" : "+s"(K_));
    const int K = K_, nt = K / BK;
    unsigned voffA[2], voffB[2];
#pragma unroll
    for (int i = 0; i < 2; ++i) { int R, C; stage_rc(tid * 16 + i * 8192, R, C); const int Rb = Epi::PERM ? ((R & ~31) + perm32(R & 31)) : R;
        const int Ra = Epi::APERM ? ((R & 64) + 4 * (R & 15) + ((R >> 4) & 3)) : R;
        voffA[i] = (unsigned)(Ra * K + C) * 2u; voffB[i] = (unsigned)(Rb * K + C) * 2u; }
    const size_t kstep = (size_t)(BK * 2);
    const size_t hstep = (size_t)HALF * K * 2;
    const size_t tstep = 2 * hstep;
    const unsigned ldsw = (unsigned)wid * 1024u;
    const int aoff = lds_byte(wr * 64 + fr, fq * 8), boff = lds_byte(wc * 32 + fr, fq * 8);
#define PG8_SA(b, h) (((b) * 2 + (h)) * HTB)
#define PG8_SB(b, h) ((4 + (b) * 2 + (h)) * HTB)
#define PG8_STAGE(bufoff, gbase, voff) do { _Pragma("unroll") for (int _i = 0; _i < 2; ++_i) \
        __builtin_amdgcn_global_load_lds((const unsigned*)((const char*)(gbase) + (voff)[_i]), (PG8_LAS unsigned*)(lds + (bufoff) + ldsw + _i * 8192), 16, 0, 0); } while (0)
#define PG8_LDA(dst, b, h) do { _Pragma("unroll") for (int m = 0; m < 4; ++m) _Pragma("unroll") for (int k = 0; k < 2; ++k) dst[m][k] = *(const PG8_LAS bf16x8*)(lds + PG8_SA(b, h) + aoff + m * 2048 + k * 1024); } while (0)
#define PG8_LDB(dst, b, h) do { _Pragma("unroll") for (int n = 0; n < 2; ++n) _Pragma("unroll") for (int k = 0; k < 2; ++k) dst[n][k] = *(const PG8_LAS bf16x8*)(lds + PG8_SB(b, h) + boff + n * 2048 + k * 1024); } while (0)
#define PG8_MMA(ai, bj, At, Bt) do { __builtin_amdgcn_s_setprio(1); _Pragma("unroll") for (int m = 0; m < 4; ++m) _Pragma("unroll") for (int n = 0; n < 2; ++n) _Pragma("unroll") for (int k = 0; k < 2; ++k) \
        acc[ai][bj][m][n] = __builtin_amdgcn_mfma_f32_16x16x32_bf16(Bt[n][k], At[m][k], acc[ai][bj][m][n], 0, 0, 0); __builtin_amdgcn_s_setprio(0); } while (0)
#define PG8_WAIT_V(n) asm volatile("s_waitcnt vmcnt(" #n ")" ::: "memory")
#define PG8_WAIT_L(n) asm volatile("s_waitcnt lgkmcnt(" #n ")" ::: "memory")
#define PG8_BAR __builtin_amdgcn_s_barrier()
#define PG8_SCHED __builtin_amdgcn_sched_barrier(0)
    Unit cur, nxt; int ui = 0;
    if (!S.next(0, cur)) return;
    f32x4 acc[2][2][4][2];
#pragma unroll
    for (int a = 0; a < 2; ++a)
#pragma unroll
        for (int b = 0; b < 2; ++b)
#pragma unroll
            for (int m = 0; m < 4; ++m)
#pragma unroll
                for (int n = 0; n < 2; ++n) acc[a][b][m][n] = (f32x4){0.f, 0.f, 0.f, 0.f};
    bf16x8 At[4][2], B0[2][2], B1[2][2];
    const char* cA = (const char*)g.A + (size_t)cur.pm * tstep; const char* cB = (const char*)g.Bt + (size_t)cur.pn * tstep;
    S.a_ready(cur);
    if constexpr (SP2) {
        PG8_STAGE(PG8_SB(0, 0), cB, voffB); PG8_STAGE(PG8_SB(0, 1), cB + hstep, voffB); PG8_STAGE(PG8_SA(0, 0), cA, voffA); PG8_STAGE(PG8_SA(0, 1), cA + hstep, voffA);
        if (wr == 1) PG8_BAR;
        PG8_WAIT_V(2); PG8_BAR;
        PG8_STAGE(PG8_SB(1, 0), cB + kstep, voffB); PG8_STAGE(PG8_SA(1, 0), cA + kstep, voffA); PG8_STAGE(PG8_SB(1, 1), cB + hstep + kstep, voffB);
        PG8_WAIT_V(6); PG8_BAR;
    } else {
        PG8_STAGE(PG8_SB(0, 0), cB, voffB); PG8_STAGE(PG8_SA(0, 0), cA, voffA); PG8_STAGE(PG8_SB(0, 1), cB + hstep, voffB); PG8_STAGE(PG8_SA(0, 1), cA + hstep, voffA);
        if (wr == 1) PG8_BAR;
        PG8_WAIT_V(4); PG8_BAR;
        PG8_STAGE(PG8_SB(1, 0), cB + kstep, voffB); PG8_STAGE(PG8_SA(1, 0), cA + kstep, voffA); PG8_STAGE(PG8_SB(1, 1), cB + hstep + kstep, voffB);
        PG8_WAIT_V(6); PG8_BAR;
    }
    for (;;) {
        const bool has_next = S.next(ui + 1, nxt);
        const char* nA = has_next ? (const char*)g.A + (size_t)nxt.pm * tstep : cA; const char* nB = has_next ? (const char*)g.Bt + (size_t)nxt.pn * tstep : cB;
        for (int t = 0; t < nt; t += 2) {
            const bool last = (t == nt - 2);
            const char* a1 = cA + (size_t)(t + 1) * kstep;
            const char* a2 = last ? nA : cA + (size_t)(t + 2) * kstep; const char* b2 = last ? nB : cB + (size_t)(t + 2) * kstep;
            const char* a3 = a2 + kstep; const char* b3 = b2 + kstep;
            if (last && has_next) S.a_ready(nxt);
            if constexpr (SP2) {
            PG8_LDB(B0, 0, 0); PG8_LDB(B1, 0, 1); PG8_SCHED; PG8_LDA(At, 0, 0); PG8_STAGE(PG8_SA(1, 1), a1 + hstep, voffA);
            PG8_WAIT_V(8); PG8_WAIT_L(0); PG8_BAR; PG8_MMA(0, 0, At, B0); PG8_MMA(0, 1, At, B1); PG8_BAR; PG8_SCHED;
            PG8_LDA(At, 0, 1); PG8_STAGE(PG8_SB(0, 0), b2, voffB); PG8_STAGE(PG8_SB(0, 1), b2 + hstep, voffB); PG8_STAGE(PG8_SA(0, 0), a2, voffA);
            PG8_WAIT_V(8); PG8_WAIT_L(0); PG8_BAR; PG8_MMA(1, 0, At, B0); PG8_MMA(1, 1, At, B1); PG8_BAR; PG8_SCHED;
            PG8_LDB(B0, 1, 0); PG8_LDB(B1, 1, 1); PG8_SCHED; PG8_LDA(At, 1, 0); PG8_STAGE(PG8_SA(0, 1), a2 + hstep, voffA);
            PG8_WAIT_V(8); PG8_WAIT_L(0); PG8_BAR; PG8_MMA(0, 0, At, B0); PG8_MMA(0, 1, At, B1); PG8_BAR; PG8_SCHED;
            PG8_LDA(At, 1, 1); PG8_STAGE(PG8_SB(1, 0), b3, voffB); PG8_STAGE(PG8_SB(1, 1), b3 + hstep, voffB); PG8_STAGE(PG8_SA(1, 0), a3, voffA);
            PG8_WAIT_V(8); PG8_WAIT_L(0); PG8_BAR; PG8_MMA(1, 0, At, B0); PG8_MMA(1, 1, At, B1); PG8_BAR; PG8_SCHED;
            } else {
            PG8_LDB(B0, 0, 0); PG8_SCHED; PG8_LDA(At, 0, 0); PG8_STAGE(PG8_SA(1, 1), a1 + hstep, voffA);
            PG8_WAIT_L(8); PG8_BAR; PG8_WAIT_L(0); PG8_MMA(0, 0, At, B0); PG8_BAR; PG8_SCHED;
            PG8_LDB(B1, 0, 1); PG8_STAGE(PG8_SB(0, 0), b2, voffB);
            PG8_BAR; PG8_WAIT_L(0); PG8_MMA(0, 1, At, B1); PG8_BAR;
            PG8_LDA(At, 0, 1); PG8_STAGE(PG8_SA(0, 0), a2, voffA);
            PG8_BAR; PG8_WAIT_L(0); PG8_MMA(1, 0, At, B0); PG8_BAR; PG8_SCHED;
            PG8_STAGE(PG8_SB(0, 1), b2 + hstep, voffB);
            PG8_WAIT_V(6); PG8_BAR; PG8_MMA(1, 1, At, B1); PG8_BAR;
            PG8_LDB(B0, 1, 0); PG8_SCHED; PG8_LDA(At, 1, 0); PG8_STAGE(PG8_SA(0, 1), a2 + hstep, voffA);
            PG8_WAIT_L(8); PG8_BAR; PG8_WAIT_L(0); PG8_MMA(0, 0, At, B0); PG8_BAR; PG8_SCHED;
            PG8_LDB(B1, 1, 1); PG8_STAGE(PG8_SB(1, 0), b3, voffB);
            PG8_BAR; PG8_WAIT_L(0); PG8_MMA(0, 1, At, B1); PG8_BAR;
            PG8_LDA(At, 1, 1); PG8_STAGE(PG8_SA(1, 0), a3, voffA);
            PG8_BAR; PG8_WAIT_L(0); PG8_MMA(1, 0, At, B0); PG8_BAR; PG8_SCHED;
            PG8_STAGE(PG8_SB(1, 1), b3 + hstep, voffB);
            PG8_WAIT_V(6); PG8_BAR; PG8_MMA(1, 1, At, B1); PG8_BAR;
            }
        }
        if constexpr (ALIGN_EPI) { if (wr == 0) PG8_BAR; }
        if constexpr (!Epi::AFTER_DRAIN) { E(acc, cur, wr, wc, fr, fq); S.done(cur); }
        if (!has_next) break;
#pragma unroll
        for (int a = 0; a < 2; ++a)
#pragma unroll
            for (int b = 0; b < 2; ++b)
#pragma unroll
                for (int m = 0; m < 4; ++m)
#pragma unroll
                    for (int n = 0; n < 2; ++n) acc[a][b][m][n] = (f32x4){0.f, 0.f, 0.f, 0.f};
        cur = nxt; cA = nA; cB = nB; ++ui;
        if constexpr (ALIGN_EPI) { if (wr == 1) PG8_BAR; }
    }
    PG8_WAIT_V(0);
    if constexpr (!ALIGN_EPI) { if (wr == 0) PG8_BAR; }
    PG8_BAR;
    if constexpr (Epi::AFTER_DRAIN) { E.fused(acc, cur, wr, wc, fr, fq, lds, wid, lane); S.done(cur); }
#undef PG8_SA
#undef PG8_SB
#undef PG8_STAGE
#undef PG8_LDA
#undef PG8_LDB
#undef PG8_MMA
#undef PG8_WAIT_V
#undef PG8_WAIT_L
#undef PG8_BAR
#undef PG8_SCHED
}
}
constexpr int NWAVES = 8;
constexpr int RING_BYTES = 131072;
constexpr int MISC_OFF = RING_BYTES + 20480;
constexpr int LDS_BYTES = MISC_OFF + 256;
constexpr int CW_TMO = 0, CW_BAR = 4096, CW_PQ = 12288;
constexpr size_t CTL_ZERO_BYTES = 1 * MiB;
static_assert((CW_BAR + 3456) * 4 <= 32768, "control words");
constexpr size_t WS_GBUP = 65536;
constexpr size_t WS_ST1 = 131072;
static_assert(WS_GBUP + 2 * 5632 * 4 <= WS_ST1 && WS_ST1 + (size_t)66560 * 8 <= 1048576, "per-call zeroed region");
typedef unsigned u32x2 __attribute__((ext_vector_type(2)));
typedef float f32x2 __attribute__((ext_vector_type(2)));
typedef __bf16 bf16x2_t __attribute__((ext_vector_type(2)));
__device__ __forceinline__ unsigned pk2(float lo, float hi) { const f32x2 v = {lo, hi}; const bf16x2_t b = __builtin_convertvector(v, bf16x2_t); return __builtin_bit_cast(unsigned, b); }
__device__ __forceinline__ float wave_sum(float v) {
#pragma unroll
    for (int o = 1; o < 64; o <<= 1) v += __shfl_xor(v, o);
    return v; }

struct Args { const float* in[N_IN]; float* out; unsigned char* ws; int ph_lo, ph_hi; };
static_assert(sizeof(Args) == (N_IN + 2) * 8 + 8, "Args has no padding");
struct Frame {
    LAS unsigned char* lds; volatile LAS unsigned* MISC; gu32* ctl;
    int wave, G, gw, NGW;
    const Args* a; float* out; unsigned char* ws;
#define FB(T, name, off) __device__ __forceinline__ T* name() const { return (T*)(ws + (off)); }
    FB(bf16_t, XB, WS_XB) FB(bf16_t, W1T, WS_W1T) FB(bf16_t, WUQT, WS_WUQT) FB(bf16_t, WUKVT, WS_WUKVT) FB(bf16_t, WOUTT, WS_WOUTT) FB(bf16_t, WUPT, WS_WUPT) FB(bf16_t, WDNT, WS_WDNT)
    FB(bf16_t, QKVR, WS_QKVR) FB(bf16_t, Z, WS_Z) FB(bf16_t, CQN, WS_CQN) FB(bf16_t, CN, WS_CN) FB(bf16_t, KPE, WS_KPE) FB(bf16_t, QP, WS_QP) FB(bf16_t, KNV, WS_KNV)
    FB(bf16_t, MIX, WS_MIX) FB(bf16_t, X1B, WS_X1B) FB(bf16_t, U, WS_U) FB(bf16_t, HB, WS_HB) FB(float, SM, WS_SM) FB(float, BG, WS_BG) FB(float, PRE1, WS_PRE1) FB(float2, RT, WS_ROPE)
#undef FB
};
__device__ __forceinline__ int lane_now() { int l; asm volatile("v_mbcnt_lo_u32_b32 %0, -1, 0\n\tv_mbcnt_hi_u32_b32 %0, -1, %0" : "=v"(l)); return l; }
__device__ __forceinline__ int row_pos(int row) { return row < MP ? (row & (SEQ - 1)) : SEQ + ((row - MP) & (DT - 1)); }

template <class Src> __device__ __forceinline__ void p0_item(const Src& src, bf16_t* WT, int Kd, int Nd, LAS float* scr, int item, int lane) {
    const int nblk = Nd / 32, kb = item / nblk, nb = item % nblk, k0 = 64 * kb, n0 = 32 * nb;
#pragma unroll 8
    for (int i = 0; i < 32; ++i) { const int kk = 2 * i + (lane >> 5); scr[kk * 33 + (lane & 31)] = src(k0 + kk, n0 + (lane & 31)); }
    LDS_WAIT(); asm volatile("" ::: "memory");
    const int c = lane & 7;
#pragma unroll
    for (int j = 0; j < 4; ++j) { const int n = (lane >> 3) + 8 * j; const LAS float* s = scr + (8 * c) * 33 + n;
        v4u o; o.x = pk2(s[0 * 33], s[1 * 33]); o.y = pk2(s[2 * 33], s[3 * 33]); o.z = pk2(s[4 * 33], s[5 * 33]); o.w = pk2(s[6 * 33], s[7 * 33]);
        *(GAS v4u*)(WT + (size_t)(n0 + n) * Kd + k0 + 8 * c) = o; }
    LDS_WAIT(); asm volatile("" ::: "memory");
}
struct SrcW1 { const float* w; __device__ __forceinline__ float operator()(int k, int n) const { const int o = map1(n); return o < 0 ? 0.f : w[(size_t)k * INC + o]; } };
struct SrcUq { const float* w; const float* g; __device__ __forceinline__ float operator()(int k, int n) const { return g[k] * w[(size_t)k * NQ + mapq(n)]; } };
struct SrcUkv { const float* wk; const float* wv; __device__ __forceinline__ float operator()(int k, int n) const { return k >= KVL ? 0.f : (n < 512 ? wk[(size_t)k * 512 + n] : wv[(size_t)k * 512 + n - 512]); } };
struct SrcUp { const float* w; __device__ __forceinline__ float operator()(int k, int n) const { const int j = n & 255, c = (n >> 8) * 128 + (j & 127); return w[(size_t)k * FF2 + (j < 128 ? c : FF + c)]; } };
struct SrcPlain { const float* w; int N; __device__ __forceinline__ float operator()(int k, int n) const { return w[(size_t)k * N + n]; } };
__device__ __forceinline__ void p0_item_up(Frame& F, LAS float* scr, int item, int lane) {
    const float* w = F.a->in[I_WUP]; const float* g1 = F.a->in[I_LN1G]; const float* b1 = F.a->in[I_LN1B]; bf16_t* WT = F.WUPT(); float* G = (float*)(F.ws + WS_GBUP); float* B = G + FF2;
    const int nblk = FF2 / 32, kb = item / nblk, nb = item % nblk, k0 = 64 * kb, n0 = 32 * nb;
    const int nl = n0 + (lane & 31), j = nl & 255, c = (nl >> 8) * 128 + (j & 127), col = j < 128 ? c : FF + c; float sb = 0.f;
#pragma unroll 8
    for (int i = 0; i < 32; ++i) { const int kk = 2 * i + (lane >> 5); const float wv = w[(size_t)(k0 + kk) * FF2 + col]; sb += b1[k0 + kk] * wv; scr[kk * 33 + (lane & 31)] = g1[k0 + kk] * wv; }
    sb += __shfl_xor(sb, 32); if (lane < 32) unsafeAtomicAdd(B + nl, sb);
    LDS_WAIT(); asm volatile("" ::: "memory");
    const int cc = lane & 7;
#pragma unroll
    for (int jj = 0; jj < 4; ++jj) { const int n = (lane >> 3) + 8 * jj; const LAS float* sp = scr + (8 * cc) * 33 + n;
        v4u o; o.x = pk2(sp[0 * 33], sp[1 * 33]); o.y = pk2(sp[2 * 33], sp[3 * 33]); o.z = pk2(sp[4 * 33], sp[5 * 33]); o.w = pk2(sp[6 * 33], sp[7 * 33]);
        *(GAS v4u*)(WT + (size_t)(n0 + n) * 1024 + k0 + 8 * cc) = o;
        float sg = 0.f;
#pragma unroll
        for (int e = 0; e < 4; ++e) sg += __builtin_bit_cast(float, o[e] << 16) + __builtin_bit_cast(float, o[e] & 0xffff0000u);
        sg += __shfl_xor(sg, 1); sg += __shfl_xor(sg, 2); sg += __shfl_xor(sg, 4); if (cc == 0) unsafeAtomicAdd(G + n0 + n, sg); }
    LDS_WAIT(); asm volatile("" ::: "memory");
}
__device__ __forceinline__ void p0_prologue(Frame& F) {
    LAS float* scr = (LAS float*)(F.lds + F.wave * 16384); const int lane = lane_now();
    constexpr int I1 = 16 * (N1 / 32), I2 = 4 * (NQ / 32), I3 = 4 * 32, I4 = 16 * 32, I5 = 16 * (FF2 / 32), I6 = (FF / 64) * 32, NIT = I1 + I2 + I3 + I4 + I5 + I6;
    for (int it = F.gw; it < NIT; it += F.NGW) { int r = it;
        if (r < I1) { p0_item(SrcW1{F.a->in[I_WIN]}, F.W1T(), 1024, N1, scr, r, lane); continue; } r -= I1;
        if (r < I2) { p0_item(SrcUq{F.a->in[I_WUQ], F.a->in[I_QNW]}, F.WUQT(), 256, NQ, scr, r, lane); continue; } r -= I2;
        if (r < I3) { p0_item(SrcUkv{F.a->in[I_WUK], F.a->in[I_WUV]}, F.WUKVT(), 256, 1024, scr, r, lane); continue; } r -= I3;
        if (r < I4) { p0_item(SrcPlain{F.a->in[I_WOUT], 1024}, F.WOUTT(), 1024, 1024, scr, r, lane); continue; } r -= I4;
        if (r < I5) { p0_item_up(F, scr, r, lane); continue; } r -= I5;
        p0_item(SrcPlain{F.a->in[I_WDN], 1024}, F.WDNT(), FF, 1024, scr, r, lane); }
    { const size_t nth = (size_t)F.NGW * 64, t0 = (size_t)F.gw * 64 + lane; const size_t NP8 = (size_t)MP * D / 8, NT8 = (size_t)M * D / 8;
      for (size_t i = t0; i < NT8; i += nth) { const float* s = i < NP8 ? F.a->in[I_XP] + i * 8 : F.a->in[I_XS] + (i - NP8) * 8; const f32x4 a = *(const GAS f32x4*)s, b = *(const GAS f32x4*)(s + 4);
          v4u o; o.x = pk2(a.x, a.y); o.y = pk2(a.z, a.w); o.z = pk2(b.x, b.y); o.w = pk2(b.z, b.w); *(GAS v4u*)(F.XB() + i * 8) = o; } }
    for (int i = F.gw * 64 + lane; i < (SEQ + DT) * 16; i += F.NGW * 64) { float c, s; rope_entry(i / 16, i % 16, c, s); F.RT()[i] = make_float2(c, s); }
}

__device__ __forceinline__ void unpack8(const v4u w, float (&f)[8]) {
#pragma unroll
    for (int i = 0; i < 4; ++i) { f[2 * i] = __builtin_bit_cast(float, w[i] << 16); f[2 * i + 1] = __builtin_bit_cast(float, w[i] & 0xffff0000u); } }
__device__ __forceinline__ v4u pack8(const f32x4 a, const f32x4 b) { v4u w; w.x = pk2(a[0], a[1]); w.y = pk2(a[2], a[3]); w.z = pk2(b[0], b[1]); w.w = pk2(b[2], b[3]); return w; }
template <int NK> __device__ __forceinline__ bool state_row(int row, size_t& off_rows, bool& sample) {
    if (row < MP) { const int t = row & (SEQ - 1); if (t < SEQ - NK) return false; off_rows = (size_t)(row >> 11) * NK + (t - (SEQ - NK)); sample = false; return true; }
    const int r = row - MP, t = r & (DT - 1); if (t < DT - NK) return false; off_rows = (size_t)(r >> 3) * NK + (t - (DT - NK)); sample = true; return true; }
struct Epi1 {
    static constexpr bool PERM = true, AFTER_DRAIN = false, APERM = false;
    bf16_t* QKVR; bf16_t* Z; float* out; LAS float* P; bf16_t* CQN; bf16_t* CN; bf16_t* KPE; float* BG; const float* kvnw; const float* alog; const float* dtb; const float2* RT;
    __device__ __forceinline__ void operator()(const f32x4 (&acc)[2][2][4][2], const pg8::Unit& u, int wr, int wc, int fr, int fq) const {
        if (u.pn < 8) { const int row0 = u.pm * 256 + wr * 64 + fr, cl = wc * 32 + 8 * fq;
#pragma unroll
            for (int ai = 0; ai < 2; ++ai)
#pragma unroll
                for (int m = 0; m < 4; ++m) { const int row = row0 + ai * 128 + m * 16;
                    if (u.pn < 6) { bf16_t* p = QKVR + (size_t)row * 1536 + u.pn * 256 + cl;
#pragma unroll
                        for (int bj = 0; bj < 2; ++bj) *(v4u*)(p + bj * 128) = pack8(acc[ai][bj][m][0], acc[ai][bj][m][1]);
                        size_t orow; bool smp; if (state_row<3>(row, orow, smp)) { float* o = out + (smp ? O_SGC : O_PGC) + orow * CONVD + u.pn * 256 + cl;
#pragma unroll
                            for (int bj = 0; bj < 2; ++bj) { *(f32x4*)(o + bj * 128) = acc[ai][bj][m][0]; *(f32x4*)(o + bj * 128 + 4) = acc[ai][bj][m][1]; } } }
                    else { bf16_t* p = Z + (size_t)row * 512 + (u.pn - 6) * 256 + cl;
#pragma unroll
                        for (int bj = 0; bj < 2; ++bj) *(v4u*)(p + bj * 128) = pack8(acc[ai][bj][m][0], acc[ai][bj][m][1]); } }
            return; }
        { const int lo_ = lane_now(); fr = lo_ & 15; fq = lo_ >> 4; }
        const int row0 = u.pm * 256 + wr * 64 + fr, cl = wc * 32 + 8 * fq;
        const int nb = u.pn == 8 ? 2 : 1;
#pragma unroll
        for (int ai = 0; ai < 2; ++ai)
#pragma unroll
            for (int m = 0; m < 4; ++m) { float ss = 0.f;
#pragma unroll
                for (int bj = 0; bj < 2; ++bj) if (bj < nb) { const f32x4 a = acc[ai][bj][m][0], b = acc[ai][bj][m][1]; ss += (a[0] * a[0] + a[1] * a[1]) + (a[2] * a[2] + a[3] * a[3]) + (b[0] * b[0] + b[1] * b[1]) + (b[2] * b[2] + b[3] * b[3]); }
                ss += __shfl_xor(ss, 16); ss += __shfl_xor(ss, 32);
                if (fq == 0) P[(ai * 128 + wr * 64 + m * 16 + fr) * 4 + wc] = ss; }
        asm volatile("s_waitcnt lgkmcnt(0)\n\ts_barrier" ::: "memory");
#pragma unroll
        for (int ai = 0; ai < 2; ++ai)
#pragma unroll
            for (int m = 0; m < 4; ++m) { const int row = row0 + ai * 128 + m * 16; const f32x4 p4 = *(const LAS f32x4*)(P + (ai * 128 + wr * 64 + m * 16 + fr) * 4);
                const float tot = (p4[0] + p4[1]) + (p4[2] + p4[3]);
                if (u.pn == 8) { const float r = rsqrtf(tot * (1.f / 256.f) + RMS_EPS); bf16_t* p = CQN + (size_t)row * 256 + cl;
#pragma unroll
                    for (int bj = 0; bj < 2; ++bj) *(v4u*)(p + bj * 128) = pack8(acc[ai][bj][m][0] * r, acc[ai][bj][m][1] * r); }
                else { const float r = rsqrtf(tot * (1.f / 128.f) + RMS_EPS); const f32x4 g0 = *(const f32x4*)(kvnw + cl), g1 = *(const f32x4*)(kvnw + cl + 4);
                    const f32x4 c0 = acc[ai][0][m][0] * r * g0, c1 = acc[ai][0][m][1] * r * g1; float* oc = out + O_PCKV + (size_t)row * KVL + cl;
                    *(f32x4*)oc = c0; *(f32x4*)(oc + 4) = c1; *(v4u*)(CN + (size_t)row * 256 + cl) = pack8(c0, c1); *(v4u*)(CN + (size_t)row * 256 + 128 + cl) = (v4u){0u, 0u, 0u, 0u};
                    const f32x4 x0 = acc[ai][1][m][0], x1 = acc[ai][1][m][1];
                    if (wc == 0) { f32x4 q0, q1;
#pragma unroll
                        for (int e = 0; e < 4; ++e) { q0[e] = __shfl_xor(x0[e], 32); q1[e] = __shfl_xor(x1[e], 32); }
                        if (fq < 2) { const float2* rt = RT + (row & (SEQ - 1)) * 16 + 8 * fq; f32x4 ya, yb, za, zb;
#pragma unroll
                            for (int e = 0; e < 4; ++e) { const float2 ca = rt[e], cb = rt[4 + e]; ya[e] = x0[e] * ca.x - q0[e] * ca.y; za[e] = x0[e] * ca.y + q0[e] * ca.x; yb[e] = x1[e] * cb.x - q1[e] * cb.y; zb[e] = x1[e] * cb.y + q1[e] * cb.x; }
                            float* ok = out + O_PKPE + (size_t)row * ROPE + 8 * fq; *(f32x4*)ok = ya; *(f32x4*)(ok + 4) = yb; *(f32x4*)(ok + 16) = za; *(f32x4*)(ok + 20) = zb;
                            bf16_t* kp = KPE + (size_t)row * 32 + 16 * fq;
                            *(v4u*)kp = (v4u){pk2(ya[0], za[0]), pk2(ya[1], za[1]), pk2(ya[2], za[2]), pk2(ya[3], za[3])}; *(v4u*)(kp + 8) = (v4u){pk2(yb[0], zb[0]), pk2(yb[1], zb[1]), pk2(yb[2], zb[2]), pk2(yb[3], zb[3])}; } }
                    else if (wc == 1 && fq == 0) { f32x4 b0, b1;
#pragma unroll
                        for (int e = 0; e < 4; ++e) { b0[e] = 1.f / (1.f + __expf(-x0[e])); b1[e] = 1.f / (1.f + __expf(-x1[e])); }
                        *(f32x4*)(BG + (size_t)row * 16 + 8) = b0; *(f32x4*)(BG + (size_t)row * 16 + 12) = b1; }
                    else if (wc == 1 && fq == 1) { f32x4 gA, gB;
#pragma unroll
                        for (int e = 0; e < 4; ++e) { gA[e] = -__expf(alog[e]) * softplus_f(x0[e] + dtb[e]); gB[e] = -__expf(alog[4 + e]) * softplus_f(x1[e] + dtb[4 + e]); }
                        *(f32x4*)(BG + (size_t)row * 16) = gA; *(f32x4*)(BG + (size_t)row * 16 + 4) = gB; } } }
        asm volatile("s_waitcnt lgkmcnt(0)\n\ts_barrier" ::: "memory");
    }
};
struct EpiQ {
    static constexpr bool PERM = true, AFTER_DRAIN = false, APERM = false;
    bf16_t* QP; const float2* RT;
    __device__ __forceinline__ void operator()(const f32x4 (&acc)[2][2][4][2], const pg8::Unit& u, int wr, int wc, int fr, int fq) const {
        const int row0 = u.pm * 256 + wr * 64 + fr, cl = wc * 32 + 8 * fq;
#pragma unroll
        for (int ai = 0; ai < 2; ++ai)
#pragma unroll
            for (int m = 0; m < 4; ++m) { const int row = row0 + ai * 128 + m * 16; bf16_t* p = QP + (size_t)row * NQ + u.pn * 256 + cl;
                if (u.pn < 2) {
#pragma unroll
                    for (int bj = 0; bj < 2; ++bj) *(v4u*)(p + bj * 128) = pack8(acc[ai][bj][m][0] * QSCALE, acc[ai][bj][m][1] * QSCALE); }
                else { const float2* rt = RT + row_pos(row) * 16 + 4 * fq; const f32x4 cs01 = *(const f32x4*)rt, cs23 = *(const f32x4*)(rt + 2);
#pragma unroll
                    for (int bj = 0; bj < 2; ++bj) { const f32x4 a = acc[ai][bj][m][0], b = acc[ai][bj][m][1]; f32x4 ra, rb;
                        ra[0] = a[0] * cs01[0] - a[1] * cs01[1]; ra[1] = a[0] * cs01[1] + a[1] * cs01[0]; ra[2] = a[2] * cs01[2] - a[3] * cs01[3]; ra[3] = a[2] * cs01[3] + a[3] * cs01[2];
                        rb[0] = b[0] * cs23[0] - b[1] * cs23[1]; rb[1] = b[0] * cs23[1] + b[1] * cs23[0]; rb[2] = b[2] * cs23[2] - b[3] * cs23[3]; rb[3] = b[2] * cs23[3] + b[3] * cs23[2];
                        *(v4u*)(p + bj * 128) = pack8(ra * QSCALE, rb * QSCALE); } } }
    }
};
struct EpiB16 {
    static constexpr bool PERM = true, AFTER_DRAIN = false, APERM = false;
    bf16_t* O; int ld; int pad;
    __device__ __forceinline__ void operator()(const f32x4 (&acc)[2][2][4][2], const pg8::Unit& u, int wr, int wc, int fr, int fq) const {
        const int row0 = u.pm * 256 + wr * 64 + fr, c0 = u.pn * 256 + wc * 32 + 8 * fq;
#pragma unroll
        for (int ai = 0; ai < 2; ++ai)
#pragma unroll
            for (int m = 0; m < 4; ++m) { bf16_t* p = O + (size_t)(row0 + ai * 128 + m * 16) * ld + c0;
#pragma unroll
                for (int bj = 0; bj < 2; ++bj) *(v4u*)(p + bj * 128) = pack8(acc[ai][bj][m][0], acc[ai][bj][m][1]); }
    }
};
struct EpiUp {
    static constexpr bool PERM = true, AFTER_DRAIN = false, APERM = false;
    bf16_t* U; float* out;
    __device__ __forceinline__ void operator()(const f32x4 (&acc)[2][2][4][2], const pg8::Unit& u, int wr, int wc, int fr, int fq) const {
        const int row0 = u.pm * 256 + wr * 64 + fr, c0 = u.pn * 256 + wc * 32 + 8 * fq;
#pragma unroll
        for (int ai = 0; ai < 2; ++ai)
#pragma unroll
            for (int m = 0; m < 4; ++m) { const int row = row0 + ai * 128 + m * 16; bf16_t* p = U + (size_t)row * FF2 + c0;
#pragma unroll
                for (int bj = 0; bj < 2; ++bj) *(v4u*)(p + bj * 128) = pack8(acc[ai][bj][m][0], acc[ai][bj][m][1]);
                size_t orow; bool smp; if (state_row<2>(row, orow, smp)) { float* o = out + (smp ? O_SFC : O_PFC) + orow * FF2 + c0;
#pragma unroll
                    for (int bj = 0; bj < 2; ++bj) { *(f32x4*)(o + bj * 128) = acc[ai][bj][m][0]; *(f32x4*)(o + bj * 128 + 4) = acc[ai][bj][m][1]; } } }
    }
};
struct EpiRes {
    static constexpr bool PERM = false, AFTER_DRAIN = false, APERM = false;
    float* O; const float* R0; const float* R1;
    __device__ __forceinline__ void operator()(const f32x4 (&acc)[2][2][4][2], const pg8::Unit& u, int wr, int wc, int fr, int fq) const {
        const int row0 = u.pm * 256 + wr * 64 + fr, c0 = u.pn * 256 + wc * 32 + 4 * fq;
#pragma unroll
        for (int ai = 0; ai < 2; ++ai)
#pragma unroll
            for (int m = 0; m < 4; ++m) { const int row = row0 + ai * 128 + m * 16; const float* r = (row < MP ? R0 + (size_t)row * D : R1 + (size_t)(row - MP) * D) + c0; float* o = O + (size_t)row * D + c0;
#pragma unroll
                for (int bj = 0; bj < 2; ++bj)
#pragma unroll
                    for (int n = 0; n < 2; ++n) { const f32x4 x = *(const f32x4*)(r + bj * 128 + n * 16); *(f32x4*)(o + bj * 128 + n * 16) = acc[ai][bj][m][n] + ALPHA * x; } }
    }
};

struct EpiPre1 {
    static constexpr bool PERM = true, AFTER_DRAIN = false, APERM = false;
    bf16_t* O; const bf16_t* RB; float* ST;
    __device__ __forceinline__ void operator()(const f32x4 (&acc)[2][2][4][2], const pg8::Unit& u, int wr, int wc, int fr, int fq) const {
        const int row0 = u.pm * 256 + wr * 64 + fr, c0 = u.pn * 256 + wc * 32 + 8 * fq;
#pragma unroll
        for (int ai = 0; ai < 2; ++ai)
#pragma unroll
            for (int m = 0; m < 4; ++m) { const int row = row0 + ai * 128 + m * 16; const size_t off = (size_t)row * D + c0; float s1 = 0.f, s2 = 0.f;
#pragma unroll
                for (int bj = 0; bj < 2; ++bj) { float xx[8]; unpack8(*(const v4u*)(RB + off + bj * 128), xx); const f32x4 x0 = {xx[0], xx[1], xx[2], xx[3]}, x1 = {xx[4], xx[5], xx[6], xx[7]};
                    const f32x4 v0 = acc[ai][bj][m][0] + ALPHA * x0, v1 = acc[ai][bj][m][1] + ALPHA * x1;
                    s1 += (v0[0] + v0[1]) + (v0[2] + v0[3]) + (v1[0] + v1[1]) + (v1[2] + v1[3]);
                    s2 += (v0[0] * v0[0] + v0[1] * v0[1]) + (v0[2] * v0[2] + v0[3] * v0[3]) + (v1[0] * v1[0] + v1[1] * v1[1]) + (v1[2] * v1[2] + v1[3] * v1[3]);
                    *(v4u*)(O + off + bj * 128) = pack8(v0, v1); }
                s1 += __shfl_xor(s1, 16); s1 += __shfl_xor(s1, 32); s2 += __shfl_xor(s2, 16); s2 += __shfl_xor(s2, 32);
                if (fq == 0) { unsafeAtomicAdd(ST + 2 * row, s1); unsafeAtomicAdd(ST + 2 * row + 1, s2); } }
    }
};
__device__ __forceinline__ void ln1_stats(const float* ST, int row, float& mu, float& rstd) { const f32x2 s = *(const f32x2*)(ST + 2 * row); mu = s.x * (1.f / D); rstd = rsqrtf(fmaxf(s.y * (1.f / D) - mu * mu, 0.f) + LN_EPS); }
struct EpiPre2 {
    static constexpr bool PERM = true, AFTER_DRAIN = false, APERM = false;
    bf16_t* O; const bf16_t* R; const float* ST; const float* g1; const float* b1;
    __device__ __forceinline__ void operator()(const f32x4 (&acc)[2][2][4][2], const pg8::Unit& u, int wr, int wc, int fr, int fq) const {
        const int row0 = u.pm * 256 + wr * 64 + fr, c0 = u.pn * 256 + wc * 32 + 8 * fq;
        f32x4 gg[2][2], bb[2][2];
#pragma unroll
        for (int bj = 0; bj < 2; ++bj)
#pragma unroll
            for (int n = 0; n < 2; ++n) { gg[bj][n] = *(const f32x4*)(g1 + c0 + bj * 128 + 4 * n); bb[bj][n] = *(const f32x4*)(b1 + c0 + bj * 128 + 4 * n); }
#pragma unroll
        for (int ai = 0; ai < 2; ++ai)
#pragma unroll
            for (int m = 0; m < 4; ++m) { const int row = row0 + ai * 128 + m * 16; const size_t off = (size_t)row * D + c0; float mu, rstd; ln1_stats(ST, row, mu, rstd);
#pragma unroll
                for (int bj = 0; bj < 2; ++bj) { float x[8]; unpack8(*(const v4u*)(R + off + bj * 128), x);
                    const f32x4 x0 = ((f32x4){x[0], x[1], x[2], x[3]} - mu) * rstd * gg[bj][0] + bb[bj][0], x1 = ((f32x4){x[4], x[5], x[6], x[7]} - mu) * rstd * gg[bj][1] + bb[bj][1];
                    *(v4u*)(O + off + bj * 128) = pack8(acc[ai][bj][m][0] + ALPHA * x0, acc[ai][bj][m][1] + ALPHA * x1); } }
    }
};
struct EpiResB {
    static constexpr bool PERM = false, AFTER_DRAIN = false, APERM = false;
    float* O; const bf16_t* R;
    __device__ __forceinline__ void operator()(const f32x4 (&acc)[2][2][4][2], const pg8::Unit& u, int wr, int wc, int fr, int fq) const {
        const int row0 = u.pm * 256 + wr * 64 + fr, c0 = u.pn * 256 + wc * 32 + 4 * fq;
#pragma unroll
        for (int ai = 0; ai < 2; ++ai)
#pragma unroll
            for (int m = 0; m < 4; ++m) { const size_t off = (size_t)(row0 + ai * 128 + m * 16) * D + c0;
#pragma unroll
                for (int bj = 0; bj < 2; ++bj)
#pragma unroll
                    for (int n = 0; n < 2; ++n) { const u32x2 xr = *(const u32x2*)(R + off + bj * 128 + n * 16);
                        const f32x4 x = {__builtin_bit_cast(float, xr.x << 16), __builtin_bit_cast(float, xr.x & 0xffff0000u), __builtin_bit_cast(float, xr.y << 16), __builtin_bit_cast(float, xr.y & 0xffff0000u)};
                        *(f32x4*)(O + off + bj * 128 + n * 16) = acc[ai][bj][m][n] + ALPHA * x; } }
    }
};
__device__ __forceinline__ float dpp_shr1(float v) { return __builtin_bit_cast(float, __builtin_amdgcn_update_dpp(0, __builtin_bit_cast(int, v), 0x111, 0xf, 0xf, true)); }
constexpr size_t WS_RAWB = (size_t)3100 * MiB, WS_PARTB = (size_t)3160 * MiB;
struct EpiUpCG {
    static constexpr bool PERM = true, AFTER_DRAIN = false, APERM = true;
    bf16_t* U; bf16_t* HB; float* RAWB; float* PARTB; const float* cw; float* out; const float* GB; const float* ST;
    __device__ __forceinline__ void operator()(const f32x4 (&acc_)[2][2][4][2], const pg8::Unit& u, int wr, int wc, int fr, int fq) const {
        f32x4 (&acc)[2][2][4][2] = const_cast<f32x4 (&)[2][2][4][2]>(acc_);
        { const float* Gp = GB + u.pn * 256 + wc * 32 + 8 * fq; f32x4 Gv[2][2], Bv[2][2];
#pragma unroll
          for (int bj = 0; bj < 2; ++bj)
#pragma unroll
              for (int n = 0; n < 2; ++n) { Gv[bj][n] = *(const f32x4*)(Gp + bj * 128 + 4 * n); Bv[bj][n] = *(const f32x4*)(Gp + FF2 + bj * 128 + 4 * n); }
#pragma unroll
          for (int ai = 0; ai < 2; ++ai)
#pragma unroll
              for (int m = 0; m < 4; ++m) { float mu, rstd; ln1_stats(ST, u.pm * 256 + ai * 128 + wr * 64 + 4 * fr + m, mu, rstd);
#pragma unroll
                  for (int bj = 0; bj < 2; ++bj)
#pragma unroll
                      for (int n = 0; n < 2; ++n) acc[ai][bj][m][n] = (acc[ai][bj][m][n] - mu * Gv[bj][n]) * rstd + Bv[bj][n]; } }
        const int c0 = u.pn * 128 + wc * 32 + 8 * fq;
        if (u.pm >= MP / 256) {
#pragma unroll
            for (int ai = 0; ai < 2; ++ai)
#pragma unroll
                for (int m = 0; m < 4; ++m) { const int row = u.pm * 256 + ai * 128 + wr * 64 + 4 * fr + m; bf16_t* p = U + (size_t)row * FF2 + u.pn * 256 + wc * 32 + 8 * fq;
#pragma unroll
                    for (int bj = 0; bj < 2; ++bj) *(v4u*)(p + bj * 128) = pack8(acc[ai][bj][m][0], acc[ai][bj][m][1]);
                    size_t orow; bool smp; if (state_row<2>(row, orow, smp)) { float* o = out + O_SFC + orow * FF2 + c0;
#pragma unroll
                        for (int bj = 0; bj < 2; ++bj) { *(f32x4*)(o + bj * FF) = acc[ai][bj][m][0]; *(f32x4*)(o + bj * FF + 4) = acc[ai][bj][m][1]; } } }
            return; }
#pragma unroll
        for (int ai = 0; ai < 2; ++ai) { const int tok0 = u.pm * 256 + ai * 128 + wr * 64, blk = tok0 >> 6; u32x2 hp0[4];
#pragma unroll
            for (int n = 0; n < 2; ++n) { f32x4 wU[3], wG[3];
#pragma unroll
                for (int j = 0; j < 3; ++j) { wU[j] = *(const f32x4*)(cw + j * FF2 + c0 + 4 * n); wG[j] = *(const f32x4*)(cw + j * FF2 + FF + c0 + 4 * n); }
                const f32x4 u0 = acc[ai][0][0][n], u1 = acc[ai][0][1][n], u2 = acc[ai][0][2][n], u3 = acc[ai][0][3][n], g0 = acc[ai][1][0][n], g1 = acc[ai][1][1][n], g2 = acc[ai][1][2][n], g3 = acc[ai][1][3][n];
                f32x4 su3, su2, sg3, sg2;
#pragma unroll
                for (int e = 0; e < 4; ++e) { su3[e] = dpp_shr1(u3[e]); su2[e] = dpp_shr1(u2[e]); sg3[e] = dpp_shr1(g3[e]); sg2[e] = dpp_shr1(g2[e]); }
                u32x2 hq[4];
                { const f32x4 hu = wU[2] * u0 + wU[1] * su3 + wU[0] * su2, hg = wG[2] * g0 + wG[1] * sg3 + wG[0] * sg2;
                  if (fr == 0) { float* pp = PARTB + (size_t)blk * 2 * FF2 + c0 + 4 * n; *(f32x4*)pp = hu; *(f32x4*)(pp + FF) = hg; }
                  hq[0] = (u32x2){pk2(silu_f(hg[0]) * hu[0], silu_f(hg[1]) * hu[1]), pk2(silu_f(hg[2]) * hu[2], silu_f(hg[3]) * hu[3])}; }
                { const f32x4 hu = wU[2] * u1 + wU[1] * u0 + wU[0] * su3, hg = wG[2] * g1 + wG[1] * g0 + wG[0] * sg3;
                  if (fr == 0) { float* pp = PARTB + (size_t)blk * 2 * FF2 + FF2 + c0 + 4 * n; *(f32x4*)pp = hu; *(f32x4*)(pp + FF) = hg; }
                  hq[1] = (u32x2){pk2(silu_f(hg[0]) * hu[0], silu_f(hg[1]) * hu[1]), pk2(silu_f(hg[2]) * hu[2], silu_f(hg[3]) * hu[3])}; }
                { const f32x4 hu = wU[2] * u2 + wU[1] * u1 + wU[0] * u0, hg = wG[2] * g2 + wG[1] * g1 + wG[0] * g0;
                  hq[2] = (u32x2){pk2(silu_f(hg[0]) * hu[0], silu_f(hg[1]) * hu[1]), pk2(silu_f(hg[2]) * hu[2], silu_f(hg[3]) * hu[3])}; }
                { const f32x4 hu = wU[2] * u3 + wU[1] * u2 + wU[0] * u1, hg = wG[2] * g3 + wG[1] * g2 + wG[0] * g1;
                  hq[3] = (u32x2){pk2(silu_f(hg[0]) * hu[0], silu_f(hg[1]) * hu[1]), pk2(silu_f(hg[2]) * hu[2], silu_f(hg[3]) * hu[3])}; }
                if (fr == 15) { float* rp = RAWB + (size_t)blk * 2 * FF2 + c0 + 4 * n;
                    *(f32x4*)rp = u2; *(f32x4*)(rp + FF) = g2; *(f32x4*)(rp + FF2) = u3; *(f32x4*)(rp + FF2 + FF) = g3;
                    if ((blk & 31) == 31) { float* o = out + O_PFC + (size_t)(blk >> 5) * 2 * FF2 + c0 + 4 * n; *(f32x4*)o = u2; *(f32x4*)(o + FF) = g2; *(f32x4*)(o + FF2) = u3; *(f32x4*)(o + FF2 + FF) = g3; } }
                if (n == 0) {
#pragma unroll
                    for (int m = 0; m < 4; ++m) hp0[m] = hq[m]; }
                else { bf16_t* hp = HB + (size_t)(tok0 + 4 * fr) * FF + c0;
#pragma unroll
                    for (int m = 0; m < 4; ++m) if (fr != 0 || m >= 2) *(v4u*)(hp + (size_t)m * FF) = (v4u){hp0[m].x, hp0[m].y, hq[m].x, hq[m].y}; } } }
    }
};

__device__ __forceinline__ void p_tok(Frame& F) {
    const float* kvnw = F.a->in[I_KVNW]; const float* alog = F.a->in[I_ALOG]; const float* dtb = F.a->in[I_DTB]; const int l = lane_now();
    const f32x2 kvw = *(const f32x2*)(kvnw + 2 * l);
    for (int row = MP + F.gw; row < M; row += F.NGW) { const bf16_t* s = (const bf16_t*)F.SM() + (size_t)row * 512;
        const u32x2 qr = *(const GAS u32x2*)(s + 4 * l); const unsigned cr = *(const GAS unsigned*)(s + 256 + 2 * l); const float sm = bf2f(s[384 + l]);
        const f32x4 q = {__builtin_bit_cast(float, qr.x << 16), __builtin_bit_cast(float, qr.x & 0xffff0000u), __builtin_bit_cast(float, qr.y << 16), __builtin_bit_cast(float, qr.y & 0xffff0000u)}; const f32x2 c = {__builtin_bit_cast(float, cr << 16), __builtin_bit_cast(float, cr & 0xffff0000u)};
        const float r1 = rsqrtf(wave_sum(q.x * q.x + q.y * q.y + q.z * q.z + q.w * q.w) * (1.f / 256.f) + RMS_EPS);
        const float r2 = rsqrtf(wave_sum(c.x * c.x + c.y * c.y) * (1.f / 128.f) + RMS_EPS);
        u32x2 w; w.x = pk2(q.x * r1, q.y * r1); w.y = pk2(q.z * r1, q.w * r1); *(GAS u32x2*)(F.CQN() + (size_t)row * 256 + 4 * l) = w;
        const float c0 = c.x * r2 * kvw.x, c1 = c.y * r2 * kvw.y;
        float* ockv = row < MP ? F.out + O_PCKV + (size_t)row * KVL : F.out + O_SCKV + (size_t)(row - MP) * KVL;
        float* okpe = row < MP ? F.out + O_PKPE + (size_t)row * ROPE : F.out + O_SKPE + (size_t)(row - MP) * ROPE;
        *(GAS f32x2*)(ockv + 2 * l) = (f32x2){c0, c1}; ((GAS unsigned*)(F.CN() + (size_t)row * 256))[l] = pk2(c0, c1); ((GAS unsigned*)(F.CN() + (size_t)row * 256 + 128))[l] = 0u;
        const float x2 = __shfl(sm, (l + 16) & 63);
        if (l < 16) { const float2 cs = F.RT()[row_pos(row) * 16 + l]; const float y1 = sm * cs.x - x2 * cs.y, y2 = sm * cs.y + x2 * cs.x; okpe[l] = y1; okpe[16 + l] = y2; ((GAS unsigned*)(F.KPE() + (size_t)row * 32))[l] = pk2(y1, y2); }
        if (l >= 32 && l < 40) F.BG()[(size_t)row * 16 + 8 + (l - 32)] = 1.f / (1.f + __expf(-sm));
        if (l >= 40 && l < 48) { const int h = l - 40; F.BG()[(size_t)row * 16 + h] = -__expf(alog[h]) * softplus_f(sm + dtb[h]); } }
}
__device__ __forceinline__ void p_ln(Frame& F, const bf16_t* in, const float* g, const float* bt, float* outp, bf16_t* ob) {
    const int l = lane_now(); f32x4 gg[4], bb[4];
#pragma unroll
    for (int j = 0; j < 4; ++j) { gg[j] = *(const f32x4*)(g + 4 * l + 256 * j); bb[j] = *(const f32x4*)(bt + 4 * l + 256 * j); }
    for (int row = F.gw; row < M; row += F.NGW) { const GAS u32x2* xr = (const GAS u32x2*)(in + (size_t)row * D) + l; f32x4 v[4]; float s = 0.f;
#pragma unroll
        for (int j = 0; j < 4; ++j) { const u32x2 r = xr[64 * j]; v[j] = (f32x4){__builtin_bit_cast(float, r.x << 16), __builtin_bit_cast(float, r.x & 0xffff0000u), __builtin_bit_cast(float, r.y << 16), __builtin_bit_cast(float, r.y & 0xffff0000u)}; s += (v[j].x + v[j].y) + (v[j].z + v[j].w); }
        const float mean = wave_sum(s) * (1.f / D); float s2 = 0.f;
#pragma unroll
        for (int j = 0; j < 4; ++j) { v[j] = v[j] - mean; s2 += (v[j].x * v[j].x + v[j].y * v[j].y) + (v[j].z * v[j].z + v[j].w * v[j].w); }
        const float rstd = rsqrtf(wave_sum(s2) * (1.f / D) + LN_EPS);
#pragma unroll
        for (int j = 0; j < 4; ++j) { const f32x4 y = v[j] * rstd * gg[j] + bb[j]; if (outp) *((GAS f32x4*)(outp + (size_t)row * D) + l + 64 * j) = y;
            if (ob) { u32x2 w; w.x = pk2(y.x, y.y); w.y = pk2(y.z, y.w); *((GAS u32x2*)(ob + (size_t)row * D) + l + 64 * j) = w; } } }
}
__device__ __forceinline__ void p_cg(Frame& F) {
    const float* cw = F.a->in[I_FCW]; const float* hist = F.a->in[I_SFC]; const float* RAWB = (const float*)(F.ws + WS_RAWB); const float* PARTB = (const float*)(F.ws + WS_PARTB);
    const int lane = lane_now(); const int gt = F.gw * 64 + lane, gn = F.NGW * 64;
    for (int it = gt; it < (MP / 64) * 2 * (FF / 4); it += gn) { const int c = (it % (FF / 4)) * 4, r = (it / (FF / 4)) & 1, blk = it / (2 * (FF / 4));
        const float* pp = PARTB + ((size_t)blk * 2 + r) * FF2 + c; f32x4 hu = *(const GAS f32x4*)pp, hg = *(const GAS f32x4*)(pp + FF);
        if (blk & 31) { const float* rp = RAWB + (size_t)(blk - 1) * 2 * FF2 + c; const f32x4 u62 = *(const GAS f32x4*)rp, g62 = *(const GAS f32x4*)(rp + FF), u63 = *(const GAS f32x4*)(rp + FF2), g63 = *(const GAS f32x4*)(rp + FF2 + FF);
            const f32x4 wu0 = *(const GAS f32x4*)(cw + c), wg0 = *(const GAS f32x4*)(cw + FF + c), wu1 = *(const GAS f32x4*)(cw + FF2 + c), wg1 = *(const GAS f32x4*)(cw + FF2 + FF + c);
            if (r == 0) { hu += wu1 * u63 + wu0 * u62; hg += wg1 * g63 + wg0 * g62; } else { hu += wu0 * u63; hg += wg0 * g63; } }
        u32x2 w; w.x = pk2(silu_f(hg[0]) * hu[0], silu_f(hg[1]) * hu[1]); w.y = pk2(silu_f(hg[2]) * hu[2], silu_f(hg[3]) * hu[3]);
        *(GAS u32x2*)(F.HB() + (size_t)(blk * 64 + r) * FF + c) = w; }
    for (int it = gt; it < MS * (FF / 8); it += gn) { const int cg = it % (FF / 8), rs = it / (FF / 8), c = cg * 8, row = MP + rs, t = rs & (DT - 1); const int pc = (c >> 7) * 256 + (c & 127);
        float au[8], ag[8];
#pragma unroll
        for (int e = 0; e < 8; ++e) { au[e] = 0.f; ag[e] = 0.f; }
#pragma unroll
        for (int j = 0; j < 3; ++j) { const int tt = t + j - 2; float xu[8], xg[8];
            if (tt >= 0) { const bf16_t* p = F.U() + (size_t)(row - t + tt) * FF2 + pc; unpack8(*(const GAS v4u*)p, xu); unpack8(*(const GAS v4u*)(p + 128), xg); }
            else { const float* h = hist + ((size_t)(rs >> 3) * 2 + (tt + 2)) * FF2 + c;
#pragma unroll
                for (int e = 0; e < 8; ++e) { xu[e] = h[e]; xg[e] = h[FF + e]; } }
#pragma unroll
            for (int e = 0; e < 8; ++e) { au[e] += cw[j * FF2 + c + e] * xu[e]; ag[e] += cw[j * FF2 + FF + c + e] * xg[e]; } }
        v4u w; w.x = pk2(silu_f(ag[0]) * au[0], silu_f(ag[1]) * au[1]); w.y = pk2(silu_f(ag[2]) * au[2], silu_f(ag[3]) * au[3]); w.z = pk2(silu_f(ag[4]) * au[4], silu_f(ag[5]) * au[5]); w.w = pk2(silu_f(ag[6]) * au[6], silu_f(ag[7]) * au[7]);
        *(GAS v4u*)(F.HB() + (size_t)row * FF + c) = w; }
}
namespace pattn {
typedef float f32x16 __attribute__((ext_vector_type(16)));
typedef short s16x4 __attribute__((ext_vector_type(4)));
constexpr int KSTR = 208, VSTR = 192, KBUF = 128 * KSTR, VBUF = 128 * VSTR, BUF = KBUF + VBUF;
__device__ __forceinline__ s16x4 vtr(const LAS unsigned char* p) { return __builtin_bit_cast(s16x4, __builtin_amdgcn_ds_read_tr16_b64_v4i16((LAS s16x4*)p)); }
__device__ __forceinline__ void phase(Frame& F) {
    const int lane = lane_now(), w = F.wave, tid = w * 64 + lane, r32 = lane & 31, hi = lane >> 5;
    const int skey = tid >> 3, sc = tid & 7, pkey = tid >> 2, pc = tid & 3;
    LAS unsigned char* L = F.lds;
    unsigned* qctr = (unsigned*)(F.ctl + CW_PQ); LAS int* qs = (LAS int*)(L + 2 * BUF);
    for (;;) {
        if (tid == 0) *qs = (int)__hip_atomic_fetch_add(qctr, 1u, __ATOMIC_RELAXED, __HIP_MEMORY_SCOPE_AGENT);
        __syncthreads();
        const int item = __builtin_amdgcn_readfirstlane(*qs);
        __syncthreads();
        if (item >= BATCH * H * 8) break;
        const int qb = 7 - (item >> 8), unit = item & 255;
        const int b = unit >> 3, h = unit & 7;
        const bf16_t* KNVb = F.KNV() + (size_t)b * SEQ * 1024 + h * 64; const bf16_t* KPEb = F.KPE() + (size_t)b * SEQ * 32; const bf16_t* QPb = F.QP() + (size_t)b * SEQ * NQ;
        bf16_t* Ob = F.MIX() + (size_t)b * SEQ * 1024 + 512 + h * 64;
        {
            const int q0 = qb * 256 + w * 32, NT = 4 * (qb + 1);
            bf16x8 qf[6];
            { const bf16_t* qrow = QPb + (size_t)(q0 + r32) * NQ;
#pragma unroll
              for (int ks = 0; ks < 4; ++ks) qf[ks] = *(const GAS bf16x8*)(qrow + h * 64 + ks * 16 + hi * 8);
#pragma unroll
              for (int ks = 0; ks < 2; ++ks) qf[4 + ks] = *(const GAS bf16x8*)(qrow + 512 + h * 32 + ks * 16 + hi * 8); }
            f32x16 o0, o1;
#pragma unroll
            for (int i = 0; i < 16; ++i) { o0[i] = 0.f; o1[i] = 0.f; }
            float m = -INFINITY, lsum = 0.f;
            v4u gk[2], gv[2], gp;
#define PA_LOAD(ts) do { _Pragma("unroll") for (int u_ = 0; u_ < 2; ++u_) { const bf16_t* kp_ = KNVb + (size_t)(128 * (ts) + 64 * u_ + skey) * 1024 + sc * 8; gk[u_] = *(const GAS v4u*)kp_; gv[u_] = *(const GAS v4u*)(kp_ + 512); } \
                        gp = *(const GAS v4u*)(KPEb + (size_t)(128 * (ts) + pkey) * 32 + pc * 8); } while (0)
#define PA_STORE(bufi) do { LAS unsigned char* kb_ = L + (bufi) * BUF; _Pragma("unroll") for (int u_ = 0; u_ < 2; ++u_) { *(LAS v4u*)(kb_ + (64 * u_ + skey) * KSTR + sc * 16) = gk[u_]; *(LAS v4u*)(kb_ + KBUF + (64 * u_ + skey) * VSTR + sc * 16) = gv[u_]; } \
                        *(LAS v4u*)(kb_ + pkey * KSTR + 128 + pc * 16) = gp; } while (0)
            PA_LOAD(0); PA_STORE(0); __syncthreads();
            for (int ts = 0; ts < NT / 2; ++ts) {
                if (ts + 1 < NT / 2) PA_LOAD(ts + 1);
#pragma unroll 1
                for (int sub = 0; sub < 2; ++sub) { const int t = 2 * ts + sub;
                if (64 * t <= q0 + 31) {
                    const LAS unsigned char* kb = L + (ts & 1) * BUF + sub * 64 * KSTR; const LAS unsigned char* vb = L + (ts & 1) * BUF + KBUF + sub * 64 * VSTR;
                    f32x16 p0, p1;
#pragma unroll
                    for (int i = 0; i < 16; ++i) { p0[i] = 0.f; p1[i] = 0.f; }
                    __builtin_amdgcn_s_setprio(1);
#pragma unroll
                    for (int ks = 0; ks < 6; ++ks) { const bf16x8 a0 = *(const LAS bf16x8*)(kb + r32 * KSTR + ks * 32 + hi * 16), a1 = *(const LAS bf16x8*)(kb + (32 + r32) * KSTR + ks * 32 + hi * 16);
                        p0 = __builtin_amdgcn_mfma_f32_32x32x16_bf16(a0, qf[ks], p0, 0, 0, 0); p1 = __builtin_amdgcn_mfma_f32_32x32x16_bf16(a1, qf[ks], p1, 0, 0, 0); }
                    __builtin_amdgcn_s_setprio(0);
                    if (64 * t + 63 > q0) { const int qa = q0 + r32, k0 = 64 * t + 4 * hi;
#pragma unroll
                        for (int i = 0; i < 16; ++i) { const int kk = k0 + 8 * (i >> 2) + (i & 3); if (kk > qa) p0[i] = -INFINITY; if (kk + 32 > qa) p1[i] = -INFINITY; } }
                    float mx = fmaxf(p0[0], p1[0]);
#pragma unroll
                    for (int i = 1; i < 16; ++i) mx = fmaxf(mx, fmaxf(p0[i], p1[i]));
                    mx = fmaxf(mx, __shfl_xor(mx, 32));
                    const float mn = fmaxf(m, mx); const bool resc = __any(mx > m);
                    float ps = 0.f;
#pragma unroll
                    for (int i = 0; i < 16; ++i) { p0[i] = __builtin_amdgcn_exp2f(p0[i] - mn); p1[i] = __builtin_amdgcn_exp2f(p1[i] - mn); ps += p0[i] + p1[i]; }
                    if (resc) { const float alpha = __builtin_amdgcn_exp2f(m - mn); lsum *= alpha;
#pragma unroll
                        for (int i = 0; i < 16; ++i) { o0[i] *= alpha; o1[i] *= alpha; } }
                    lsum += ps; m = mn;
                    v4u pf[4];
                    pf[0] = (v4u){pk2(p0[0], p0[1]), pk2(p0[2], p0[3]), pk2(p0[4], p0[5]), pk2(p0[6], p0[7])};
                    pf[1] = (v4u){pk2(p0[8], p0[9]), pk2(p0[10], p0[11]), pk2(p0[12], p0[13]), pk2(p0[14], p0[15])};
                    pf[2] = (v4u){pk2(p1[0], p1[1]), pk2(p1[2], p1[3]), pk2(p1[4], p1[5]), pk2(p1[6], p1[7])};
                    pf[3] = (v4u){pk2(p1[8], p1[9]), pk2(p1[10], p1[11]), pk2(p1[12], p1[13]), pk2(p1[14], p1[15])};
                    const LAS unsigned char* vl = vb + (4 * hi + ((lane & 15) >> 2)) * VSTR + (16 * ((lane >> 4) & 1) + 4 * (lane & 3)) * 2;
                    __builtin_amdgcn_s_setprio(1);
#pragma unroll
                    for (int st = 0; st < 4; ++st) {
#pragma unroll
                        for (int vbk = 0; vbk < 2; ++vbk) { const s16x4 lo = vtr(vl + (16 * st) * VSTR + vbk * 64), hh = vtr(vl + (16 * st + 8) * VSTR + vbk * 64);
                            const bf16x8 af = (bf16x8){lo[0], lo[1], lo[2], lo[3], hh[0], hh[1], hh[2], hh[3]};
                            if (vbk == 0) o0 = __builtin_amdgcn_mfma_f32_32x32x16_bf16(af, __builtin_bit_cast(bf16x8, pf[st]), o0, 0, 0, 0);
                            else o1 = __builtin_amdgcn_mfma_f32_32x32x16_bf16(af, __builtin_bit_cast(bf16x8, pf[st]), o1, 0, 0, 0); } }
                    __builtin_amdgcn_s_setprio(0);
                } }
                if (ts + 1 < NT / 2) PA_STORE((ts + 1) & 1);
                __syncthreads();
            }
#undef PA_LOAD
#undef PA_STORE
            const float il = 1.f / (lsum + __shfl_xor(lsum, 32));
            bf16_t* orow = Ob + (size_t)(q0 + r32) * 1024 + 4 * hi;
#pragma unroll
            for (int g = 0; g < 4; ++g) { u32x2 a, c; a.x = pk2(o0[4 * g] * il, o0[4 * g + 1] * il); a.y = pk2(o0[4 * g + 2] * il, o0[4 * g + 3] * il); c.x = pk2(o1[4 * g] * il, o1[4 * g + 1] * il); c.y = pk2(o1[4 * g + 2] * il, o1[4 * g + 3] * il);
                *(GAS u32x2*)(orow + 8 * g) = a; *(GAS u32x2*)(orow + 32 + 8 * g) = c; }
        }
    }
}
}
namespace sattn {
typedef float f32x16 __attribute__((ext_vector_type(16)));
typedef short s16x4 __attribute__((ext_vector_type(4)));
constexpr int STR = 336, TILE = 128 * STR;
constexpr int OFF_T0 = 0, OFF_T1 = TILE, OFF_Q = 2 * TILE;
constexpr int OFF_ML = 131072;
constexpr int PSTR = 132;
__device__ __forceinline__ s16x4 vtr(const LAS unsigned char* p) { return __builtin_bit_cast(s16x4, __builtin_amdgcn_ds_read_tr16_b64_v4i16((LAS s16x4*)p)); }
__device__ __forceinline__ void phase(Frame& F, int first, int step) {
    const int w = F.wave, qb2 = w & 1, kg = w >> 1;
    LAS unsigned char* L = F.lds; float* SP = (float*)(F.ws + WS_SPART);
    const float* cckv = F.a->in[I_CCKV]; const float* ckpe = F.a->in[I_CKPE]; const int* pt = (const int*)F.a->in[I_PT];
    for (int unit = first; unit < DB * 2; unit += step) {
        const int sb = unit >> 1, sp = unit & 1;
        { const int tid = w * 64 + lane_now(); const int hq = tid >> 3, rg = tid & 7, h = hq >> 3, t = hq & 7; const bf16_t* qrow = F.QP() + (size_t)(MP + sb * DT + t) * NQ;
          float qn[64];
#pragma unroll
          for (int c = 0; c < 8; ++c) { const v4u v = *(const GAS v4u*)(qrow + h * 64 + c * 8);
#pragma unroll
              for (int e = 0; e < 4; ++e) { qn[c * 8 + 2 * e] = __builtin_bit_cast(float, v[e] << 16); qn[c * 8 + 2 * e + 1] = __builtin_bit_cast(float, v[e] & 0xffff0000u); } }
          const float* wk = F.a->in[I_WUK] + (size_t)(rg * 16) * 512 + h * 64; LAS unsigned char* qd = L + OFF_Q + hq * STR + rg * 32;
#pragma unroll 1
          for (int rr = 0; rr < 16; rr += 2) { float a0 = 0.f, a1 = 0.f; const float* w0p = wk + (size_t)rr * 512;
#pragma unroll
              for (int n = 0; n < 64; n += 4) { const f32x4 w0 = *(const GAS f32x4*)(w0p + n), w1 = *(const GAS f32x4*)(w0p + 512 + n);
                  a0 += qn[n] * w0.x + qn[n + 1] * w0.y + qn[n + 2] * w0.z + qn[n + 3] * w0.w; a1 += qn[n] * w1.x + qn[n + 1] * w1.y + qn[n + 2] * w1.z + qn[n + 3] * w1.w; }
              *(LAS unsigned*)(qd + rr * 2) = pk2(a0, a1); }
          if (rg < 4) { const bf16_t* pe = qrow + 512 + h * 32; bf16_t e8[8];
#pragma unroll
              for (int e = 0; e < 8; ++e) { const int p = rg * 8 + e; e8[e] = pe[p < 16 ? 2 * p : 2 * (p - 16) + 1]; }
              v4u o; o.x = e8[0] | ((unsigned)e8[1] << 16); o.y = e8[2] | ((unsigned)e8[3] << 16); o.z = e8[4] | ((unsigned)e8[5] << 16); o.w = e8[6] | ((unsigned)e8[7] << 16);
              *(LAS v4u*)(L + OFF_Q + hq * STR + 256 + rg * 16) = o; } }
        __syncthreads();
        const int lane = lane_now(), tid = w * 64 + lane, r32 = lane & 31, hi = lane >> 5;
        const LAS unsigned char* qlp = L + OFF_Q + (32 * qb2 + r32) * STR + hi * 16;
        f32x16 o[4];
#pragma unroll
        for (int lb = 0; lb < 4; ++lb)
#pragma unroll
            for (int i = 0; i < 16; ++i) o[lb][i] = 0.f;
        float m = -INFINITY, lsum = 0.f;
        f32x4 gcA[8], gpA[2], gcB[8], gpB[2]; const int mypage = pt[sb * NPAGES + sp * (NPAGES / 2) + lane];
#define SA_LOAD(gc, gp, j) do { const size_t pg = (size_t)(unsigned)__builtin_amdgcn_readlane(mypage, (j));     const __amdgpu_buffer_rsrc_t rc_ = __builtin_amdgcn_make_buffer_rsrc((void*)(cckv + pg * (PAGE * KVL)), 0, PAGE * KVL * 4, 0x00020000), rp_ = __builtin_amdgcn_make_buffer_rsrc((void*)(ckpe + pg * (PAGE * ROPE)), 0, PAGE * ROPE * 4, 0x00020000); \
                _Pragma("unroll") for (int i = 0; i < 8; ++i) gc[i] = __builtin_bit_cast(f32x4, __builtin_amdgcn_raw_buffer_load_b128(rc_, tid * 16 + i * 8192, 0, 2));   \
                _Pragma("unroll") for (int i = 0; i < 2; ++i) gp[i] = __builtin_bit_cast(f32x4, __builtin_amdgcn_raw_buffer_load_b128(rp_, tid * 16 + i * 8192, 0, 2)); } while (0)
#define SA_LOADV(gc, gp) do { const float* c0 = F.out + O_SCKV + (size_t)sb * DT * KVL + tid * 4; const float* p0 = F.out + O_SKPE + (size_t)sb * DT * ROPE + tid * 4;     \
                _Pragma("unroll") for (int i = 0; i < 8; ++i) gc[i] = (i == 0 && tid < 256) ? *(const GAS f32x4*)c0 : (f32x4){0.f, 0.f, 0.f, 0.f}; \
                _Pragma("unroll") for (int i = 0; i < 2; ++i) gp[i] = (i == 0 && tid < 64) ? *(const GAS f32x4*)p0 : (f32x4){0.f, 0.f, 0.f, 0.f}; } while (0)
#define SA_STORE(gc, gp, bufi) do { LAS unsigned char* tb = L + (bufi) * TILE; \
            _Pragma("unroll") for (int i = 0; i < 8; ++i) { const int c = tid + 512 * i; u32x2 v; v.x = pk2(gc[i].x, gc[i].y); v.y = pk2(gc[i].z, gc[i].w); *(LAS u32x2*)(tb + (c >> 5) * STR + (c & 31) * 8) = v; } \
            _Pragma("unroll") for (int i = 0; i < 2; ++i) { const int c = tid + 512 * i; u32x2 v; v.x = pk2(gp[i].x, gp[i].y); v.y = pk2(gp[i].z, gp[i].w); *(LAS u32x2*)(tb + (c >> 3) * STR + 256 + (c & 7) * 8) = v; } } while (0)
#define SA_COMPUTE(newk, bufi) do { \
            if (!newk || kg == 0) { \
                const LAS unsigned char* tb = L + (bufi) * TILE + (32 * kg) * STR; \
                f32x16 p; \
                _Pragma("unroll") for (int i = 0; i < 16; ++i) p[i] = 0.f; \
                _Pragma("unroll") for (int ks = 0; ks < 10; ++ks) { const bf16x8 a = *(const LAS bf16x8*)(tb + r32 * STR + ks * 32 + hi * 16), qk = *(const LAS bf16x8*)(qlp + ks * 32); p = __builtin_amdgcn_mfma_f32_32x32x16_bf16(a, qk, p, 0, 0, 0); } \
                if (newk) { const int tq = r32 & 7;                   \
                    _Pragma("unroll") for (int i = 0; i < 16; ++i) { const int kk = 4 * hi + 8 * (i >> 2) + (i & 3); if (kk > tq) p[i] = -INFINITY; } } \
                float mx = p[0]; \
                _Pragma("unroll") for (int i = 1; i < 16; ++i) mx = fmaxf(mx, p[i]); \
                mx = fmaxf(mx, __shfl_xor(mx, 32)); \
                const float mn = fmaxf(m, mx), alpha = __builtin_amdgcn_exp2f(m - mn); m = mn; float ps = 0.f; \
                _Pragma("unroll") for (int i = 0; i < 16; ++i) { p[i] = __builtin_amdgcn_exp2f(p[i] - mn); ps += p[i]; } \
                lsum = lsum * alpha + ps; \
                _Pragma("unroll") for (int lb = 0; lb < 4; ++lb) _Pragma("unroll") for (int i = 0; i < 16; ++i) o[lb][i] *= alpha; \
                v4u pf[2]; \
                pf[0] = (v4u){pk2(p[0], p[1]), pk2(p[2], p[3]), pk2(p[4], p[5]), pk2(p[6], p[7])}; pf[1] = (v4u){pk2(p[8], p[9]), pk2(p[10], p[11]), pk2(p[12], p[13]), pk2(p[14], p[15])}; \
                const LAS unsigned char* vl = tb + (4 * hi + ((lane & 15) >> 2)) * STR + (16 * ((lane >> 4) & 1) + 4 * (lane & 3)) * 2; \
                _Pragma("unroll") for (int st = 0; st < 2; ++st) _Pragma("unroll") for (int lb = 0; lb < 4; ++lb) { const s16x4 lo = vtr(vl + (16 * st) * STR + lb * 64), hh = vtr(vl + (16 * st + 8) * STR + lb * 64); \
                        const bf16x8 af = (bf16x8){lo[0], lo[1], lo[2], lo[3], hh[0], hh[1], hh[2], hh[3]}; \
                        o[lb] = __builtin_amdgcn_mfma_f32_32x32x16_bf16(af, __builtin_bit_cast(bf16x8, pf[st]), o[lb], 0, 0, 0); } \
            } } while (0)
#define SA_BAR() asm volatile("s_waitcnt lgkmcnt(0)\n\ts_barrier" ::: "memory")
        SA_LOAD(gcB, gpB, 0); SA_STORE(gcB, gpB, 0); asm volatile("" ::: "memory");
        SA_LOAD(gcA, gpA, 1);
        SA_LOAD(gcB, gpB, 2);
        SA_BAR();
#define SA_PAIR(jj, LA, LB) do { \
            SA_COMPUTE(false, 0); \
            SA_STORE(gcA, gpA, 1); asm volatile("" ::: "memory"); \
            if (LA) SA_LOAD(gcA, gpA, (jj) + 3); \
            SA_BAR(); \
            SA_COMPUTE(false, 1); \
            if ((jj) + 2 < NPAGES / 2) { SA_STORE(gcB, gpB, 0); asm volatile("" ::: "memory"); if (LB) SA_LOAD(gcB, gpB, (jj) + 4); } \
            SA_BAR(); } while (0)
#pragma unroll 1
        for (int jj = 0; jj < NPAGES / 2 - 4; jj += 2) SA_PAIR(jj, true, true);
        SA_PAIR(NPAGES / 2 - 4, true, false);
        SA_PAIR(NPAGES / 2 - 2, false, false);
#undef SA_PAIR
        if (sp) {
            SA_LOADV(gcB, gpB); SA_STORE(gcB, gpB, 0); SA_BAR();
            SA_COMPUTE(true, 0);
            SA_BAR();
        }
#undef SA_LOADV
#undef SA_LOAD
#undef SA_STORE
#undef SA_COMPUTE
#undef SA_BAR
        lsum += __shfl_xor(lsum, 32);
        LAS float* PO = (LAS float*)L; LAS float* ML = (LAS float*)(L + OFF_ML);
#pragma unroll
        for (int lb = 0; lb < 4; ++lb)
#pragma unroll
            for (int i = 0; i < 16; ++i) PO[w * 4096 + (lb * 16 + i) * 64 + lane] = o[lb][i];
        if (hi == 0) { ML[w * 64 + r32] = m; ML[w * 64 + 32 + r32] = lsum; }
        __syncthreads();
        { const int q2 = w & 1, jb = (w >> 1) * 16; float mk[4], fk[4], Mx = -INFINITY, Ls = 0.f;
#pragma unroll
          for (int g = 0; g < 4; ++g) { mk[g] = ML[(2 * g + q2) * 64 + r32]; Mx = fmaxf(Mx, mk[g]); }
#pragma unroll
          for (int g = 0; g < 4; ++g) { fk[g] = mk[g] == -INFINITY ? 0.f : __builtin_amdgcn_exp2f(mk[g] - Mx); Ls += fk[g] * ML[(2 * g + q2) * 64 + 32 + r32]; }
          float* dst = SP + ((size_t)unit * 64 + 32 * q2 + r32) * PSTR;
#pragma unroll
          for (int j4 = 0; j4 < 4; ++j4) { f32x4 av;
#pragma unroll
              for (int e = 0; e < 4; ++e) { const int j = jb + 4 * j4 + e; float a = 0.f;
#pragma unroll
                  for (int g = 0; g < 4; ++g) a += fk[g] * PO[(2 * g + q2) * 4096 + j * 64 + lane];
                  av[e] = a; }
              *(GAS f32x4*)(dst + 32 * (jb >> 4) + 8 * j4 + 4 * hi) = av; }
          if (jb == 0 && hi == 0) { dst[128] = Mx; dst[129] = Ls; } }
        __syncthreads();
    }
}
__device__ __forceinline__ void combine_phase(Frame& F) {
    const int lane = lane_now(), tid = F.wave * 64 + lane; const float* SP = (const float*)(F.ws + WS_SPART); LAS float* OL = (LAS float*)F.lds;
    for (int u = blockIdx.x; u < DB * 2; u += F.G) { const int sb = u >> 1, hl = tid >> 4, hq = (u & 1) * 32 + hl;
        { const int rg = tid & 15; const float* a = SP + ((size_t)(2 * sb) * 64 + hq) * PSTR; const float* b = a + 64 * PSTR;
          const float ma = a[128], mb = b[128], Mx = fmaxf(ma, mb), fa = __builtin_amdgcn_exp2f(ma - Mx), fb = __builtin_amdgcn_exp2f(mb - Mx), il = 1.f / (fa * a[129] + fb * b[129]);
          const f32x4 a0 = *(const GAS f32x4*)(a + rg * 8), a1 = *(const GAS f32x4*)(a + rg * 8 + 4), b0 = *(const GAS f32x4*)(b + rg * 8), b1 = *(const GAS f32x4*)(b + rg * 8 + 4);
#pragma unroll
          for (int e = 0; e < 4; ++e) { OL[hl * 129 + rg * 8 + e] = (fa * a0[e] + fb * b0[e]) * il; OL[hl * 129 + rg * 8 + 4 + e] = (fa * a1[e] + fb * b1[e]) * il; } }
        __syncthreads();
        { const int vg = tid & 15, h = hq >> 3, t = hq & 7; const float* wv = F.a->in[I_WUV] + h * 64 + vg * 4; float acc[4] = {0.f, 0.f, 0.f, 0.f};
#pragma unroll 8
          for (int r = 0; r < 128; ++r) { const float ov = OL[hl * 129 + r]; const f32x4 w0 = *(const GAS f32x4*)(wv + (size_t)r * 512);
              acc[0] += ov * w0.x; acc[1] += ov * w0.y; acc[2] += ov * w0.z; acc[3] += ov * w0.w; }
          u32x2 o; o.x = pk2(acc[0], acc[1]); o.y = pk2(acc[2], acc[3]);
          *(GAS u32x2*)(F.MIX() + (size_t)(MP + sb * DT + t) * 1024 + 512 + h * 64 + vg * 4) = o; }
        __syncthreads();
    }
}
}
namespace gdn {
typedef short s16x4 __attribute__((ext_vector_type(4)));
constexpr int STRB = 144, IMG = 64 * STRB;
constexpr size_t WS_GI = (size_t)2680 * MiB;
constexpr size_t ITEM_B = 5 * 8192;
constexpr size_t WS_GL = WS_GI + (size_t)8192 * ITEM_B;
__device__ __forceinline__ s16x4 vtr(const LAS unsigned char* p) { return __builtin_bit_cast(s16x4, __builtin_amdgcn_ds_read_tr16_b64_v4i16((LAS s16x4*)p)); }
__device__ __forceinline__ void zero4(f32x4 (&a)[4]) {
#pragma unroll
    for (int t = 0; t < 4; ++t) a[t] = (f32x4){0.f, 0.f, 0.f, 0.f}; }
__device__ __forceinline__ void strip_mm(f32x4 (&acc)[4], const LAS unsigned char* A, const LAS unsigned char* Bt, const int r0, const int lane) {
    const int c16 = lane & 15, q4 = lane >> 4; bf16x8 a[2], b[2][4];
#pragma unroll
    for (int ks = 0; ks < 2; ++ks) { a[ks] = *(const LAS bf16x8*)(A + (r0 + c16) * STRB + (32 * ks + 8 * q4) * 2);
#pragma unroll
        for (int tn = 0; tn < 4; ++tn) b[ks][tn] = *(const LAS bf16x8*)(Bt + (16 * tn + c16) * STRB + (32 * ks + 8 * q4) * 2); }
    __builtin_amdgcn_sched_barrier(0);
#pragma unroll
    for (int ks = 0; ks < 2; ++ks)
#pragma unroll
        for (int tn = 0; tn < 4; ++tn) acc[tn] = __builtin_amdgcn_mfma_f32_16x16x32_bf16(a[ks], b[ks][tn], acc[tn], 0, 0, 0);
}
__device__ __forceinline__ void strip_mm_at(f32x4 (&acc)[4], const LAS unsigned char* AT, const LAS unsigned char* Bt, const int r0, const int lane) {
    const int c16 = lane & 15, q4 = lane >> 4; s16x4 lo[2], hh[2]; bf16x8 b[2][4];
    const LAS unsigned char* ap = AT + (8 * q4 + (c16 >> 2)) * STRB + (r0 + 4 * (lane & 3)) * 2;
#pragma unroll
    for (int ks = 0; ks < 2; ++ks) { lo[ks] = vtr(ap + (32 * ks) * STRB); hh[ks] = vtr(ap + (32 * ks + 4) * STRB);
#pragma unroll
        for (int tn = 0; tn < 4; ++tn) b[ks][tn] = *(const LAS bf16x8*)(Bt + (16 * tn + c16) * STRB + (32 * ks + 8 * q4) * 2); }
    __builtin_amdgcn_sched_barrier(0);
#pragma unroll
    for (int ks = 0; ks < 2; ++ks) { const bf16x8 a = (bf16x8){lo[ks][0], lo[ks][1], lo[ks][2], lo[ks][3], hh[ks][0], hh[ks][1], hh[ks][2], hh[ks][3]};
#pragma unroll
        for (int tn = 0; tn < 4; ++tn) acc[tn] = __builtin_amdgcn_mfma_f32_16x16x32_bf16(a, b[ks][tn], acc[tn], 0, 0, 0); }
}
__device__ __forceinline__ void strip_mm_bk(f32x4 (&acc)[4], const LAS unsigned char* A, const LAS unsigned char* Bk, const int r0, const int lane) {
    const int c16 = lane & 15, q4 = lane >> 4; bf16x8 a[2]; s16x4 lo[2][4], hh[2][4];
    const LAS unsigned char* bp = Bk + (8 * q4 + (c16 >> 2)) * STRB + (4 * (lane & 3)) * 2;
#pragma unroll
    for (int ks = 0; ks < 2; ++ks) { a[ks] = *(const LAS bf16x8*)(A + (r0 + c16) * STRB + (32 * ks + 8 * q4) * 2);
#pragma unroll
        for (int tn = 0; tn < 4; ++tn) { lo[ks][tn] = vtr(bp + (32 * ks) * STRB + tn * 32); hh[ks][tn] = vtr(bp + (32 * ks + 4) * STRB + tn * 32); } }
    __builtin_amdgcn_sched_barrier(0);
#pragma unroll
    for (int ks = 0; ks < 2; ++ks)
#pragma unroll
        for (int tn = 0; tn < 4; ++tn) { const bf16x8 b = (bf16x8){lo[ks][tn][0], lo[ks][tn][1], lo[ks][tn][2], lo[ks][tn][3], hh[ks][tn][0], hh[ks][tn][1], hh[ks][tn][2], hh[ks][tn][3]};
            acc[tn] = __builtin_amdgcn_mfma_f32_16x16x32_bf16(a[ks], b, acc[tn], 0, 0, 0); }
}
__host__ __device__ __forceinline__ constexpr int lr_n(int r) { return ((r + 3) >> 2) << 2; }
__host__ __device__ __forceinline__ constexpr int lr_off(int r) { return r == 0 ? 0 : (8 * ((r - 1) >> 2) * (((r - 1) >> 2) + 1) + 4 * ((r - 1) & 3) * (((r - 1) >> 2) + 1)); }
static_assert(lr_off(63) + lr_n(63) == 2112 && lr_off(1) == 0 && lr_off(2) == 4 && lr_off(5) == 16 && lr_off(6) == 24, "packed L layout");

__device__ __forceinline__ void prep_seg(const bf16_t* QK, const float* cw, const size_t rowbase, const int t0, const int h, const int seg, const int lane, float (&o)[8][8]) {
    const int rg = lane >> 3, cg = lane & 7, col = seg * 512 + h * 64 + cg * 8;
    float wt[4][8];
#pragma unroll
    for (int j = 0; j < 4; ++j) { const f32x4 a = *(const GAS f32x4*)(cw + j * CONVD + col), b = *(const GAS f32x4*)(cw + j * CONVD + col + 4); wt[j][0] = a.x; wt[j][1] = a.y; wt[j][2] = a.z; wt[j][3] = a.w; wt[j][4] = b.x; wt[j][5] = b.y; wt[j][6] = b.z; wt[j][7] = b.w; }
#pragma unroll
    for (int r = 0; r < 8; ++r)
#pragma unroll
        for (int e = 0; e < 8; ++e) o[r][e] = 0.f;
#pragma unroll
    for (int rr = 0; rr < 11; ++rr) { const int t = t0 + 8 * rg + rr - 3; float x[8];
        if (t >= 0) unpack8(*(const GAS v4u*)(QK + (rowbase + t) * CONVD + col), x); else {
#pragma unroll
            for (int e = 0; e < 8; ++e) x[e] = 0.f; }
#pragma unroll
        for (int j = 0; j < 4; ++j) { const int r = rr - j;
            if (r >= 0 && r < 8) {
#pragma unroll
                for (int e = 0; e < 8; ++e) o[r][e] += wt[j][e] * x[e]; } } }
#pragma unroll
    for (int r = 0; r < 8; ++r) { float ss = 0.f;
#pragma unroll
        for (int e = 0; e < 8; ++e) { o[r][e] = silu_f(o[r][e]); ss += o[r][e] * o[r][e]; }
        if (seg < 2) { ss += __shfl_xor(ss, 1); ss += __shfl_xor(ss, 2); ss += __shfl_xor(ss, 4); const float sc = rsqrtf(ss + 1e-6f) * (seg == 0 ? 0.125f : 1.f);
#pragma unroll
            for (int e = 0; e < 8; ++e) o[r][e] *= sc; } }
}
__device__ __forceinline__ v4u pk8(const float (&a)[8], const float s) { return (v4u){pk2(a[0] * s, a[1] * s), pk2(a[2] * s, a[3] * s), pk2(a[4] * s, a[5] * s), pk2(a[6] * s, a[7] * s)}; }

template <int K> struct SolveRow {
    static __device__ __forceinline__ void run(float (&X)[64], const float xk, const f32x4 (&l)[lr_n(K) / 4], const LAS unsigned char* SB, const int lane) {
        f32x4 ln[lr_n(K - 1) / 4 + 1];
        int o_ = lr_off(K - 1) * 4; asm volatile("" : "+v"(o_) : "v"(xk));
        constexpr int NA = lr_n(K - 1) / 4 < 9 ? lr_n(K - 1) / 4 : 9;
#pragma unroll
        for (int q = 0; q < NA; ++q) ln[q] = *(const LAS f32x4*)(SB + o_ + 16 * q);
        __builtin_amdgcn_sched_barrier(0);
#pragma unroll
        for (int q = 0; q < lr_n(K) / 4; ++q)
#pragma unroll
            for (int e = 0; e < 4; ++e) if (4 * q + e < K) X[4 * q + e] = __builtin_fmaf(xk, l[q][e], X[4 * q + e]);
        const float xn = (lane == K - 1 ? 1.f : 0.f) - X[K - 1]; X[K - 1] = xn;
        __builtin_amdgcn_sched_barrier(0);
#pragma unroll
        for (int q = NA; q < lr_n(K - 1) / 4; ++q) ln[q] = *(const LAS f32x4*)(SB + o_ + 16 * q);
        __builtin_amdgcn_sched_barrier(0);
        if constexpr (K > 1) { const f32x4 (&lr)[lr_n(K - 1) / 4] = reinterpret_cast<const f32x4 (&)[lr_n(K - 1) / 4]>(ln); SolveRow<K - 1>::run(X, xn, lr, SB, lane); }
    }
};
__device__ __forceinline__ void st8_pair16(unsigned char* p, const u32x2 w, const bool evenrow, const bool sel) {
    const auto rx = __builtin_amdgcn_permlane16_swap(w.x, w.x, false, false); const auto ry = __builtin_amdgcn_permlane16_swap(w.y, w.y, false, false);
    const unsigned nx = sel ? rx[1] : rx[0], ny = sel ? ry[1] : ry[0];
    if (evenrow) *(GAS v4u*)p = (v4u){w.x, w.y, nx, ny};
}
__device__ __forceinline__ void intra_item(Frame& F, const int item, LAS unsigned char* SA, LAS unsigned char* SB, LAS float* GC, LAS float* BT) {
    const int lane = lane_now();
    const int chain = item >> 5, n = item & 31, b = chain >> 3, h = chain & 7, c16 = lane & 15, q4 = lane >> 4, rg = lane >> 3, cg = lane & 7;
    const size_t rowbase = (size_t)b * SEQ; const int t0 = 64 * n;
    const bool evenrow = !(q4 & 1); const bool sel = [&] { const auto t = __builtin_amdgcn_permlane16_swap((unsigned)lane, (unsigned)lane, false, false); return t[1] == (unsigned)(lane ^ 16); }();
    unsigned char* gi = F.ws + WS_GI + (size_t)item * ITEM_B; const bf16_t* QK = F.QKVR(); const float* cw = F.a->in[I_GCW];
    { const size_t row = rowbase + t0 + lane; float g = F.BG()[row * 16 + h]; const float bt = F.BG()[row * 16 + 8 + h];
#pragma unroll
      for (int o = 1; o < 64; o <<= 1) { const float y = __shfl_up(g, o); if (lane >= o) g += y; }
      GC[lane] = g; BT[lane] = bt; if (lane == 63) *(float*)(F.ws + WS_GL + (size_t)item * 4) = g; }
    const float gl = GC[63];
    float o[8][8];
    prep_seg(QK, cw, rowbase, t0, h, 1, lane, o);
#pragma unroll
    for (int r = 0; r < 8; ++r) { const int c = 8 * rg + r; *(LAS v4u*)(SA + c * STRB + cg * 16) = pk8(o[r], 1.f); *(GAS v4u*)(gi + 3 * 8192 + c * 128 + cg * 16) = pk8(o[r], __expf(gl - GC[c])); }
    prep_seg(QK, cw, rowbase, t0, h, 0, lane, o);
#pragma unroll
    for (int r = 0; r < 8; ++r) { const int c = 8 * rg + r; *(LAS v4u*)(SB + c * STRB + cg * 16) = pk8(o[r], 1.f); *(GAS v4u*)(gi + 2 * 8192 + c * 128 + cg * 16) = pk8(o[r], __expf(GC[c])); }
#pragma unroll 1
    for (int st = 0; st < 4; ++st) { f32x4 acc[4]; zero4(acc); strip_mm(acc, SA, SB, 16 * st, lane);
#pragma unroll
        for (int tn = 0; tn < 4; ++tn) { const int c = 16 * tn + c16, s0 = 16 * st + 4 * q4; const float gcc = GC[c]; float v[4];
#pragma unroll
            for (int i = 0; i < 4; ++i) v[i] = (c >= s0 + i) ? acc[tn][i] * __expf(gcc - GC[s0 + i]) : 0.f;
            st8_pair16(gi + 8192 + c * 128 + s0 * 2, (u32x2){pk2(v[0], v[1]), pk2(v[2], v[3])}, evenrow, sel); } }
#pragma unroll 1
    for (int st = 0; st < 4; ++st) { f32x4 acc[4]; zero4(acc); strip_mm(acc, SA, SA, 16 * st, lane);
#pragma unroll
        for (int tn = 0; tn < 4; ++tn) { const int bb = 16 * tn + c16, k0 = 16 * st + 4 * q4; const float gb = GC[bb], btb = BT[bb];
            if (k0 < lr_n(bb)) { f32x4 v;
#pragma unroll
                for (int i = 0; i < 4; ++i) v[i] = (k0 + i < bb) ? btb * acc[tn][i] * __expf(gb - GC[k0 + i]) : 0.f;
                *(LAS f32x4*)(SB + (lr_off(bb) + k0) * 4) = v; } } }
    float X[64];
#pragma unroll
    for (int k = 0; k < 64; ++k) X[k] = 0.f;
    { f32x4 l63[16];
#pragma unroll
      for (int q = 0; q < 16; ++q) l63[q] = *(const LAS f32x4*)(SB + (lr_off(63) + 4 * q) * 4);
      const float x63 = lane == 63 ? 1.f : 0.f; SolveRow<63>::run(X, x63, l63, SB, lane); X[63] = x63; }
#pragma unroll
    for (int c8 = 0; c8 < 8; ++c8) { float ww[8]; __builtin_amdgcn_sched_barrier(0);
#pragma unroll
        for (int e = 0; e < 8; ++e) { const int s = c8 * 8 + e; ww[e] = X[s] * BT[s] * __expf(GC[s]); }
        *(LAS v4u*)(SB + lane * STRB + c8 * 16) = pk8(ww, 1.f); }
#pragma unroll 1
    for (int st = 0; st < 4; ++st) { f32x4 acc[4]; zero4(acc); strip_mm_at(acc, SA, SB, 16 * st, lane);
#pragma unroll
        for (int tn = 0; tn < 4; ++tn) { const int c = 16 * tn + c16, d0 = 16 * st + 4 * q4; st8_pair16(gi + c * 128 + d0 * 2, (u32x2){pk2(-acc[tn][0], -acc[tn][1]), pk2(-acc[tn][2], -acc[tn][3])}, evenrow, sel); } }
    prep_seg(QK, cw, rowbase, t0, h, 2, lane, o);
#pragma unroll
    for (int r = 0; r < 8; ++r) *(LAS v4u*)(SA + (8 * rg + r) * STRB + cg * 16) = pk8(o[r], 1.f);
#pragma unroll
    for (int c8 = 0; c8 < 8; ++c8) { float uu[8]; __builtin_amdgcn_sched_barrier(0);
#pragma unroll
        for (int e = 0; e < 8; ++e) { const int s = c8 * 8 + e; uu[e] = X[s] * BT[s]; }
        *(LAS v4u*)(SB + lane * STRB + c8 * 16) = pk8(uu, 1.f); }
#pragma unroll 1
    for (int st = 0; st < 4; ++st) { f32x4 acc[4]; zero4(acc); strip_mm_bk(acc, SB, SA, 16 * st, lane);
#pragma unroll
        for (int tn = 0; tn < 4; ++tn) { const int v = 16 * tn + c16, c0 = 16 * st + 4 * q4; st8_pair16(gi + 4 * 8192 + (v * 64 + c0) * 2, (u32x2){pk2(acc[tn][0], acc[tn][1]), pk2(acc[tn][2], acc[tn][3])}, evenrow, sel); } }
}
__device__ __forceinline__ void sample_chain(Frame& F, const int c2, const int lane) {
    const int sb = c2 >> 3, h = c2 & 7; const size_t row0 = MP + (size_t)sb * DT; const float* S0 = F.a->in[I_SGDN] + (size_t)c2 * 4096; const float* hist = F.a->in[I_SGC] + (size_t)sb * 3 * CONVD; const float* cw = F.a->in[I_GCW];
    float S[64];
#pragma unroll
    for (int d = 0; d < 64; ++d) S[d] = S0[d * 64 + lane];
    float wq[4], wk[4], wv[4];
#pragma unroll
    for (int j = 0; j < 4; ++j) { wq[j] = cw[j * CONVD + h * 64 + lane]; wk[j] = cw[j * CONVD + 512 + h * 64 + lane]; wv[j] = cw[j * CONVD + 1024 + h * 64 + lane]; }
    const float gw = F.a->in[I_GNW][lane];
    for (int t = 0; t < DT; ++t) { const size_t row = row0 + t; float aq = 0.f, ak = 0.f, av = 0.f;
#pragma unroll
        for (int j = 0; j < 4; ++j) { const int tt = t - 3 + j; float xq, xk, xv;
            if (tt >= 0) { const bf16_t* p = F.QKVR() + (row0 + tt) * CONVD + h * 64 + lane; xq = bf2f(p[0]); xk = bf2f(p[512]); xv = bf2f(p[1024]); }
            else { const float* p = hist + (tt + 3) * CONVD + h * 64 + lane; xq = p[0]; xk = p[512]; xv = p[1024]; }
            aq += wq[j] * xq; ak += wk[j] * xk; av += wv[j] * xv; }
        aq = silu_f(aq); ak = silu_f(ak); av = silu_f(av);
        const float qd = aq * rsqrtf(wave_sum(aq * aq) + 1e-6f) * 0.125f, kd = ak * rsqrtf(wave_sum(ak * ak) + 1e-6f);
        const float g = F.BG()[row * 16 + h], beta = F.BG()[row * 16 + 8 + h], eg = __expf(g);
        float ks = 0.f;
#pragma unroll
        for (int d = 0; d < 64; ++d) ks += __builtin_bit_cast(float, __builtin_amdgcn_readlane(__builtin_bit_cast(int, kd), d)) * S[d];
        const float vn = beta * (av - eg * ks); float o = 0.f;
#pragma unroll
        for (int d = 0; d < 64; ++d) { S[d] = eg * S[d] + __builtin_bit_cast(float, __builtin_amdgcn_readlane(__builtin_bit_cast(int, kd), d)) * vn; o += __builtin_bit_cast(float, __builtin_amdgcn_readlane(__builtin_bit_cast(int, qd), d)) * S[d]; }
        const float on = o * rsqrtf(wave_sum(o * o) * (1.f / 64.f) + RMS_EPS) * gw; const float zz = bf2f(F.Z()[row * 512 + h * 64 + lane]);
        F.MIX()[row * 1024 + h * 64 + lane] = f2bf(on * silu_f(zz)); }
    float* so = F.out + O_SGDN + (size_t)c2 * 4096;
#pragma unroll
    for (int d = 0; d < 64; ++d) so[d * 64 + lane] = S[d];
}
__device__ __forceinline__ void intra_phase(Frame& F) {
    LAS unsigned char* base = F.lds + F.wave * (2 * IMG + 512);
    LAS float* GC = (LAS float*)(base + 2 * IMG); LAS float* BT = GC + 64;
#pragma unroll 1
    for (int item = F.gw; item < BATCH * H * (SEQ / 64); item += F.NGW) intra_item(F, item, base, base + IMG, GC, BT);
    for (int i = F.wave; i * F.G + (int)blockIdx.x < DB * H; i += NWAVES) sample_chain(F, i * F.G + (int)blockIdx.x, lane_now());
    __syncthreads();
}
static_assert(NWAVES * (2 * IMG + 512) <= MISC_OFF, "per-wave LDS arenas");

constexpr int C_WN = 0, C_AM = IMG, C_QG = 2 * IMG, C_KG = 3 * IMG, C_UT = 4 * IMG, C_SET = 5 * IMG;
constexpr int C_S0 = 2 * C_SET, C_S1 = C_S0 + IMG, C_VN = C_S1 + IMG, C_O = C_VN + IMG, C_END = C_O + IMG;
static_assert(C_END + 128 <= MISC_OFF, "scan LDS map");
__device__ __forceinline__ void scan_chain(Frame& F, const int chain) {
    const int lane = lane_now(), w = F.wave, tid = w * 64 + lane, c16 = lane & 15, q4 = lane >> 4, r0 = 16 * (w & 3);
    const int b = chain >> 3, h = chain & 7; const size_t rowbase = (size_t)b * SEQ; LAS unsigned char* L = F.lds;
    const unsigned char* gi0 = F.ws + WS_GI + (size_t)chain * 32 * ITEM_B; const float* GL = (const float*)(F.ws + WS_GL) + chain * 32;
    const int pr = tid >> 3, pc = tid & 7;
    for (int i = tid; i < IMG / 4; i += 512) ((LAS unsigned*)(L + C_S0))[i] = 0u;
    LAS float* EGL = (LAS float*)(L + C_END); if (tid < 32) EGL[tid] = __expf(GL[tid]);
    v4u g4a[5], g4b[5];
#define GS_LOAD(g4, n) do { const unsigned char* gp_ = gi0 + (size_t)(n) * ITEM_B + pr * 128 + pc * 16; _Pragma("unroll") for (int q = 0; q < 5; ++q) g4[q] = *(const GAS v4u*)(gp_ + q * 8192); } while (0)
#define GS_STORE(g4, set) do { LAS unsigned char* lp_ = L + (set) * C_SET + pr * STRB + pc * 16; _Pragma("unroll") for (int q = 0; q < 5; ++q) *(LAS v4u*)(lp_ + q * IMG) = g4[q]; } while (0)
    GS_LOAD(g4a, 0); GS_STORE(g4a, 0); GS_LOAD(g4a, 1);
    f32x4 Sacc[4]; zero4(Sacc);
    const float gw0 = F.a->in[I_GNW][pc * 8 + 0], gw1 = F.a->in[I_GNW][pc * 8 + 1], gw2 = F.a->in[I_GNW][pc * 8 + 2], gw3 = F.a->in[I_GNW][pc * 8 + 3], gw4 = F.a->in[I_GNW][pc * 8 + 4], gw5 = F.a->in[I_GNW][pc * 8 + 5], gw6 = F.a->in[I_GNW][pc * 8 + 6], gw7 = F.a->in[I_GNW][pc * 8 + 7];
    __syncthreads();
#define SCAN_ITER(n, LD4, ST4, ZC, ZN) do { \
        const LAS unsigned char* I = L + (n & 1) * C_SET; const LAS unsigned char* Sold = L + ((n & 1) ? C_S1 : C_S0); LAS unsigned char* Snew = L + ((n & 1) ? C_S0 : C_S1); \
        if (n + 1 < 32) ZN = *(const GAS v4u*)(F.Z() + (rowbase + 64 * (n + 1) + pr) * 512 + h * 64 + pc * 8);     \
        if (n + 2 < 32) GS_LOAD(LD4, n + 2); \
        f32x4 R[4]; \
        if (w < 4) { const LAS unsigned char* ut = I + C_UT + (r0 + 4 * q4) * 2; \
        _Pragma("unroll") \
            for (int tn = 0; tn < 4; ++tn) { const u32x2 ur = *(const LAS u32x2*)(ut + (16 * tn + c16) * STRB); R[tn] = (f32x4){__builtin_bit_cast(float, ur.x << 16), __builtin_bit_cast(float, ur.x & 0xffff0000u), __builtin_bit_cast(float, ur.y << 16), __builtin_bit_cast(float, ur.y & 0xffff0000u)}; } \
            strip_mm(R, I + C_WN, Sold, r0, lane); \
        _Pragma("unroll") \
            for (int tn = 0; tn < 4; ++tn) *(LAS u32x2*)(L + C_VN + (16 * tn + c16) * STRB + (r0 + 4 * q4) * 2) = (u32x2){pk2(R[tn][0], R[tn][1]), pk2(R[tn][2], R[tn][3])}; } \
        else { zero4(R); strip_mm(R, I + C_QG, Sold, r0, lane); } \
        asm volatile("s_waitcnt lgkmcnt(0)\n\ts_barrier" ::: "memory");     \
        if (w < 4) { const float egl = EGL[n]; \
        _Pragma("unroll") \
            for (int tn = 0; tn < 4; ++tn) Sacc[tn] = Sacc[tn] * egl; \
            strip_mm_at(Sacc, I + C_KG, L + C_VN, r0, lane); \
        _Pragma("unroll") \
            for (int tn = 0; tn < 4; ++tn) *(LAS u32x2*)(Snew + (16 * tn + c16) * STRB + (r0 + 4 * q4) * 2) = (u32x2){pk2(Sacc[tn][0], Sacc[tn][1]), pk2(Sacc[tn][2], Sacc[tn][3])}; } \
        else { strip_mm(R, I + C_AM, L + C_VN, r0, lane); \
        _Pragma("unroll") \
            for (int i = 0; i < 4; ++i) { float ss = R[0][i] * R[0][i] + R[1][i] * R[1][i] + R[2][i] * R[2][i] + R[3][i] * R[3][i]; \
                ss += __shfl_xor(ss, 1); ss += __shfl_xor(ss, 2); ss += __shfl_xor(ss, 4); ss += __shfl_xor(ss, 8); \
                const float rs = rsqrtf(ss * (1.f / 64.f) + RMS_EPS); \
        _Pragma("unroll") \
                for (int tn = 0; tn < 4; ++tn) *(LAS bf16_t*)(L + C_O + (r0 + 4 * q4 + i) * STRB + (16 * tn + c16) * 2) = (bf16_t)(pk2(R[tn][i] * rs, 0.f) & 0xffffu); } } \
        if (n + 1 < 32) GS_STORE(ST4, (n + 1) & 1); \
        asm volatile("s_waitcnt lgkmcnt(0)\n\ts_barrier" ::: "memory");     \
        { float on[8], zz[8]; unpack8(*(const LAS v4u*)(L + C_O + pr * STRB + pc * 16), on); unpack8(ZC, zz); \
          v4u ov; ov.x = pk2(on[0] * gw0 * silu_f(zz[0]), on[1] * gw1 * silu_f(zz[1])); ov.y = pk2(on[2] * gw2 * silu_f(zz[2]), on[3] * gw3 * silu_f(zz[3])); \
          ov.z = pk2(on[4] * gw4 * silu_f(zz[4]), on[5] * gw5 * silu_f(zz[5])); ov.w = pk2(on[6] * gw6 * silu_f(zz[6]), on[7] * gw7 * silu_f(zz[7])); \
          *(GAS v4u*)(F.MIX() + (rowbase + 64 * n + pr) * 1024 + h * 64 + pc * 8) = ov; } \
    } while (0)
    v4u zA = *(const GAS v4u*)(F.Z() + (rowbase + pr) * 512 + h * 64 + pc * 8), zB = zA;
    for (int n2 = 0; n2 < 32; n2 += 2) { SCAN_ITER((n2), g4b, g4a, zA, zB); SCAN_ITER((n2 + 1), g4a, g4b, zB, zA); }
#undef SCAN_ITER
#undef GS_LOAD
#undef GS_STORE
    if (w < 4) { float* so = F.out + O_PGDN + (size_t)chain * 4096;
#pragma unroll
        for (int tn = 0; tn < 4; ++tn)
#pragma unroll
            for (int i = 0; i < 4; ++i) so[(r0 + 4 * q4 + i) * 64 + 16 * tn + c16] = Sacc[tn][i]; }
    __syncthreads();
}
__device__ __forceinline__ void scan_phase(Frame& F) { for (int chain = blockIdx.x; chain < BATCH * H; chain += F.G) scan_chain(F, chain); }
}
namespace smallg {
constexpr int STRB = 144, IMG = 64 * STRB;
template <class Epi> __device__ __forceinline__ void run(Frame& F, const bf16_t* A, const bf16_t* Bt, const int K, const int N, const Epi& E) {
    const int lane = lane_now(), w = F.wave, tid = w * 64 + lane, c16 = lane & 15, q4 = lane >> 4, r0 = 16 * (w & 3), n0w = 32 * (w >> 2), pr = tid >> 3, pc = tid & 7;
    LAS unsigned char* L = F.lds;
    const int nct = N / 64;
    for (int t = blockIdx.x; t < (MS / 64) * nct; t += F.G) { const int row0 = MP + (t / nct) * 64, col0 = (t % nct) * 64;
        const bf16_t* ap = A + (size_t)(row0 + pr) * K + pc * 8; const bf16_t* bp = Bt + (size_t)(col0 + pr) * K + pc * 8;
        f32x4 acc[2] = {(f32x4){0.f, 0.f, 0.f, 0.f}, (f32x4){0.f, 0.f, 0.f, 0.f}};
        const int nk = K / 64;
#define SG_LD(ga_, gb_, kk) do { const int c_ = (kk) < nk ? (kk) : nk - 1; ga_ = *(const GAS v4u*)(ap + c_ * 64); gb_ = *(const GAS v4u*)(bp + c_ * 64); } while (0)
#define SG_ST(ga_, gb_, bufi) do { LAS unsigned char* d_ = L + (bufi) * 2 * IMG + pr * STRB + pc * 16; *(LAS v4u*)d_ = ga_; *(LAS v4u*)(d_ + IMG) = gb_; } while (0)
#define SG_MM(bufi) do { const LAS unsigned char* Ai = L + (bufi) * 2 * IMG; const LAS unsigned char* Bi = Ai + IMG; bf16x8 a[2], b[2][2]; \
            _Pragma("unroll") for (int ks = 0; ks < 2; ++ks) { a[ks] = *(const LAS bf16x8*)(Ai + (r0 + c16) * STRB + (32 * ks + 8 * q4) * 2); \
                _Pragma("unroll") for (int tn = 0; tn < 2; ++tn) b[ks][tn] = *(const LAS bf16x8*)(Bi + (n0w + 16 * tn + c16) * STRB + (32 * ks + 8 * q4) * 2); } \
            __builtin_amdgcn_sched_barrier(0); \
            _Pragma("unroll") for (int ks = 0; ks < 2; ++ks) _Pragma("unroll") for (int tn = 0; tn < 2; ++tn) acc[tn] = __builtin_amdgcn_mfma_f32_16x16x32_bf16(a[ks], b[ks][tn], acc[tn], 0, 0, 0); } while (0)
#define SG_BAR() asm volatile("s_waitcnt lgkmcnt(0)\n\ts_barrier" ::: "memory")
        v4u ga0, gb0, ga1, gb1, ga2, gb2, ga3, gb3;
        SG_LD(ga0, gb0, 0); SG_LD(ga1, gb1, 1); SG_LD(ga2, gb2, 2); SG_LD(ga3, gb3, 3);
        SG_ST(ga0, gb0, 0); asm volatile("" ::: "memory");
        SG_LD(ga0, gb0, 4);
        SG_BAR();
#pragma unroll 1
        for (int kc = 0; kc < nk; kc += 4) {
            SG_MM(0); SG_ST(ga1, gb1, 1); asm volatile("" ::: "memory"); SG_LD(ga1, gb1, kc + 5); SG_BAR();
            SG_MM(1); SG_ST(ga2, gb2, 0); asm volatile("" ::: "memory"); SG_LD(ga2, gb2, kc + 6); SG_BAR();
            SG_MM(0); SG_ST(ga3, gb3, 1); asm volatile("" ::: "memory"); SG_LD(ga3, gb3, kc + 7); SG_BAR();
            SG_MM(1); SG_ST(ga0, gb0, 0); asm volatile("" ::: "memory"); SG_LD(ga0, gb0, kc + 8); SG_BAR();
        }
#undef SG_LD
#undef SG_ST
#undef SG_MM
#undef SG_BAR
        __syncthreads();
        LAS float* T = (LAS float*)(L + 4 * IMG);
#pragma unroll
        for (int tn = 0; tn < 2; ++tn)
#pragma unroll
            for (int i = 0; i < 4; ++i) T[(r0 + 4 * q4 + i) * 68 + n0w + 16 * tn + c16] = acc[tn][i];
        __syncthreads();
        { float v[8]; const f32x4 a = *(const LAS f32x4*)(T + pr * 68 + pc * 8), b = *(const LAS f32x4*)(T + pr * 68 + pc * 8 + 4); v[0] = a[0]; v[1] = a[1]; v[2] = a[2]; v[3] = a[3]; v[4] = b[0]; v[5] = b[1]; v[6] = b[2]; v[7] = b[3];
          float s1, s2; E.vec(row0 + pr, col0 + pc * 8, v, s1, s2);
          if constexpr (Epi::STATS) { s1 += __shfl_xor(s1, 1); s1 += __shfl_xor(s1, 2); s1 += __shfl_xor(s1, 4); s2 += __shfl_xor(s2, 1); s2 += __shfl_xor(s2, 2); s2 += __shfl_xor(s2, 4); if (pc == 0) E.stat(row0 + pr, s1, s2); } }
        __syncthreads();
    }
}
__device__ __forceinline__ v4u pk8v(const float (&r)[8]) { return (v4u){pk2(r[0], r[1]), pk2(r[2], r[3]), pk2(r[4], r[5]), pk2(r[6], r[7])}; }
struct EWout { static constexpr bool STATS = true; bf16_t* O; const float* xs; float* ST;
    __device__ __forceinline__ void vec(int row, int col, const float (&v)[8], float& s1, float& s2) const { const float* x = xs + (size_t)(row - MP) * D + col; const f32x4 x0 = *(const GAS f32x4*)x, x1 = *(const GAS f32x4*)(x + 4);
        float r[8]; s1 = 0.f; s2 = 0.f;
#pragma unroll
        for (int e = 0; e < 8; ++e) { r[e] = v[e] + ALPHA * (e < 4 ? x0[e] : x1[e - 4]); s1 += r[e]; s2 += r[e] * r[e]; }
        *(GAS v4u*)(O + (size_t)row * D + col) = pk8v(r); }
    __device__ __forceinline__ void stat(int row, float s1, float s2) const { unsafeAtomicAdd(ST + 2 * row, s1); unsafeAtomicAdd(ST + 2 * row + 1, s2); } };
struct EDown { static constexpr bool STATS = false; bf16_t* O; const bf16_t* R; const float* ST; const float* g1; const float* b1;
    __device__ __forceinline__ void vec(int row, int col, const float (&v)[8], float& s1, float& s2) const { float mu, rstd; ln1_stats(ST, row, mu, rstd); float x[8]; unpack8(*(const GAS v4u*)(R + (size_t)row * D + col), x);
        const f32x4 ga = *(const GAS f32x4*)(g1 + col), gb = *(const GAS f32x4*)(g1 + col + 4), ba = *(const GAS f32x4*)(b1 + col), bb = *(const GAS f32x4*)(b1 + col + 4); float r[8];
#pragma unroll
        for (int e = 0; e < 8; ++e) r[e] = v[e] + ALPHA * ((x[e] - mu) * rstd * (e < 4 ? ga[e] : gb[e - 4]) + (e < 4 ? ba[e] : bb[e - 4]));
        *(GAS v4u*)(O + (size_t)row * D + col) = pk8v(r); s1 = 0.f; s2 = 0.f; } };
struct E1 { static constexpr bool STATS = false; bf16_t* QKVR; bf16_t* Z; bf16_t* SMB; float* out;
    __device__ __forceinline__ void vec(int row, int col, const float (&v)[8], float& s1, float& s2) const { s1 = 0.f; s2 = 0.f; const v4u w = pk8v(v);
        if (col < 1536) { *(GAS v4u*)(QKVR + (size_t)row * 1536 + col) = w; const int r = row - MP, sb = r / DT, t = r % DT;
            if (t >= DT - 3) { float* o = out + O_SGC + ((size_t)sb * 3 + (t - (DT - 3))) * CONVD + col; *(GAS f32x4*)o = (f32x4){v[0], v[1], v[2], v[3]}; *(GAS f32x4*)(o + 4) = (f32x4){v[4], v[5], v[6], v[7]}; } }
        else if (col < 2048) *(GAS v4u*)(Z + (size_t)row * 512 + col - 1536) = w;
        else *(GAS v4u*)(SMB + (size_t)row * 512 + col - 2048) = w; } };
}
#define MIXER_PHASES if (IN(4)) { { const int bid_ = (int)blockIdx.x; if ((F.G & 15) == 0) { if ((bid_ >> 3) & 1) sattn::phase(F, (bid_ >> 4) * 8 + (bid_ & 7), F.G >> 1); } else sattn::phase(F, bid_, F.G); }     pattn::phase(F); } if (IN(5)) { gdn::intra_phase(F); SEAM(5); } if (IN(6)) { sattn::combine_phase(F);     gdn::scan_phase(F); SEAM(6); }
__global__ void __launch_bounds__(NWAVES * 64, 2) fwd(Args args) {
    extern __shared__ __attribute__((aligned(16))) unsigned char lds[];
    Frame F;
    F.lds = (LAS unsigned char*)lds; F.MISC = (volatile LAS unsigned*)(F.lds + MISC_OFF);
    F.wave = __builtin_amdgcn_readfirstlane((int)threadIdx.x >> 6); F.G = gridDim.x;
    F.gw = blockIdx.x * NWAVES + F.wave; F.NGW = F.G * NWAVES;
    unsigned char* w = args.ws; F.ws = w; F.ctl = (gu32*)(w + WS_CTL); F.out = args.out; F.a = &args;
    for (int u = F.wave * 64 + lane_now(); u < (LDS_BYTES - MISC_OFF) / 4; u += NWAVES * 64) ((LAS unsigned*)(F.lds + MISC_OFF))[u] = 0u;
    __syncthreads();
    const int lo = args.ph_lo, hi = args.ph_hi;
    const bool multi = (hi - lo) > 1;
    XcdBarrier bar; bar.bar = (unsigned*)(F.ctl + CW_BAR); bar.x = 0; bar.st = nullptr; bar.lead = 0;
    if (multi) bar = xcd_barrier_post((unsigned*)(F.ctl + CW_BAR), F.MISC + 8, F.wave == 0 ? 1u : 0u);
#define IN(k) (lo <= (k) && (k) < hi)
#define SEAM(k) do { if (IN(k) && IN((k) + 1)) xcd_barrier(bar); } while (0)
    if (IN(0)) { p0_prologue(F); SEAM(0); }
    if (IN(1)) { pg8::Gemm g{F.XB(), F.W1T(), MP, N1, 1024}; pg8::StaticOrder S; S.init(MP, N1, F.G, (int)blockIdx.x); Epi1 E{F.QKVR(), F.Z(), F.out, (LAS float*)(F.lds + RING_BYTES), F.CQN(), F.CN(), F.KPE(), F.BG(), F.a->in[I_KVNW], F.a->in[I_ALOG], F.a->in[I_DTB], F.RT()};
        pg8::gemm_phase<Epi1, pg8::StaticOrder, true, true>(F.lds, g, S, E, F.wave);
        smallg::run(F, F.XB(), F.W1T(), 1024, N1, smallg::E1{F.QKVR(), F.Z(), (bf16_t*)F.SM(), F.out}); SEAM(1); }
    if (IN(2)) { p_tok(F); SEAM(2); }
    if (IN(3)) { { pg8::Gemm g{F.CQN(), F.WUQT(), M, NQ, 256}; pg8::StaticOrder S; S.init(M, NQ, F.G, (int)blockIdx.x); EpiQ E{F.QP(), F.RT()};
          pg8::gemm_phase<EpiQ, pg8::StaticOrder, true, true>(F.lds, g, S, E, F.wave); }
        { pg8::Gemm g{F.CN(), F.WUKVT(), MP, 1024, 256}; pg8::StaticOrder S; S.init(MP, 1024, F.G, (int)blockIdx.x); EpiB16 E{F.KNV(), 1024, 0};
          pg8::gemm_phase<EpiB16, pg8::StaticOrder, true, true>(F.lds, g, S, E, F.wave); }
        SEAM(3); }
    MIXER_PHASES
    if (IN(8)) { pg8::Gemm g{F.MIX(), F.WOUTT(), MP, D, 1024}; pg8::StaticOrder S; S.init(MP, D, F.G, (int)blockIdx.x); EpiPre1 E{(bf16_t*)F.PRE1(), F.XB(), (float*)(F.ws + WS_ST1)};
        pg8::gemm_phase<EpiPre1, pg8::StaticOrder, true, true>(F.lds, g, S, E, F.wave);
        smallg::run(F, F.MIX(), F.WOUTT(), 1024, D, smallg::EWout{(bf16_t*)F.PRE1(), F.a->in[I_XS], (float*)(F.ws + WS_ST1)}); SEAM(8); }
    if (IN(10)) { pg8::Gemm g{(const bf16_t*)F.PRE1(), F.WUPT(), M, FF2, 1024}; pg8::StaticOrder S; S.init(M, FF2, F.G, (int)blockIdx.x); EpiUpCG E{F.U(), F.HB(), (float*)(F.ws + WS_RAWB), (float*)(F.ws + WS_PARTB), F.a->in[I_FCW], F.out, (const float*)(F.ws + WS_GBUP), (const float*)(F.ws + WS_ST1)};
        pg8::gemm_phase<EpiUpCG, pg8::StaticOrder, true, true>(F.lds, g, S, E, F.wave); SEAM(10); }
    if (IN(11)) { p_cg(F); SEAM(11); }
    if (IN(12)) { pg8::Gemm g{F.HB(), F.WDNT(), MP, D, FF}; pg8::StaticOrder S; S.init(MP, D, F.G, (int)blockIdx.x); EpiPre2 E{F.X1B(), (const bf16_t*)F.PRE1(), (const float*)(F.ws + WS_ST1), F.a->in[I_LN1G], F.a->in[I_LN1B]};
        pg8::gemm_phase<EpiPre2, pg8::StaticOrder, true, true>(F.lds, g, S, E, F.wave);
        smallg::run(F, F.HB(), F.WDNT(), FF, D, smallg::EDown{F.X1B(), (const bf16_t*)F.PRE1(), (const float*)(F.ws + WS_ST1), F.a->in[I_LN1G], F.a->in[I_LN1B]}); SEAM(12); }
    if (IN(13)) { p_ln(F, F.X1B(), F.a->in[I_LN2G], F.a->in[I_LN2B], F.out + O_Y, nullptr); }
#undef IN
#undef SEAM
}
static int g_grid = 0;
static bool fast_setup() {
    if (g_grid) return g_grid > 0;
    int dev = 0, cus = 0, per_cu = 0;
    if (hipGetDevice(&dev) != hipSuccess || hipDeviceGetAttribute(&cus, hipDeviceAttributeMultiprocessorCount, dev) != hipSuccess) { g_grid = -1; return false; }
    if (hipFuncSetAttribute((const void*)fwd, hipFuncAttributeMaxDynamicSharedMemorySize, LDS_BYTES) != hipSuccess) { fprintf(stderr, "kernel_launch: hipFuncSetAttribute failed\n"); g_grid = -1; return false; }
    if (hipOccupancyMaxActiveBlocksPerMultiprocessor(&per_cu, (const void*)fwd, NWAVES * 64, LDS_BYTES) != hipSuccess || per_cu < 1) { fprintf(stderr, "kernel_launch: occupancy query says %d blocks/CU\n", per_cu); (void)hipGetLastError(); g_grid = -1; return false; }
    g_grid = cus;
    return true; }
static void fast_launch(void* const* d_in, void* d_out, void* d_ws, hipStream_t st, int lo, int hi) {
    Args a{}; for (int i = 0; i < N_IN; ++i) a.in[i] = (const float*)d_in[i]; a.out = (float*)d_out; a.ws = (unsigned char*)d_ws; a.ph_lo = lo; a.ph_hi = hi;
    hipLaunchKernelGGL(fwd, dim3(g_grid), dim3(NWAVES * 64), LDS_BYTES, st, a);
    const hipError_t e = hipPeekAtLastError(); if (e != hipSuccess) fprintf(stderr, "kernel_launch: launch [%d,%d) failed: %s\n", lo, hi, hipGetErrorName(e)); }
extern "C" void kernel_launch(void* const* d_in, const int* in_sizes, int n_in, void* d_out, int out_size, void* d_ws, size_t ws_size, hipStream_t stream) {
    if (n_in != N_IN || (size_t)out_size != O_END || ws_size < WS_NEED) { fprintf(stderr, "kernel_launch: unexpected sizes n_in %d out %d ws %zu\n", n_in, out_size, ws_size); return; }
    if (!fast_setup()) return;
    hipMemsetAsync((char*)d_ws + WS_CTL, 0, CTL_ZERO_BYTES, stream);
    fast_launch(d_in, d_out, d_ws, stream, 0, 14);
}
```
